# Optimizing an MI355X kernel written in HIP

```python
import math
import jax, jax.numpy as jnp
from jax import lax
import numpy as np

D_MODEL = 1024
BATCH = 2
SEQ = 8192
DEPTH = 4

N_EVEN = (DEPTH + 1) // 2
N_ODD = DEPTH // 2
D_FF = 2816
RMS_EPS = 1e-6
LN_EPS = 1e-5
SC_WIDTH = D_MODEL // 2
SC_KERNEL = 3
CM_WIDTH = D_MODEL // 2
CM_KERNEL = 31
IN_AB = 3 * SC_WIDTH + 2 * CM_WIDTH
N_HEADS = 16
HEAD_DIM = D_MODEL // N_HEADS
ATTN_WIDTH = N_HEADS * HEAD_DIM
DILATED_BRANCHES = ((128, 1), (512, 4), (2048, 16))
ATTN_BLOCK = 128
NEG_INF = -1e30

kernel_name = "hybrid_shortconv_conformer_dilated_macaron"


def rms_norm(x, g):
    xf = x.astype(jnp.float32)
    y = xf * lax.rsqrt(jnp.mean(xf * xf, axis=-1, keepdims=True) + RMS_EPS)
    return (y * g.astype(jnp.float32)).astype(x.dtype)


def layer_norm(x, g, b):
    xf = x.astype(jnp.float32)
    mu = jnp.mean(xf, axis=-1, keepdims=True)
    xc = xf - mu
    y = xc * lax.rsqrt(jnp.mean(xc * xc, axis=-1, keepdims=True) + LN_EPS)
    return (y * g.astype(jnp.float32) + b.astype(jnp.float32)).astype(x.dtype)


def swiglu_ffn(x, w_gate_up, w_down):
    gate, up = jnp.split(x @ w_gate_up, 2, axis=-1)
    return (jax.nn.silu(gate) * up) @ w_down


def causal_depthwise_conv(x, w):
    k_len, ch = w.shape
    return lax.conv_general_dilated(
        x, w[:, None, :].astype(x.dtype), window_strides=(1,), padding=[(k_len - 1, 0)],
        dimension_numbers=('NWC', 'WIO', 'NWC'), feature_group_count=ch)


def conv_mixers(h, w_in, a_kernel, b_kernel, b_bias, b_ln_g, b_ln_b, w_out):
    z = h @ w_in
    a_b, a_c, a_x, b_val, b_gate = jnp.split(
        z, [SC_WIDTH, 2 * SC_WIDTH, 3 * SC_WIDTH, 3 * SC_WIDTH + CM_WIDTH], axis=-1)
    y_a = a_b * causal_depthwise_conv(a_c * a_x, a_kernel)
    u = b_val * jax.nn.sigmoid(b_gate)
    u = causal_depthwise_conv(u, b_kernel) + b_bias.astype(u.dtype)
    y_b = jax.nn.silu(layer_norm(u, b_ln_g, b_ln_b))
    return jnp.concatenate([y_a, y_b], axis=-1) @ w_out


def alibi_slopes(n_heads):
    return np.array([2.0 ** (-8.0 * (i + 1) / n_heads) for i in range(n_heads)], dtype=np.float32)


def dilated_branch(q, k, v, slopes, window, dil):
    bsz, seq, n_h, d_h = q.shape
    span = window // dil
    assert span <= ATTN_BLOCK
    n_sub = seq // dil
    n_pad = -(-n_sub // ATTN_BLOCK) * ATTN_BLOCK
    n_blk = n_pad // ATTN_BLOCK

    def to_blocks(t):
        t = t.reshape(bsz, n_sub, dil, n_h, d_h).transpose(0, 2, 1, 3, 4)
        t = jnp.pad(t, ((0, 0), (0, 0), (0, n_pad - n_sub), (0, 0), (0, 0)))
        return t.reshape(bsz, dil, n_blk, ATTN_BLOCK, n_h, d_h)

    def with_prev(t):
        prev = jnp.pad(t, ((0, 0), (0, 0), (1, 0), (0, 0), (0, 0), (0, 0)))[:, :, :-1]
        return jnp.concatenate([prev, t], axis=3)

    qb = to_blocks(q.astype(jnp.float32)) * (1.0 / math.sqrt(d_h))
    kk = with_prev(to_blocks(k.astype(jnp.float32)))
    vv = with_prev(to_blocks(v.astype(jnp.float32)))

    scores = jnp.einsum('brnqhd,brnkhd->brnhqk', qb, kk)
    q_pos = jnp.arange(ATTN_BLOCK) + ATTN_BLOCK
    k_pos = jnp.arange(2 * ATTN_BLOCK)
    rel = q_pos[:, None] - k_pos[None, :]
    key_abs = jnp.arange(n_blk)[:, None] * ATTN_BLOCK - ATTN_BLOCK + k_pos[None, :]
    valid = ((rel >= 0) & (rel <= span))[None] & (key_abs >= 0)[:, None, :]
    bias = -slopes[:, None, None] * (dil * rel).astype(jnp.float32)[None]
    scores = jnp.where(valid[None, None, :, None], scores + bias, NEG_INF)
    lse = jax.nn.logsumexp(scores, axis=-1)
    p = jnp.exp(scores - lse[..., None])
    out = jnp.einsum('brnhqk,brnkhd->brnqhd', p, vv)

    out = out.reshape(bsz, dil, n_pad, n_h, d_h)[:, :, :n_sub]
    out = out.transpose(0, 2, 1, 3, 4).reshape(bsz, seq, n_h, d_h)
    lse = lse.transpose(0, 1, 2, 4, 3).reshape(bsz, dil, n_pad, n_h)[:, :, :n_sub]
    lse = lse.transpose(0, 2, 1, 3).reshape(bsz, seq, n_h)
    return out, lse


def dilated_attention(h, w_qkv, w_o):
    bsz, seq, _ = h.shape
    qkv = (h @ w_qkv).reshape(bsz, seq, 3, N_HEADS, HEAD_DIM)
    q, k, v = qkv[:, :, 0], qkv[:, :, 1], qkv[:, :, 2]
    slopes = jnp.asarray(alibi_slopes(N_HEADS))
    branches = [dilated_branch(q, k, v, slopes, w, d) for (w, d) in DILATED_BRANCHES]
    outs = jnp.stack([o for o, _ in branches], axis=0)
    lses = jnp.stack([l for _, l in branches], axis=0)
    alpha = jax.nn.softmax(lses, axis=0)
    o = jnp.einsum('gbsh,gbshd->bshd', alpha, outs)
    return o.reshape(bsz, seq, ATTN_WIDTH).astype(h.dtype) @ w_o


def setup_inputs(seed: int = 0) -> dict:
    key = jax.random.key(seed)
    ks = jax.random.split(key, 24)
    f32 = jnp.float32

    def dense(k, shape, fan_in):
        return jax.random.normal(k, shape, f32) * (fan_in ** -0.5)

    def gain(k, shape):
        return 1.0 + 0.01 * jax.random.normal(k, shape, f32)

    def small(k, shape):
        return 0.02 * jax.random.normal(k, shape, f32)

    return {
        'x': jax.random.normal(ks[0], (BATCH, SEQ, D_MODEL), f32),
        'ffn1_norm': gain(ks[1], (DEPTH, D_MODEL)),
        'ffn1_w_gate_up': dense(ks[2], (DEPTH, D_MODEL, 2 * D_FF), D_MODEL),
        'ffn1_w_down': dense(ks[3], (DEPTH, D_FF, D_MODEL), D_FF),
        'mix_norm': gain(ks[4], (DEPTH, D_MODEL)),
        'ffn2_norm': gain(ks[5], (DEPTH, D_MODEL)),
        'ffn2_w_gate_up': dense(ks[6], (DEPTH, D_MODEL, 2 * D_FF), D_MODEL),
        'ffn2_w_down': dense(ks[7], (DEPTH, D_FF, D_MODEL), D_FF),
        'conv_w_in': dense(ks[8], (N_EVEN, D_MODEL, IN_AB), D_MODEL),
        'conv_a_kernel': dense(ks[9], (N_EVEN, SC_KERNEL, SC_WIDTH), SC_KERNEL),
        'conv_b_kernel': dense(ks[10], (N_EVEN, CM_KERNEL, CM_WIDTH), CM_KERNEL),
        'conv_b_bias': small(ks[11], (N_EVEN, CM_WIDTH)),
        'conv_b_ln_gain': gain(ks[12], (N_EVEN, CM_WIDTH)),
        'conv_b_ln_bias': small(ks[13], (N_EVEN, CM_WIDTH)),
        'conv_w_out': dense(ks[14], (N_EVEN, SC_WIDTH + CM_WIDTH, D_MODEL), SC_WIDTH + CM_WIDTH),
        'attn_w_qkv': dense(ks[15], (N_ODD, D_MODEL, 3 * ATTN_WIDTH), D_MODEL),
        'attn_w_o': dense(ks[16], (N_ODD, ATTN_WIDTH, D_MODEL), ATTN_WIDTH),
        'final_norm': gain(ks[17], (D_MODEL,)),
    }


def reference(x, ffn1_norm, ffn1_w_gate_up, ffn1_w_down, mix_norm, ffn2_norm, ffn2_w_gate_up,
              ffn2_w_down, conv_w_in, conv_a_kernel, conv_b_kernel, conv_b_bias, conv_b_ln_gain,
              conv_b_ln_bias, conv_w_out, attn_w_qkv, attn_w_o, final_norm):
    for layer in range(DEPTH):
        x = x + 0.5 * swiglu_ffn(rms_norm(x, ffn1_norm[layer]), ffn1_w_gate_up[layer], ffn1_w_down[layer])
        h = rms_norm(x, mix_norm[layer])
        i = layer // 2
        if layer % 2 == 0:
            x = x + conv_mixers(h, conv_w_in[i], conv_a_kernel[i], conv_b_kernel[i], conv_b_bias[i],
                                conv_b_ln_gain[i], conv_b_ln_bias[i], conv_w_out[i])
        else:
            x = x + dilated_attention(h, attn_w_qkv[i], attn_w_o[i])
        x = x + 0.5 * swiglu_ffn(rms_norm(x, ffn2_norm[layer]), ffn2_w_gate_up[layer], ffn2_w_down[layer])
    return rms_norm(x, final_norm)
```

```cpp
#include <hip/hip_runtime.h>
#include <hip/hip_cooperative_groups.h>
#include <cstdio>
#include <cstdint>
namespace cg = cooperative_groups;
namespace pg8 {
#define PG8_LAS __attribute__((address_space(3)))
typedef unsigned short bf16_t;
typedef short bf16x8 __attribute__((ext_vector_type(8)));
typedef float f32x4 __attribute__((ext_vector_type(4)));
typedef unsigned u32x4 __attribute__((ext_vector_type(4)));
constexpr int BM = 256, BK = 64, HALF = 128, HTB = HALF * BK * 2  , STAGE_BYTES = 8 * HTB, NXCD = 8, WGM = 8;

__host__ __device__ __forceinline__ int lds_byte(int r, int c) { const int st = (r >> 4) * 2 + (c >> 5), rr = r & 15, cc = c & 31, ob = rr * 64 + cc * 2; return st * 1024 + (ob ^ (((ob >> 9) & 1) << 5)); }
__host__ __device__ __forceinline__ void stage_rc(int b, int& R, int& C) { const int st = b / 1024, sb = b % 1024, swz = sb ^ (((sb >> 9) & 1) << 5); R = (st >> 1) * 16 + swz / 64; C = (st & 1) * 32 + (swz % 64) / 2; }
__host__ __device__ __forceinline__ int perm32(int rho) { const int n = rho >> 4, i = rho & 15; return 8 * (i >> 2) + 4 * n + (i & 3); }

struct Unit { int pm, pn; };
struct Gemm { const bf16_t* A; const bf16_t* Bt; int M, N, K; };

struct StaticOrder {
    int nM, nN, nwg, G, c;
    __host__ __device__ void init(int M, int N, int G_, int c_) { nM = M / BM; nN = N / BM; nwg = nM * nN; G = G_; c = c_; }
    __host__ __device__ bool next(int i, Unit& u) const {
        const long L = (long)i * G + c; if (L >= nwg) return false;
        int wgid = (int)L; { const int q = nwg / NXCD, r = nwg % NXCD, xcd = wgid % NXCD, off = wgid / NXCD; wgid = (xcd < r ? xcd * (q + 1) : r * (q + 1) + (xcd - r) * q) + off; }
        const int nig = WGM * nN, gid = wgid / nig, fm = gid * WGM, gsz = (nM - fm) < WGM ? (nM - fm) : WGM;
        u.pm = fm + ((wgid % nig) % gsz); u.pn = (wgid % nig) / gsz; return true;
    }
    __device__ __forceinline__ void a_ready(const Unit&) const {}
    __device__ __forceinline__ void done(const Unit&) const {}
};

__device__ __forceinline__ unsigned cvt_pk_bf16(float lo, float hi) { unsigned r; asm volatile("v_cvt_pk_bf16_f32 %0, %1, %2" : "=v"(r) : "v"(lo), "v"(hi)); return r; }
typedef float f32x2 __attribute__((ext_vector_type(2)));
typedef unsigned long long ss_t;
constexpr float SS_SCALE = 1048576.0f;
__device__ __forceinline__ float rstd_of(const ss_t* ss, int row) { return __builtin_amdgcn_rsqf((float)ss[row] * (1.0f / (1024.0f * SS_SCALE)) + 1e-6f); }
struct EpiScale {
    static constexpr bool PERM = true, AFTER_DRAIN = false;
    bf16_t* O; int ldc; const ss_t* ss;
    __device__ __forceinline__ void operator()(const f32x4 (&acc)[2][2][4][2], const Unit& u, int wr, int wc, int fr, int fq) const {
        const int row0 = u.pm * BM + wr * 64 + fr, col0 = u.pn * BM + wc * 32 + 8 * fq;
#pragma unroll
        for (int ai = 0; ai < 2; ++ai)
#pragma unroll
            for (int m = 0; m < 4; ++m) { const int row = row0 + ai * HALF + m * 16; const float rs = rstd_of(ss, row); bf16_t* rowp = O + (size_t)row * ldc + col0;
#pragma unroll
                for (int bj = 0; bj < 2; ++bj) { const f32x4 v0 = acc[ai][bj][m][0] * rs, v1 = acc[ai][bj][m][1] * rs;
                    u32x4 w; w.x = cvt_pk_bf16(v0[0], v0[1]); w.y = cvt_pk_bf16(v0[2], v0[3]); w.z = cvt_pk_bf16(v1[0], v1[1]); w.w = cvt_pk_bf16(v1[2], v1[3]);
                    *(u32x4*)(rowp + bj * HALF) = w; }
                asm volatile("" ::: "memory"); }
    }
};
__device__ __forceinline__ float silu_mul(float g, float u) { const float e = __builtin_amdgcn_exp2f(g * -1.4426950408889634f); return g * u * __builtin_amdgcn_rcpf(1.0f + e); }
struct EpiSwiglu {
    static constexpr bool PERM = true, AFTER_DRAIN = false;
    bf16_t* H; int ldh; const ss_t* ss;
    __device__ __forceinline__ void operator()(const f32x4 (&acc)[2][2][4][2], const Unit& u, int wr, int wc, int fr, int fq) const {
        const int row0 = u.pm * BM + wr * 64 + fr, col0 = u.pn * HALF + wc * 32 + 8 * fq;
#pragma unroll
        for (int ai = 0; ai < 2; ++ai)
#pragma unroll
            for (int m = 0; m < 4; ++m) { const int row = row0 + ai * HALF + m * 16; const float rs = rstd_of(ss, row);
                const f32x4 g0 = acc[ai][0][m][0] * rs, g1 = acc[ai][0][m][1] * rs, u0 = acc[ai][1][m][0] * rs, u1 = acc[ai][1][m][1] * rs;
                u32x4 w; w.x = cvt_pk_bf16(silu_mul(g0[0], u0[0]), silu_mul(g0[1], u0[1])); w.y = cvt_pk_bf16(silu_mul(g0[2], u0[2]), silu_mul(g0[3], u0[3]));
                w.z = cvt_pk_bf16(silu_mul(g1[0], u1[0]), silu_mul(g1[1], u1[1])); w.w = cvt_pk_bf16(silu_mul(g1[2], u1[2]), silu_mul(g1[3], u1[3]));
                *(u32x4*)(H + (size_t)row * ldh + col0) = w; asm volatile("" ::: "memory"); }
    }
};
struct EpiResid {
    static constexpr bool PERM = true, AFTER_DRAIN = false;
    float* X; bf16_t* XB; ss_t* ssn; float alpha;
    __device__ __forceinline__ void operator()(const f32x4 (&acc)[2][2][4][2], const Unit& u, int wr, int wc, int fr, int fq) const {
        const int row0 = u.pm * BM + wr * 64 + fr, col0 = u.pn * BM + wc * 32 + 8 * fq;
#pragma unroll
        for (int ai = 0; ai < 2; ++ai)
#pragma unroll
            for (int m = 0; m < 4; ++m) { const int row = row0 + ai * HALF + m * 16; float* xp = X + (size_t)row * 1024 + col0; bf16_t* bp = XB + (size_t)row * 1024 + col0; float q = 0.f;
#pragma unroll
                for (int bj = 0; bj < 2; ++bj) { const f32x4 x0 = *(const f32x4*)(xp + bj * HALF), x1 = *(const f32x4*)(xp + bj * HALF + 4);
                    const f32x4 y0 = x0 + acc[ai][bj][m][0] * alpha, y1 = x1 + acc[ai][bj][m][1] * alpha;
                    *(f32x4*)(xp + bj * HALF) = y0; *(f32x4*)(xp + bj * HALF + 4) = y1;
                    u32x4 w; w.x = cvt_pk_bf16(y0[0], y0[1]); w.y = cvt_pk_bf16(y0[2], y0[3]); w.z = cvt_pk_bf16(y1[0], y1[1]); w.w = cvt_pk_bf16(y1[2], y1[3]);
                    *(u32x4*)(bp + bj * HALF) = w;
                    q += (y0[0] * y0[0] + y0[1] * y0[1]) + (y0[2] * y0[2] + y0[3] * y0[3]) + (y1[0] * y1[0] + y1[1] * y1[1]) + (y1[2] * y1[2] + y1[3] * y1[3]); }
                q += __shfl_xor(q, 16); q += __shfl_xor(q, 32);
                if (fq == 0) __hip_atomic_fetch_add(ssn + row, (ss_t)(q * SS_SCALE), __ATOMIC_RELAXED, __HIP_MEMORY_SCOPE_AGENT); asm volatile("" ::: "memory"); }
    }
};
template <class Epi, class Sched, bool ALIGN_EPI = false, bool SP2 = false>
__device__ __forceinline__ void gemm_phase(PG8_LAS unsigned char* lds, const Gemm g, const Sched& S, const Epi& E) {
    int tid = threadIdx.x; asm volatile("" : "+v"(tid)); const int wid = __builtin_amdgcn_readfirstlane(tid >> 6), lane = tid & 63, wr = wid >> 2, wc = wid & 3, fr = lane & 15, fq = lane >> 4;
    const int K = g.K, nt = K / BK;
    unsigned voffA[2], voffB[2];
#pragma unroll
    for (int i = 0; i < 2; ++i) { int R, C; stage_rc(tid * 16 + i * 8192, R, C); const int Rb = Epi::PERM ? ((R & ~31) + perm32(R & 31)) : R;
        voffA[i] = (unsigned)(R * K + C) * 2u; voffB[i] = (unsigned)(Rb * K + C) * 2u; }
    const size_t kstep = (size_t)(BK * 2);
    const size_t hstep = (size_t)HALF * K * 2;
    const size_t tstep = 2 * hstep;
    const unsigned ldsw = (unsigned)wid * 1024u;
    const int aoff = lds_byte(wr * 64 + fr, fq * 8), boff = lds_byte(wc * 32 + fr, fq * 8);
#define PG8_SA(b, h) (((b) * 2 + (h)) * HTB)
#define PG8_SB(b, h) ((4 + (b) * 2 + (h)) * HTB)
#define PG8_STAGE(bufoff, gbase, voff) do { _Pragma("unroll") for (int _i = 0; _i < 2; ++_i) \
        __builtin_amdgcn_global_load_lds((const unsigned*)((const char*)(gbase) + (voff)[_i]), (PG8_LAS unsigned*)(lds + (bufoff) + ldsw + _i * 8192), 16, 0, 0); } while (0)
#define PG8_LDA(dst, b, h) do { _Pragma("unroll") for (int m = 0; m < 4; ++m) _Pragma("unroll") for (int k = 0; k < 2; ++k) dst[m][k] = *(const PG8_LAS bf16x8*)(lds + PG8_SA(b, h) + aoff + m * 2048 + k * 1024); } while (0)
#define PG8_LDB(dst, b, h) do { _Pragma("unroll") for (int n = 0; n < 2; ++n) _Pragma("unroll") for (int k = 0; k < 2; ++k) dst[n][k] = *(const PG8_LAS bf16x8*)(lds + PG8_SB(b, h) + boff + n * 2048 + k * 1024); } while (0)
#define PG8_MMA(ai, bj, At, Bt) do { __builtin_amdgcn_s_setprio(1); _Pragma("unroll") for (int m = 0; m < 4; ++m) _Pragma("unroll") for (int n = 0; n < 2; ++n) _Pragma("unroll") for (int k = 0; k < 2; ++k) \
        acc[ai][bj][m][n] = __builtin_amdgcn_mfma_f32_16x16x32_bf16(Bt[n][k], At[m][k], acc[ai][bj][m][n], 0, 0, 0); __builtin_amdgcn_s_setprio(0); } while (0)
#define PG8_WAIT_V(n) asm volatile("s_waitcnt vmcnt(" #n ")" ::: "memory")
#define PG8_WAIT_L(n) asm volatile("s_waitcnt lgkmcnt(" #n ")" ::: "memory")
#define PG8_BAR __builtin_amdgcn_s_barrier()
#define PG8_SCHED __builtin_amdgcn_sched_barrier(0)
    Unit cur, nxt; int ui = 0;
    if (!S.next(0, cur)) return;
    f32x4 acc[2][2][4][2];
#pragma unroll
    for (int a = 0; a < 2; ++a)
#pragma unroll
        for (int b = 0; b < 2; ++b)
#pragma unroll
            for (int m = 0; m < 4; ++m)
#pragma unroll
                for (int n = 0; n < 2; ++n) acc[a][b][m][n] = (f32x4){0.f, 0.f, 0.f, 0.f};
    bf16x8 At[4][2], B0[2][2], B1[2][2];
    const char* cA = (const char*)g.A + (size_t)cur.pm * tstep; const char* cB = (const char*)g.Bt + (size_t)cur.pn * tstep;
    S.a_ready(cur);
    if constexpr (SP2) {
        PG8_STAGE(PG8_SB(0, 0), cB, voffB); PG8_STAGE(PG8_SB(0, 1), cB + hstep, voffB); PG8_STAGE(PG8_SA(0, 0), cA, voffA); PG8_STAGE(PG8_SA(0, 1), cA + hstep, voffA);
        if (wr == 1) PG8_BAR;
        PG8_WAIT_V(2); PG8_BAR;
        PG8_STAGE(PG8_SB(1, 0), cB + kstep, voffB); PG8_STAGE(PG8_SA(1, 0), cA + kstep, voffA); PG8_STAGE(PG8_SB(1, 1), cB + hstep + kstep, voffB);
        PG8_WAIT_V(6); PG8_BAR;
    } else {
        PG8_STAGE(PG8_SB(0, 0), cB, voffB); PG8_STAGE(PG8_SA(0, 0), cA, voffA); PG8_STAGE(PG8_SB(0, 1), cB + hstep, voffB); PG8_STAGE(PG8_SA(0, 1), cA + hstep, voffA);
        if (wr == 1) PG8_BAR;
        PG8_WAIT_V(4); PG8_BAR;
        PG8_STAGE(PG8_SB(1, 0), cB + kstep, voffB); PG8_STAGE(PG8_SA(1, 0), cA + kstep, voffA); PG8_STAGE(PG8_SB(1, 1), cB + hstep + kstep, voffB);
        PG8_WAIT_V(6); PG8_BAR;
    }
    for (;;) {
        const bool has_next = S.next(ui + 1, nxt);
        const char* nA = has_next ? (const char*)g.A + (size_t)nxt.pm * tstep : cA; const char* nB = has_next ? (const char*)g.Bt + (size_t)nxt.pn * tstep : cB;
        for (int t = 0; t < nt; t += 2) {
            const bool last = (t == nt - 2);
            const char* a1 = cA + (size_t)(t + 1) * kstep;
            const char* a2 = last ? nA : cA + (size_t)(t + 2) * kstep; const char* b2 = last ? nB : cB + (size_t)(t + 2) * kstep;
            const char* a3 = a2 + kstep; const char* b3 = b2 + kstep;
            if (last && has_next) S.a_ready(nxt);
            if constexpr (SP2) {
            PG8_LDB(B0, 0, 0); PG8_LDB(B1, 0, 1); PG8_SCHED; PG8_LDA(At, 0, 0); PG8_STAGE(PG8_SA(1, 1), a1 + hstep, voffA);
            PG8_WAIT_V(8); PG8_WAIT_L(0); PG8_BAR; PG8_MMA(0, 0, At, B0); PG8_MMA(0, 1, At, B1); PG8_BAR; PG8_SCHED;
            PG8_LDA(At, 0, 1); PG8_STAGE(PG8_SB(0, 0), b2, voffB); PG8_STAGE(PG8_SB(0, 1), b2 + hstep, voffB); PG8_STAGE(PG8_SA(0, 0), a2, voffA);
            PG8_WAIT_V(8); PG8_WAIT_L(0); PG8_BAR; PG8_MMA(1, 0, At, B0); PG8_MMA(1, 1, At, B1); PG8_BAR; PG8_SCHED;
            PG8_LDB(B0, 1, 0); PG8_LDB(B1, 1, 1); PG8_SCHED; PG8_LDA(At, 1, 0); PG8_STAGE(PG8_SA(0, 1), a2 + hstep, voffA);
            PG8_WAIT_V(8); PG8_WAIT_L(0); PG8_BAR; PG8_MMA(0, 0, At, B0); PG8_MMA(0, 1, At, B1); PG8_BAR; PG8_SCHED;
            PG8_LDA(At, 1, 1); PG8_STAGE(PG8_SB(1, 0), b3, voffB); PG8_STAGE(PG8_SB(1, 1), b3 + hstep, voffB); PG8_STAGE(PG8_SA(1, 0), a3, voffA);
            PG8_WAIT_V(8); PG8_WAIT_L(0); PG8_BAR; PG8_MMA(1, 0, At, B0); PG8_MMA(1, 1, At, B1); PG8_BAR; PG8_SCHED;
            } else {
            PG8_LDB(B0, 0, 0); PG8_SCHED; PG8_LDA(At, 0, 0); PG8_STAGE(PG8_SA(1, 1), a1 + hstep, voffA);
            PG8_WAIT_L(8); PG8_BAR; PG8_WAIT_L(0); PG8_MMA(0, 0, At, B0); PG8_BAR; PG8_SCHED;
            PG8_LDB(B1, 0, 1); PG8_STAGE(PG8_SB(0, 0), b2, voffB);
            PG8_BAR; PG8_WAIT_L(0); PG8_MMA(0, 1, At, B1); PG8_BAR;
            PG8_LDA(At, 0, 1); PG8_STAGE(PG8_SA(0, 0), a2, voffA);
            PG8_BAR; PG8_WAIT_L(0); PG8_MMA(1, 0, At, B0); PG8_BAR; PG8_SCHED;
            PG8_STAGE(PG8_SB(0, 1), b2 + hstep, voffB);
            PG8_WAIT_V(6); PG8_BAR; PG8_MMA(1, 1, At, B1); PG8_BAR;
            PG8_LDB(B0, 1, 0); PG8_SCHED; PG8_LDA(At, 1, 0); PG8_STAGE(PG8_SA(0, 1), a2 + hstep, voffA);
            PG8_WAIT_L(8); PG8_BAR; PG8_WAIT_L(0); PG8_MMA(0, 0, At, B0); PG8_BAR; PG8_SCHED;
            PG8_LDB(B1, 1, 1); PG8_STAGE(PG8_SB(1, 0), b3, voffB);
            PG8_BAR; PG8_WAIT_L(0); PG8_MMA(0, 1, At, B1); PG8_BAR;
            PG8_LDA(At, 1, 1); PG8_STAGE(PG8_SA(1, 0), a3, voffA);
            PG8_BAR; PG8_WAIT_L(0); PG8_MMA(1, 0, At, B0); PG8_BAR; PG8_SCHED;
            PG8_STAGE(PG8_SB(1, 1), b3 + hstep, voffB);
            PG8_WAIT_V(6); PG8_BAR; PG8_MMA(1, 1, At, B1); PG8_BAR;
            }
        }
        if constexpr (ALIGN_EPI) { if (wr == 0) PG8_BAR; }
        if constexpr (!Epi::AFTER_DRAIN) { E(acc, cur, wr, wc, fr, fq); S.done(cur); }
        if (!has_next) break;
#pragma unroll
        for (int a = 0; a < 2; ++a)
#pragma unroll
            for (int b = 0; b < 2; ++b)
#pragma unroll
                for (int m = 0; m < 4; ++m)
#pragma unroll
                    for (int n = 0; n < 2; ++n) acc[a][b][m][n] = (f32x4){0.f, 0.f, 0.f, 0.f};
        cur = nxt; cA = nA; cB = nB; ++ui;
        if constexpr (ALIGN_EPI) { if (wr == 1) PG8_BAR; }
    }
    PG8_WAIT_V(0);
    if constexpr (!ALIGN_EPI) { if (wr == 0) PG8_BAR; }
    PG8_BAR;
    if constexpr (Epi::AFTER_DRAIN) { E.fused(acc, cur, wr, wc, fr, fq, lds, wid, lane); S.done(cur); }
#undef PG8_SA
#undef PG8_SB
#undef PG8_STAGE
#undef PG8_LDA
#undef PG8_LDB
#undef PG8_MMA
#undef PG8_WAIT_V
#undef PG8_WAIT_L
#undef PG8_BAR
#undef PG8_SCHED
}
}

#ifndef MK_N_LAUNCHES
#define MK_N_LAUNCHES 1
#endif
constexpr int NWAVES = 8;
constexpr int BATCH = 2, SEQ = 8192, D = 1024, FF = 2816, M = BATCH * SEQ, DEPTH = 4;
constexpr int NIN_CONV = 2560, NQKV = 3072, NHEAD = 16;
constexpr size_t MiB = 1u << 20;
constexpr size_t WS_CTL = 0, CTL_ZERO_BYTES = 2 * MiB;
constexpr size_t WS_SS = 64 * 1024;
constexpr size_t WS_LSE = 2 * MiB;
constexpr size_t WS_W = 8 * MiB, W_STRIDE = 44 * MiB;
constexpr size_t WS_XB = 96 * MiB;
constexpr size_t WS_ACT = 128 * MiB;
constexpr size_t WS_OG = 224 * MiB;
constexpr size_t WS_MG = 320 * MiB;
constexpr size_t WS_END = 352 * MiB;
constexpr size_t OW_GU1 = 0, OW_D1 = OW_GU1 + (size_t)2 * FF * D, OW_MI = OW_D1 + (size_t)D * FF, OW_MO = OW_MI + (size_t)NQKV * D, OW_GU2 = OW_MO + (size_t)D * D, OW_D2 = OW_GU2 + (size_t)2 * FF * D, OW_END = OW_D2 + (size_t)D * FF;
static_assert(OW_END * 2 <= W_STRIDE, "weight buffer");
constexpr int LDS_BYTES = 147456;

#define LAS __attribute__((address_space(3)))
typedef unsigned short bf16;
typedef unsigned v4u __attribute__((ext_vector_type(4)));
typedef unsigned v2u __attribute__((ext_vector_type(2)));
typedef float f32x4 __attribute__((ext_vector_type(4)));
typedef short bf16x8 __attribute__((ext_vector_type(8)));
typedef short s16x4 __attribute__((ext_vector_type(4)));
#define LDS_WAIT() asm volatile("s_waitcnt lgkmcnt(0)" ::: "memory")
__device__ __forceinline__ unsigned pk2(float lo, float hi) { return pg8::cvt_pk_bf16(lo, hi); }
__device__ __forceinline__ int opq(int x) { asm volatile("" : "+v"(x)); return x; }
__device__ __forceinline__ float bf_lo(unsigned u) { return __uint_as_float(u << 16); }
__device__ __forceinline__ float bf_hi(unsigned u) { return __uint_as_float(u & 0xffff0000u); }
__device__ __forceinline__ float wave_sum(float v) {
#pragma unroll
    for (int o = 1; o < 64; o <<= 1) v += __shfl_xor(v, o);
    return v;
}

__device__ __forceinline__ void cvt_item(const float* __restrict__ W, int K, int N, bf16* WT, int dst_row0, int k0, int n0, const float* __restrict__ g, float cs, LAS float* scr, int lane) {
#pragma unroll 8
    for (int i = 0; i < 32; ++i) { const int kk = 2 * i + (lane >> 5); const float gk = g ? g[k0 + kk] * cs : cs; scr[kk * 33 + (lane & 31)] = W[(size_t)(k0 + kk) * N + n0 + (lane & 31)] * gk; }
    LDS_WAIT(); asm volatile("" ::: "memory");
    const int c = lane & 7;
#pragma unroll
    for (int j = 0; j < 4; ++j) { const int n = (lane >> 3) + 8 * j; const LAS float* s = scr + (8 * c) * 33 + n;
        v4u o; o.x = pk2(s[0 * 33], s[1 * 33]); o.y = pk2(s[2 * 33], s[3 * 33]); o.z = pk2(s[4 * 33], s[5 * 33]); o.w = pk2(s[6 * 33], s[7 * 33]);
        *(v4u*)(WT + (size_t)(dst_row0 + n) * K + k0 + 8 * c) = o; }
    LDS_WAIT(); asm volatile("" ::: "memory");
}
struct LayerW { const float *gu1, *d1, *mi, *mo, *gu2, *d2, *g1, *gm, *g2; int even; };
__device__ __forceinline__ void convert_layer(const LayerW& w, bf16* WB, LAS unsigned char* lds, int gw, int NGW, int wave, int lane) {
    LAS float* scr = (LAS float*)(lds + wave * 16384);
    const int nmi = w.even ? NIN_CONV : NQKV;
    const int I_GU = (D / 64) * (2 * FF / 32), I_D = (FF / 64) * (D / 32), I_MI = (D / 64) * (nmi / 32), I_MO = (D / 64) * (D / 32);
    const int NITEMS = 2 * I_GU + 2 * I_D + I_MI + I_MO;
    for (int it = gw; it < NITEMS; it += NGW) {
        int r = it;
        if (r < 2 * I_GU) { const int second = r >= I_GU; if (second) r -= I_GU;
            const int nblk = 2 * FF / 32, kb = r / nblk, nb = r % nblk, n0 = nb * 32;
            const int j0 = n0 < FF ? n0 : n0 - FF; const int dst = (j0 >> 7) * 256 + (n0 < FF ? 0 : 128) + (j0 & 127);
            cvt_item(second ? w.gu2 : w.gu1, D, 2 * FF, WB + (second ? OW_GU2 : OW_GU1), dst, kb * 64, n0, second ? w.g2 : w.g1, 1.0f, scr, lane); continue; }
        r -= 2 * I_GU;
        if (r < 2 * I_D) { const int second = r >= I_D; if (second) r -= I_D;
            const int nblk = D / 32, kb = r / nblk, nb = r % nblk;
            cvt_item(second ? w.d2 : w.d1, FF, D, WB + (second ? OW_D2 : OW_D1), nb * 32, kb * 64, nb * 32, nullptr, 1.0f, scr, lane); continue; }
        r -= 2 * I_D;
        if (r < I_MI) { const int nblk = nmi / 32, kb = r / nblk, nb = r % nblk, n0 = nb * 32;
            const float cs = (!w.even && n0 < D) ? 0.125f * 1.4426950408889634f : 1.0f;
            cvt_item(w.mi, D, nmi, WB + OW_MI, n0, kb * 64, n0, w.gm, cs, scr, lane); continue; }
        r -= I_MI;
        { const int nblk = D / 32, kb = r / nblk, nb = r % nblk; cvt_item(w.mo, D, D, WB + OW_MO, nb * 32, kb * 64, nb * 32, nullptr, 1.0f, scr, lane); }
    }
}

constexpr int KP = 144;
constexpr int ATT_K = 0, ATT_V = 272 * KP;
__device__ __forceinline__ void attn_phase(LAS unsigned char* lds, const bf16* __restrict__ QKV, bf16* OG, float* LSE, int G, int vcu) {
    const int tid = opq(threadIdx.x), lane = tid & 63, wid = __builtin_amdgcn_readfirstlane(tid >> 6), fr = lane & 15, fq = lane >> 4;
    for (int i = tid; i < 2 * 144; i += 512) { const int which = i / 144, c = i % 144; *(LAS v4u*)(lds + (which ? ATT_V : ATT_K) + 256 * KP + c * 16) = (v4u){0u, 0u, 0u, 0u}; }
    const int total = 3 * BATCH * NHEAD * 64;
    const int per = (total + G - 1) / G, u_beg = vcu * per, u_end = (u_beg + per < total) ? u_beg + per : total;
    v4u kreg[4], vreg[4];
#define ATT_DECODE(u) const int g_ = (u) >> 11, rem_ = (u) & 2047, b_ = rem_ >> 10, h_ = (rem_ >> 6) & 15, rb_ = rem_ & 63, sh_ = 2 * g_, nl_ = 6 - sh_, r_ = rb_ >> nl_, n_ = rb_ & ((1 << nl_) - 1)
#define ATT_PREFETCH(u) do { ATT_DECODE(u); _Pragma("unroll") for (int i = 0; i < 4; ++i) { const int idx = tid + 512 * i, k = idx >> 3, ch = idx & 7; const int j = 128 * (n_ - 1) + k; \
        if (j >= 0) { const bf16* src = QKV + ((size_t)(b_ * SEQ + (j << sh_) + r_)) * NQKV + D + h_ * 64 + ch * 8; kreg[i] = *(const v4u*)src; vreg[i] = *(const v4u*)(src + D); } \
        else { kreg[i] = (v4u){0u, 0u, 0u, 0u}; vreg[i] = (v4u){0u, 0u, 0u, 0u}; } } } while (0)
    if (u_beg < u_end) ATT_PREFETCH(u_beg);
    for (int u = u_beg; u < u_end; ++u) {
        __syncthreads();
#pragma unroll
        for (int i = 0; i < 4; ++i) { const int idx = tid + 512 * i, k = idx >> 3, ch = idx & 7; *(LAS v4u*)(lds + ATT_K + k * KP + ch * 16) = kreg[i]; *(LAS v4u*)(lds + ATT_V + k * KP + ch * 16) = vreg[i]; }
        __syncthreads();
        ATT_DECODE(u);
        const int dil = 1 << sh_;
        const size_t qrow = (size_t)(b_ * SEQ + ((128 * n_ + 16 * wid + fr) << sh_) + r_);
        const bf16* qp = QKV + qrow * NQKV + h_ * 64 + fq * 8;
        const bf16x8 qf0 = *(const bf16x8*)qp, qf1 = *(const bf16x8*)(qp + 32);
        if (u + 1 < u_end) ATT_PREFETCH(u + 1);
        f32x4 s[10];
        const LAS unsigned char* kb = lds + ATT_K + (16 * wid + fr) * KP + fq * 16;
#pragma unroll
        for (int j = 0; j < 10; ++j) { const bf16x8 k0 = *(const LAS bf16x8*)(kb + j * 16 * KP), k1 = *(const LAS bf16x8*)(kb + j * 16 * KP + 64);
            f32x4 a = (f32x4){0.f, 0.f, 0.f, 0.f}; a = __builtin_amdgcn_mfma_f32_16x16x32_bf16(k0, qf0, a, 0, 0, 0); s[j] = __builtin_amdgcn_mfma_f32_16x16x32_bf16(k1, qf1, a, 0, 0, 0); }
        const float cb = __builtin_amdgcn_exp2f(-0.5f * (float)(h_ + 1)) * (float)dil * 1.4426950408889634f;
        const int kmin = (n_ > 0) ? 0 : 128;
        float mx = -1e30f;
#pragma unroll
        for (int j = 0; j < 10; ++j)
#pragma unroll
            for (int r = 0; r < 4; ++r) { const int rel = 128 + fr - 16 * j - 4 * fq - r, k = 16 * wid + 16 * j + 4 * fq + r; const bool ok = (rel >= 0) && (rel <= 128) && (k >= kmin);
                const float v = ok ? s[j][r] - cb * (float)rel : -1e30f; s[j][r] = v; mx = fmaxf(mx, v); }
        mx = fmaxf(mx, __shfl_xor(mx, 16)); mx = fmaxf(mx, __shfl_xor(mx, 32));
        float l = 0.f;
#pragma unroll
        for (int j = 0; j < 10; ++j)
#pragma unroll
            for (int r = 0; r < 4; ++r) { const float p = __builtin_amdgcn_exp2f(s[j][r] - mx); s[j][r] = p; l += p; }
        l += __shfl_xor(l, 16); l += __shfl_xor(l, 32);
        f32x4 o[4];
#pragma unroll
        for (int dt = 0; dt < 4; ++dt) o[dt] = (f32x4){0.f, 0.f, 0.f, 0.f};
        const LAS unsigned char* vb = lds + ATT_V + (16 * wid + 4 * fq + (fr >> 2)) * KP + (fr & 3) * 8;
#pragma unroll
        for (int gk = 0; gk < 5; ++gk) {
            v4u pw; pw.x = pk2(s[2 * gk][0], s[2 * gk][1]); pw.y = pk2(s[2 * gk][2], s[2 * gk][3]); pw.z = pk2(s[2 * gk + 1][0], s[2 * gk + 1][1]); pw.w = pk2(s[2 * gk + 1][2], s[2 * gk + 1][3]);
            const bf16x8 pb = __builtin_bit_cast(bf16x8, pw);
#pragma unroll
            for (int dt = 0; dt < 4; ++dt) {
                const s16x4 lo = __builtin_bit_cast(s16x4, __builtin_amdgcn_ds_read_tr16_b64_v4i16((LAS s16x4*)(vb + gk * 32 * KP + dt * 32)));
                const s16x4 hi = __builtin_bit_cast(s16x4, __builtin_amdgcn_ds_read_tr16_b64_v4i16((LAS s16x4*)(vb + gk * 32 * KP + 16 * KP + dt * 32)));
                const bf16x8 vf = (bf16x8){lo[0], lo[1], lo[2], lo[3], hi[0], hi[1], hi[2], hi[3]};
                o[dt] = __builtin_amdgcn_mfma_f32_16x16x32_bf16(vf, pb, o[dt], 0, 0, 0);
            }
        }
        const float il = __builtin_amdgcn_rcpf(l);
        bf16* op = OG + (size_t)g_ * M * D + qrow * D + h_ * 64 + 4 * fq;
#pragma unroll
        for (int dt = 0; dt < 4; ++dt) { v2u w; w.x = pk2(o[dt][0] * il, o[dt][1] * il); w.y = pk2(o[dt][2] * il, o[dt][3] * il); *(v2u*)(op + dt * 16) = w; }
        if (fq == 0) LSE[(size_t)g_ * M * NHEAD + qrow * NHEAD + h_] = mx + __builtin_amdgcn_logf(l);
    }
#undef ATT_DECODE
#undef ATT_PREFETCH
}
__device__ __forceinline__ void merge_phase(const bf16* __restrict__ OG, const float* __restrict__ LSE, bf16* MG, int G, int bid) {
    const size_t nth = (size_t)G * 512;
    const int tid = opq(threadIdx.x);
    for (size_t idx = (size_t)bid * 512 + tid; idx < (size_t)M * 128; idx += nth) {
        const size_t row = idx >> 7; const int c = (int)(idx & 127), h = c >> 3;
        const float l0 = LSE[row * NHEAD + h], l1 = LSE[(size_t)M * NHEAD + row * NHEAD + h], l2 = LSE[(size_t)2 * M * NHEAD + row * NHEAD + h];
        const float mx = fmaxf(l0, fmaxf(l1, l2));
        float w0 = __builtin_amdgcn_exp2f(l0 - mx), w1 = __builtin_amdgcn_exp2f(l1 - mx), w2 = __builtin_amdgcn_exp2f(l2 - mx);
        const float inv = __builtin_amdgcn_rcpf(w0 + w1 + w2); w0 *= inv; w1 *= inv; w2 *= inv;
        const v4u a = *(const v4u*)(OG + row * D + c * 8), b = *(const v4u*)(OG + (size_t)M * D + row * D + c * 8), cc = *(const v4u*)(OG + (size_t)2 * M * D + row * D + c * 8);
        v4u o;
#pragma unroll
        for (int i = 0; i < 4; ++i) o[i] = pk2(w0 * bf_lo(a[i]) + w1 * bf_lo(b[i]) + w2 * bf_lo(cc[i]), w0 * bf_hi(a[i]) + w1 * bf_hi(b[i]) + w2 * bf_hi(cc[i]));
        *(v4u*)(MG + row * D + c * 8) = o;
    }
}

__device__ __forceinline__ float sigmoidf_(float x) { return __builtin_amdgcn_rcpf(1.0f + __builtin_amdgcn_exp2f(x * -1.4426950408889634f)); }
__device__ __forceinline__ void conv_phase(LAS unsigned char* lds, const bf16* __restrict__ Z, bf16* CAT, const float* __restrict__ wa, const float* __restrict__ wb, const float* __restrict__ bias,
                                           const float* __restrict__ lng, const float* __restrict__ lnb, int G, int vcu) {
    const int tid = opq(threadIdx.x), lane = tid & 63, wid = __builtin_amdgcn_readfirstlane(tid >> 6), cp = tid & 255, th = tid >> 8;
    LAS float* red = (LAS float*)(lds + 62 * 1024);
    for (int unit = vcu; unit < M / 32; unit += G) {
        const int row0 = unit * 32, s0 = row0 & (SEQ - 1);
        __syncthreads();
        for (int it = tid; it < 62 * 64; it += 512) { const int lr = it >> 6, ch = it & 63; v4u o = (v4u){0u, 0u, 0u, 0u};
            if (s0 - 30 + lr >= 0) { const bf16* zp = Z + (size_t)(row0 - 30 + lr) * NIN_CONV + 1536 + ch * 8; const v4u bv = *(const v4u*)zp, bg = *(const v4u*)(zp + 512);
#pragma unroll
                for (int i = 0; i < 4; ++i) o[i] = pk2(bf_lo(bv[i]) * sigmoidf_(bf_lo(bg[i])), bf_hi(bv[i]) * sigmoidf_(bf_hi(bg[i]))); }
            *(LAS v4u*)(lds + lr * 1024 + ch * 16) = o; }
        __syncthreads();
        float acc[16][2];
        { const float b0 = bias[2 * cp], b1 = bias[2 * cp + 1];
#pragma unroll
          for (int t = 0; t < 16; ++t) { acc[t][0] = b0; acc[t][1] = b1; } }
        const LAS unsigned char* up = lds + (th * 16) * 1024 + cp * 4;
#pragma unroll 1
        for (int k = 0; k < 31; ++k) { const float w0 = wb[k * 512 + 2 * cp], w1 = wb[k * 512 + 2 * cp + 1];
#pragma unroll
            for (int t = 0; t < 16; ++t) { const unsigned uu = *(const LAS unsigned*)(up + (t + k) * 1024); acc[t][0] += w0 * bf_lo(uu); acc[t][1] += w1 * bf_hi(uu); } }
#pragma unroll
        for (int t = 0; t < 16; ++t) { const float s1 = wave_sum(acc[t][0] + acc[t][1]), s2 = wave_sum(acc[t][0] * acc[t][0] + acc[t][1] * acc[t][1]);
            if (lane == 0) { red[(wid * 16 + t) * 2] = s1; red[(wid * 16 + t) * 2 + 1] = s2; } }
        __syncthreads();
        { const float g0 = lng[2 * cp], g1 = lng[2 * cp + 1], c0 = lnb[2 * cp], c1 = lnb[2 * cp + 1];
#pragma unroll
          for (int t = 0; t < 16; ++t) { float s1 = 0.f, s2 = 0.f;
#pragma unroll
              for (int w = 0; w < 4; ++w) { s1 += red[((th * 4 + w) * 16 + t) * 2]; s2 += red[((th * 4 + w) * 16 + t) * 2 + 1]; }
              const float mean = s1 * (1.0f / 512.0f), var = fmaxf(s2 * (1.0f / 512.0f) - mean * mean, 0.f), rstd = __builtin_amdgcn_rsqf(var + 1e-5f);
              const float y0 = (acc[t][0] - mean) * rstd * g0 + c0, y1 = (acc[t][1] - mean) * rstd * g1 + c1;
              *(unsigned*)(CAT + (size_t)(row0 + th * 16 + t) * D + 512 + 2 * cp) = pk2(y0 * sigmoidf_(y0), y1 * sigmoidf_(y1)); } }
        { const float a00 = wa[2 * cp], a01 = wa[2 * cp + 1], a10 = wa[512 + 2 * cp], a11 = wa[512 + 2 * cp + 1], a20 = wa[1024 + 2 * cp], a21 = wa[1024 + 2 * cp + 1];
          float p2x = 0.f, p2y = 0.f, p1x = 0.f, p1y = 0.f;
#pragma unroll
          for (int t = -2; t < 16; ++t) { const int s = s0 + th * 16 + t; float px = 0.f, py = 0.f;
              const bf16* zp = Z + (size_t)(row0 + th * 16 + t) * NIN_CONV + 2 * cp;
              if (s >= 0) { const unsigned c = *(const unsigned*)(zp + 512), x = *(const unsigned*)(zp + 1024); px = bf_lo(c) * bf_lo(x); py = bf_hi(c) * bf_hi(x); }
              if (t >= 0) { const unsigned bb = *(const unsigned*)zp;
                  const float y0 = bf_lo(bb) * (a00 * p2x + a10 * p1x + a20 * px), y1 = bf_hi(bb) * (a01 * p2y + a11 * p1y + a21 * py);
                  *(unsigned*)(CAT + (size_t)(row0 + th * 16 + t) * D + 2 * cp) = pk2(y0, y1); }
              p2x = p1x; p2y = p1y; p1x = px; p1y = py; } }
    }
}

struct Args { const float* in[18]; float* out; unsigned char* ws; int ph_lo, ph_hi; };
__global__ void __launch_bounds__(NWAVES * 64, 2) mk_fwd(Args args) {
    extern __shared__ __attribute__((aligned(16))) unsigned char lds_raw[];
    LAS unsigned char* lds = (LAS unsigned char*)lds_raw;
    cg::grid_group grid = cg::this_grid();
    const int G = gridDim.x, bx = blockIdx.x, vcu = (G % 8 == 0) ? (bx % 8) * (G / 8) + bx / 8 : bx;
    const int NGW = G * NWAVES;
#define TID_VARS const int tid = opq(threadIdx.x), lane = tid & 63, wave = __builtin_amdgcn_readfirstlane(tid >> 6), gw = vcu * NWAVES + wave; (void)gw; (void)lane
    unsigned char* ws = args.ws;
    float* X = args.out;
    pg8::ss_t* SS = (pg8::ss_t*)(ws + WS_SS); float* LSE = (float*)(ws + WS_LSE);
    bf16* XB = (bf16*)(ws + WS_XB); bf16* ACT = (bf16*)(ws + WS_ACT); bf16* OG = (bf16*)(ws + WS_OG); bf16* MG = (bf16*)(ws + WS_MG);
    const int lo = args.ph_lo, hi = args.ph_hi;
    int ph = 0;
#define PH_ON (ph >= lo && ph < hi)
#define GRID_BAR() do { asm volatile("s_waitcnt vmcnt(0)" ::: "memory"); grid.sync(); __builtin_amdgcn_fence(__ATOMIC_ACQUIRE, "agent"); asm volatile("s_waitcnt vmcnt(0)" ::: "memory"); } while (0)
#define PH_END do { if (PH_ON && ph + 1 < hi) GRID_BAR(); ++ph; } while (0)
#define MAKE_LW(lw, L) LayerW lw; { const int L_ = (L), i_ = L_ >> 1; lw.even = !(L_ & 1); \
        lw.gu1 = args.in[2] + (size_t)L_ * D * 2 * FF; lw.d1 = args.in[3] + (size_t)L_ * FF * D; lw.gu2 = args.in[6] + (size_t)L_ * D * 2 * FF; lw.d2 = args.in[7] + (size_t)L_ * FF * D; \
        lw.g1 = args.in[1] + L_ * D; lw.gm = args.in[4] + L_ * D; lw.g2 = args.in[5] + L_ * D; \
        lw.mi = lw.even ? args.in[8] + (size_t)i_ * D * NIN_CONV : args.in[15] + (size_t)i_ * D * NQKV; lw.mo = lw.even ? args.in[14] + (size_t)i_ * D * D : args.in[16] + (size_t)i_ * D * D; }

    if (PH_ON) {
        TID_VARS;
        const float* x = args.in[0];
        for (int m = gw; m < M; m += NGW) { const f32x4* xr = (const f32x4*)(x + (size_t)m * D) + lane; f32x4 v[4]; float s = 0.f;
#pragma unroll
            for (int j = 0; j < 4; ++j) { v[j] = xr[64 * j]; s += (v[j].x * v[j].x + v[j].y * v[j].y) + (v[j].z * v[j].z + v[j].w * v[j].w); }
            s = wave_sum(s);
            f32x4* xo = (f32x4*)(X + (size_t)m * D) + lane; v2u* bo = (v2u*)(XB + (size_t)m * D) + lane;
#pragma unroll
            for (int j = 0; j < 4; ++j) { xo[64 * j] = v[j]; v2u w; w.x = pk2(v[j].x, v[j].y); w.y = pk2(v[j].z, v[j].w); bo[64 * j] = w; }
            if (lane == 0) SS[m] = (pg8::ss_t)(s * pg8::SS_SCALE); }
        MAKE_LW(lw, 0); convert_layer(lw, (bf16*)(ws + WS_W), lds, gw, NGW, wave, lane);
    }
    PH_END;

    for (int sb = 0; sb < 3 * DEPTH; ++sb) {
        const int L = sb / 3, kind = sb % 3, even = !(L & 1);
        bf16* WB = (bf16*)(ws + WS_W + (size_t)(L & 1) * W_STRIDE);
        pg8::ss_t* ss_in = SS + (size_t)sb * M; pg8::ss_t* ss_out = SS + (size_t)(sb + 1) * M;
        if (kind != 1) {
            if (PH_ON) { pg8::Gemm g{XB, WB + (kind ? OW_GU2 : OW_GU1), M, 2 * FF, D}; pg8::StaticOrder S; S.init(M, 2 * FF, G, bx);
                pg8::EpiSwiglu E{ACT, FF, ss_in};

#ifndef NO_G1
                pg8::gemm_phase<pg8::EpiSwiglu, pg8::StaticOrder, true, true>(lds, g, S, E);
#endif
            }
            PH_END;
            if (PH_ON) { pg8::Gemm g{ACT, WB + (kind ? OW_D2 : OW_D1), M, D, FF}; pg8::StaticOrder S; S.init(M, D, G, bx);
                pg8::EpiResid E{X, XB, ss_out, 0.5f};
#ifndef NO_G2
                pg8::gemm_phase<pg8::EpiResid, pg8::StaticOrder, true, true>(lds, g, S, E);
#endif
            }
            PH_END;
        } else {
            const int nmi = even ? NIN_CONV : NQKV;
            if (PH_ON) { pg8::Gemm g{XB, WB + OW_MI, M, nmi, D}; pg8::StaticOrder S; S.init(M, nmi, G, bx);
                pg8::EpiScale E{ACT, nmi, ss_in};

#ifndef NO_G3
                pg8::gemm_phase<pg8::EpiScale, pg8::StaticOrder, true, true>(lds, g, S, E);
#endif
            }
            PH_END;
            if (PH_ON) {
                const int i = L >> 1;
                if (even) {
#ifndef NO_CONV
                    conv_phase(lds, ACT, OG, args.in[9] + i * 3 * 512, args.in[10] + i * 31 * 512, args.in[11] + i * 512, args.in[12] + i * 512, args.in[13] + i * 512, G, vcu);
#endif
                } else {
#ifndef NO_ATT
                    attn_phase(lds, ACT, OG, LSE, G, vcu);
#endif
                }
                if (L + 1 < DEPTH) { __syncthreads(); TID_VARS; MAKE_LW(lw, L + 1); convert_layer(lw, (bf16*)(ws + WS_W + (size_t)((L + 1) & 1) * W_STRIDE), lds, gw, NGW, wave, lane); }
            }
            PH_END;
            if (!even) { if (PH_ON) merge_phase(OG, LSE, MG, G, vcu); PH_END; }
            if (PH_ON) { pg8::Gemm g{even ? OG : MG, WB + OW_MO, M, D, D}; pg8::StaticOrder S; S.init(M, D, G, bx);
                pg8::EpiResid E{X, XB, ss_out, 1.0f};
#ifndef NO_G4
                pg8::gemm_phase<pg8::EpiResid, pg8::StaticOrder, true, true>(lds, g, S, E);
#endif
            }
            PH_END;
        }
    }
    if (PH_ON) {
        TID_VARS;
        const float* gf = args.in[17]; const pg8::ss_t* ssf = SS + (size_t)12 * M;
        f32x4 gv[4];
#pragma unroll
        for (int j = 0; j < 4; ++j) gv[j] = ((const f32x4*)gf)[64 * j + lane];
        for (int m = gw; m < M; m += NGW) { f32x4* xr = (f32x4*)(X + (size_t)m * D) + lane; const float rs = pg8::rstd_of(ssf, m);
#pragma unroll
            for (int j = 0; j < 4; ++j) { const f32x4 v = xr[64 * j]; xr[64 * j] = v * rs * gv[j]; } }
    }
    ++ph;
}
constexpr int N_PHASES = 1 + 2 * (2 + 3 + 2) + 2 * (2 + 4 + 2) + 1;

extern "C" void kernel_launch(void* const* d_in, const int* in_sizes, int n_in, void* d_out, int out_size, void* d_ws, size_t ws_size, hipStream_t stream) {
    static int grid = 0;
    if (grid == 0) {
        if (n_in != 18 || in_sizes[0] != M * D || out_size != M * D || ws_size < WS_END) { fprintf(stderr, "kernel_launch: unexpected shapes (n_in %d, in0 %d, out %d, ws %zu)\n", n_in, n_in > 0 ? in_sizes[0] : -1, out_size, ws_size); grid = -1; return; }
        int dev = 0, cus = 0, per_cu = 0;
        hipGetDevice(&dev); hipDeviceGetAttribute(&cus, hipDeviceAttributeMultiprocessorCount, dev);
        if (hipFuncSetAttribute((const void*)mk_fwd, hipFuncAttributeMaxDynamicSharedMemorySize, LDS_BYTES) != hipSuccess) { fprintf(stderr, "kernel_launch: hipFuncSetAttribute failed\n"); grid = -1; return; }
        if (hipOccupancyMaxActiveBlocksPerMultiprocessor(&per_cu, (const void*)mk_fwd, NWAVES * 64, LDS_BYTES) != hipSuccess || per_cu < 1) { fprintf(stderr, "kernel_launch: occupancy query says %d\n", per_cu); per_cu = 1; }
        (void)hipGetLastError();
        grid = cus * (per_cu > 1 ? 1 : per_cu);
    }
    if (grid < 0) return;
    hipMemsetAsync((char*)d_ws + WS_CTL, 0, CTL_ZERO_BYTES, stream);
    Args a{};
    for (int i = 0; i < 18; ++i) a.in[i] = (const float*)d_in[i];
    a.out = (float*)d_out; a.ws = (unsigned char*)d_ws;
#if MK_N_LAUNCHES == 1
    a.ph_lo = 0; a.ph_hi = N_PHASES;
    void* kargs[] = {&a};
    hipError_t e = hipLaunchCooperativeKernel((const void*)mk_fwd, dim3(grid), dim3(NWAVES * 64), kargs, LDS_BYTES, stream);
    if (e != hipSuccess) fprintf(stderr, "kernel_launch: cooperative launch failed: %s (grid %d)\n", hipGetErrorString(e), grid);
#else
    for (int p = 0; p < N_PHASES; ++p) { a.ph_lo = p; a.ph_hi = p + 1; hipLaunchKernelGGL(mk_fwd, dim3(grid), dim3(NWAVES * 64), LDS_BYTES, stream, a); }
#endif
}
```

```cpp
#include <hip/hip_runtime.h>
#include <hip/hip_cooperative_groups.h>
#include <cstdio>
#include <cstdint>
namespace cg = cooperative_groups;
namespace pg8 {
#define PG8_LAS __attribute__((address_space(3)))
typedef unsigned short bf16_t;
typedef short bf16x8 __attribute__((ext_vector_type(8)));
typedef float f32x4 __attribute__((ext_vector_type(4)));
typedef unsigned u32x4 __attribute__((ext_vector_type(4)));
constexpr int BM = 256, BK = 64, HALF = 128, HTB = HALF * BK * 2  , STAGE_BYTES = 8 * HTB, NXCD = 8, WGM = 8;

__host__ __device__ __forceinline__ int lds_byte(int r, int c) { const int st = (r >> 4) * 2 + (c >> 5), rr = r & 15, cc = c & 31, ob = rr * 64 + cc * 2; return st * 1024 + (ob ^ (((ob >> 9) & 1) << 5)); }
__host__ __device__ __forceinline__ void stage_rc(int b, int& R, int& C) { const int st = b / 1024, sb = b % 1024, swz = sb ^ (((sb >> 9) & 1) << 5); R = (st >> 1) * 16 + swz / 64; C = (st & 1) * 32 + (swz % 64) / 2; }
__host__ __device__ __forceinline__ int perm32(int rho) { const int n = rho >> 4, i = rho & 15; return 8 * (i >> 2) + 4 * n + (i & 3); }

struct Unit { int pm, pn; };
struct Gemm { const bf16_t* A; const bf16_t* Bt; int M, N, K; };

struct StaticOrder {
    int nM, nN, nwg, G, c;
    __host__ __device__ void init(int M, int N, int G_, int c_) { nM = M / BM; nN = N / BM; nwg = nM * nN; G = G_; c = c_; }
    __host__ __device__ bool next(int i, Unit& u) const {
        const long L = (long)i * G + c; if (L >= nwg) return false;
        int wgid = (int)L; { const int q = nwg / NXCD, r = nwg % NXCD, xcd = wgid % NXCD, off = wgid / NXCD; wgid = (xcd < r ? xcd * (q + 1) : r * (q + 1) + (xcd - r) * q) + off; }
        const int nig = WGM * nN, gid = wgid / nig, fm = gid * WGM, gsz = (nM - fm) < WGM ? (nM - fm) : WGM;
        u.pm = fm + ((wgid % nig) % gsz); u.pn = (wgid % nig) / gsz; return true;
    }
    __device__ __forceinline__ void a_ready(const Unit&) const {}
    __device__ __forceinline__ void done(const Unit&) const {}
};

__device__ __forceinline__ unsigned cvt_pk_bf16(float lo, float hi) { unsigned r; asm volatile("v_cvt_pk_bf16_f32 %0, %1, %2" : "=v"(r) : "v"(lo), "v"(hi)); return r; }
typedef float f32x2 __attribute__((ext_vector_type(2)));
typedef unsigned long long ss_t;
constexpr float SS_SCALE = 1048576.0f;
__device__ __forceinline__ float rstd_of(const ss_t* ss, int row) { return __builtin_amdgcn_rsqf((float)ss[row] * (1.0f / (1024.0f * SS_SCALE)) + 1e-6f); }
struct EpiScale {
    static constexpr bool PERM = true, AFTER_DRAIN = false;
    bf16_t* O; int ldc; const ss_t* ss;
    __device__ __forceinline__ void operator()(const f32x4 (&acc)[2][2][4][2], const Unit& u, int wr, int wc, int fr, int fq) const {
        const int row0 = u.pm * BM + wr * 64 + fr, col0 = u.pn * BM + wc * 32 + 8 * fq;
#pragma unroll
        for (int ai = 0; ai < 2; ++ai)
#pragma unroll
            for (int m = 0; m < 4; ++m) { const int row = row0 + ai * HALF + m * 16; const float rs = rstd_of(ss, row); bf16_t* rowp = O + (size_t)row * ldc + col0;
#pragma unroll
                for (int bj = 0; bj < 2; ++bj) { const f32x4 v0 = acc[ai][bj][m][0] * rs, v1 = acc[ai][bj][m][1] * rs;
                    u32x4 w; w.x = cvt_pk_bf16(v0[0], v0[1]); w.y = cvt_pk_bf16(v0[2], v0[3]); w.z = cvt_pk_bf16(v1[0], v1[1]); w.w = cvt_pk_bf16(v1[2], v1[3]);
                    *(u32x4*)(rowp + bj * HALF) = w; }
                asm volatile("" ::: "memory"); }
    }
};
__device__ __forceinline__ float silu_mul(float g, float u) { const float e = __builtin_amdgcn_exp2f(g * -1.4426950408889634f); return g * u * __builtin_amdgcn_rcpf(1.0f + e); }
struct EpiSwiglu {
    static constexpr bool PERM = true, AFTER_DRAIN = false;
    bf16_t* H; int ldh; const ss_t* ss;
    __device__ __forceinline__ void operator()(const f32x4 (&acc)[2][2][4][2], const Unit& u, int wr, int wc, int fr, int fq) const {
        const int row0 = u.pm * BM + wr * 64 + fr, col0 = u.pn * HALF + wc * 32 + 8 * fq;
#pragma unroll
        for (int ai = 0; ai < 2; ++ai)
#pragma unroll
            for (int m = 0; m < 4; ++m) { const int row = row0 + ai * HALF + m * 16; const float rs = rstd_of(ss, row);
                const f32x4 g0 = acc[ai][0][m][0] * rs, g1 = acc[ai][0][m][1] * rs, u0 = acc[ai][1][m][0] * rs, u1 = acc[ai][1][m][1] * rs;
                u32x4 w; w.x = cvt_pk_bf16(silu_mul(g0[0], u0[0]), silu_mul(g0[1], u0[1])); w.y = cvt_pk_bf16(silu_mul(g0[2], u0[2]), silu_mul(g0[3], u0[3]));
                w.z = cvt_pk_bf16(silu_mul(g1[0], u1[0]), silu_mul(g1[1], u1[1])); w.w = cvt_pk_bf16(silu_mul(g1[2], u1[2]), silu_mul(g1[3], u1[3]));
                *(u32x4*)(H + (size_t)row * ldh + col0) = w; asm volatile("" ::: "memory"); }
    }
};
struct EpiResid {
    static constexpr bool PERM = true, AFTER_DRAIN = false;
    float* X; bf16_t* XB; ss_t* ssn; float alpha;
    __device__ __forceinline__ void operator()(const f32x4 (&acc)[2][2][4][2], const Unit& u, int wr, int wc, int fr, int fq) const {
        const int row0 = u.pm * BM + wr * 64 + fr, col0 = u.pn * BM + wc * 32 + 8 * fq;
#pragma unroll
        for (int ai = 0; ai < 2; ++ai)
#pragma unroll
            for (int m = 0; m < 4; ++m) { const int row = row0 + ai * HALF + m * 16; float* xp = X + (size_t)row * 1024 + col0; bf16_t* bp = XB + (size_t)row * 1024 + col0; float q = 0.f;
#pragma unroll
                for (int bj = 0; bj < 2; ++bj) { const f32x4 x0 = *(const f32x4*)(xp + bj * HALF), x1 = *(const f32x4*)(xp + bj * HALF + 4);
                    const f32x4 y0 = x0 + acc[ai][bj][m][0] * alpha, y1 = x1 + acc[ai][bj][m][1] * alpha;
                    *(f32x4*)(xp + bj * HALF) = y0; *(f32x4*)(xp + bj * HALF + 4) = y1;
                    u32x4 w; w.x = cvt_pk_bf16(y0[0], y0[1]); w.y = cvt_pk_bf16(y0[2], y0[3]); w.z = cvt_pk_bf16(y1[0], y1[1]); w.w = cvt_pk_bf16(y1[2], y1[3]);
                    *(u32x4*)(bp + bj * HALF) = w;
                    q += (y0[0] * y0[0] + y0[1] * y0[1]) + (y0[2] * y0[2] + y0[3] * y0[3]) + (y1[0] * y1[0] + y1[1] * y1[1]) + (y1[2] * y1[2] + y1[3] * y1[3]); }
                q += __shfl_xor(q, 16); q += __shfl_xor(q, 32);
                if (fq == 0) __hip_atomic_fetch_add(ssn + row, (ss_t)(q * SS_SCALE), __ATOMIC_RELAXED, __HIP_MEMORY_SCOPE_AGENT); asm volatile("" ::: "memory"); }
    }
};
template <class Epi, class Sched, bool ALIGN_EPI = false, bool SP2 = false>
__device__ __forceinline__ void gemm_phase(PG8_LAS unsigned char* lds, const Gemm g, const Sched& S, const Epi& E) {
    int tid = threadIdx.x; asm volatile("" : "+v"(tid)); const int wid = __builtin_amdgcn_readfirstlane(tid >> 6), lane = tid & 63, wr = wid >> 2, wc = wid & 3, fr = lane & 15, fq = lane >> 4;
    const int K = g.K, nt = K / BK;
    unsigned voffA[2], voffB[2];
#pragma unroll
    for (int i = 0; i < 2; ++i) { int R, C; stage_rc(tid * 16 + i * 8192, R, C); const int Rb = Epi::PERM ? ((R & ~31) + perm32(R & 31)) : R;
        voffA[i] = (unsigned)(R * K + C) * 2u; voffB[i] = (unsigned)(Rb * K + C) * 2u; }
    const size_t kstep = (size_t)(BK * 2);
    const size_t hstep = (size_t)HALF * K * 2;
    const size_t tstep = 2 * hstep;
    const unsigned ldsw = (unsigned)wid * 1024u;
    const int aoff = lds_byte(wr * 64 + fr, fq * 8), boff = lds_byte(wc * 32 + fr, fq * 8);
#define PG8_SA(b, h) (((b) * 2 + (h)) * HTB)
#define PG8_SB(b, h) ((4 + (b) * 2 + (h)) * HTB)
#define PG8_STAGE(bufoff, gbase, voff) do { _Pragma("unroll") for (int _i = 0; _i < 2; ++_i) \
        __builtin_amdgcn_global_load_lds((const unsigned*)((const char*)(gbase) + (voff)[_i]), (PG8_LAS unsigned*)(lds + (bufoff) + ldsw + _i * 8192), 16, 0, 0); } while (0)
#define PG8_LDA(dst, b, h) do { _Pragma("unroll") for (int m = 0; m < 4; ++m) _Pragma("unroll") for (int k = 0; k < 2; ++k) dst[m][k] = *(const PG8_LAS bf16x8*)(lds + PG8_SA(b, h) + aoff + m * 2048 + k * 1024); } while (0)
#define PG8_LDB(dst, b, h) do { _Pragma("unroll") for (int n = 0; n < 2; ++n) _Pragma("unroll") for (int k = 0; k < 2; ++k) dst[n][k] = *(const PG8_LAS bf16x8*)(lds + PG8_SB(b, h) + boff + n * 2048 + k * 1024); } while (0)
#define PG8_MMA(ai, bj, At, Bt) do { __builtin_amdgcn_s_setprio(1); _Pragma("unroll") for (int m = 0; m < 4; ++m) _Pragma("unroll") for (int n = 0; n < 2; ++n) _Pragma("unroll") for (int k = 0; k < 2; ++k) \
        acc[ai][bj][m][n] = __builtin_amdgcn_mfma_f32_16x16x32_bf16(Bt[n][k], At[m][k], acc[ai][bj][m][n], 0, 0, 0); __builtin_amdgcn_s_setprio(0); } while (0)
#define PG8_WAIT_V(n) asm volatile("s_waitcnt vmcnt(" #n ")" ::: "memory")
#define PG8_WAIT_L(n) asm volatile("s_waitcnt lgkmcnt(" #n ")" ::: "memory")
#define PG8_BAR __builtin_amdgcn_s_barrier()
#define PG8_SCHED __builtin_amdgcn_sched_barrier(0)
    Unit cur, nxt; int ui = 0;
    if (!S.next(0, cur)) return;
    f32x4 acc[2][2][4][2];
#pragma unroll
    for (int a = 0; a < 2; ++a)
#pragma unroll
        for (int b = 0; b < 2; ++b)
#pragma unroll
            for (int m = 0; m < 4; ++m)
#pragma unroll
                for (int n = 0; n < 2; ++n) acc[a][b][m][n] = (f32x4){0.f, 0.f, 0.f, 0.f};
    bf16x8 At[4][2], B0[2][2], B1[2][2];
    const char* cA = (const char*)g.A + (size_t)cur.pm * tstep; const char* cB = (const char*)g.Bt + (size_t)cur.pn * tstep;
    S.a_ready(cur);
    if constexpr (SP2) {
        PG8_STAGE(PG8_SB(0, 0), cB, voffB); PG8_STAGE(PG8_SB(0, 1), cB + hstep, voffB); PG8_STAGE(PG8_SA(0, 0), cA, voffA); PG8_STAGE(PG8_SA(0, 1), cA + hstep, voffA);
        if (wr == 1) PG8_BAR;
        PG8_WAIT_V(2); PG8_BAR;
        PG8_STAGE(PG8_SB(1, 0), cB + kstep, voffB); PG8_STAGE(PG8_SA(1, 0), cA + kstep, voffA); PG8_STAGE(PG8_SB(1, 1), cB + hstep + kstep, voffB);
        PG8_WAIT_V(6); PG8_BAR;
    } else {
        PG8_STAGE(PG8_SB(0, 0), cB, voffB); PG8_STAGE(PG8_SA(0, 0), cA, voffA); PG8_STAGE(PG8_SB(0, 1), cB + hstep, voffB); PG8_STAGE(PG8_SA(0, 1), cA + hstep, voffA);
        if (wr == 1) PG8_BAR;
        PG8_WAIT_V(4); PG8_BAR;
        PG8_STAGE(PG8_SB(1, 0), cB + kstep, voffB); PG8_STAGE(PG8_SA(1, 0), cA + kstep, voffA); PG8_STAGE(PG8_SB(1, 1), cB + hstep + kstep, voffB);
        PG8_WAIT_V(6); PG8_BAR;
    }
    for (;;) {
        const bool has_next = S.next(ui + 1, nxt);
        const char* nA = has_next ? (const char*)g.A + (size_t)nxt.pm * tstep : cA; const char* nB = has_next ? (const char*)g.Bt + (size_t)nxt.pn * tstep : cB;
        for (int t = 0; t < nt; t += 2) {
            const bool last = (t == nt - 2);
            const char* a1 = cA + (size_t)(t + 1) * kstep;
            const char* a2 = last ? nA : cA + (size_t)(t + 2) * kstep; const char* b2 = last ? nB : cB + (size_t)(t + 2) * kstep;
            const char* a3 = a2 + kstep; const char* b3 = b2 + kstep;
            if (last && has_next) S.a_ready(nxt);
            if constexpr (SP2) {
            PG8_LDB(B0, 0, 0); PG8_LDB(B1, 0, 1); PG8_SCHED; PG8_LDA(At, 0, 0); PG8_STAGE(PG8_SA(1, 1), a1 + hstep, voffA);
            PG8_WAIT_V(8); PG8_WAIT_L(0); PG8_BAR; PG8_MMA(0, 0, At, B0); PG8_MMA(0, 1, At, B1); PG8_BAR; PG8_SCHED;
            PG8_LDA(At, 0, 1); PG8_STAGE(PG8_SB(0, 0), b2, voffB); PG8_STAGE(PG8_SB(0, 1), b2 + hstep, voffB); PG8_STAGE(PG8_SA(0, 0), a2, voffA);
            PG8_WAIT_V(8); PG8_WAIT_L(0); PG8_BAR; PG8_MMA(1, 0, At, B0); PG8_MMA(1, 1, At, B1); PG8_BAR; PG8_SCHED;
            PG8_LDB(B0, 1, 0); PG8_LDB(B1, 1, 1); PG8_SCHED; PG8_LDA(At, 1, 0); PG8_STAGE(PG8_SA(0, 1), a2 + hstep, voffA);
            PG8_WAIT_V(8); PG8_WAIT_L(0); PG8_BAR; PG8_MMA(0, 0, At, B0); PG8_MMA(0, 1, At, B1); PG8_BAR; PG8_SCHED;
            PG8_LDA(At, 1, 1); PG8_STAGE(PG8_SB(1, 0), b3, voffB); PG8_STAGE(PG8_SB(1, 1), b3 + hstep, voffB); PG8_STAGE(PG8_SA(1, 0), a3, voffA);
            PG8_WAIT_V(8); PG8_WAIT_L(0); PG8_BAR; PG8_MMA(1, 0, At, B0); PG8_MMA(1, 1, At, B1); PG8_BAR; PG8_SCHED;
            } else {
            PG8_LDB(B0, 0, 0); PG8_SCHED; PG8_LDA(At, 0, 0); PG8_STAGE(PG8_SA(1, 1), a1 + hstep, voffA);
            PG8_WAIT_L(8); PG8_BAR; PG8_WAIT_L(0); PG8_MMA(0, 0, At, B0); PG8_BAR; PG8_SCHED;
            PG8_LDB(B1, 0, 1); PG8_STAGE(PG8_SB(0, 0), b2, voffB);
            PG8_BAR; PG8_WAIT_L(0); PG8_MMA(0, 1, At, B1); PG8_BAR;
            PG8_LDA(At, 0, 1); PG8_STAGE(PG8_SA(0, 0), a2, voffA);
            PG8_BAR; PG8_WAIT_L(0); PG8_MMA(1, 0, At, B0); PG8_BAR; PG8_SCHED;
            PG8_STAGE(PG8_SB(0, 1), b2 + hstep, voffB);
            PG8_WAIT_V(6); PG8_BAR; PG8_MMA(1, 1, At, B1); PG8_BAR;
            PG8_LDB(B0, 1, 0); PG8_SCHED; PG8_LDA(At, 1, 0); PG8_STAGE(PG8_SA(0, 1), a2 + hstep, voffA);
            PG8_WAIT_L(8); PG8_BAR; PG8_WAIT_L(0); PG8_MMA(0, 0, At, B0); PG8_BAR; PG8_SCHED;
            PG8_LDB(B1, 1, 1); PG8_STAGE(PG8_SB(1, 0), b3, voffB);
            PG8_BAR; PG8_WAIT_L(0); PG8_MMA(0, 1, At, B1); PG8_BAR;
            PG8_LDA(At, 1, 1); PG8_STAGE(PG8_SA(1, 0), a3, voffA);
            PG8_BAR; PG8_WAIT_L(0); PG8_MMA(1, 0, At, B0); PG8_BAR; PG8_SCHED;
            PG8_STAGE(PG8_SB(1, 1), b3 + hstep, voffB);
            PG8_WAIT_V(6); PG8_BAR; PG8_MMA(1, 1, At, B1); PG8_BAR;
            }
        }
        if constexpr (ALIGN_EPI) { if (wr == 0) PG8_BAR; }
        if constexpr (!Epi::AFTER_DRAIN) { E(acc, cur, wr, wc, fr, fq); S.done(cur); }
        if (!has_next) break;
#pragma unroll
        for (int a = 0; a < 2; ++a)
#pragma unroll
            for (int b = 0; b < 2; ++b)
#pragma unroll
                for (int m = 0; m < 4; ++m)
#pragma unroll
                    for (int n = 0; n < 2; ++n) acc[a][b][m][n] = (f32x4){0.f, 0.f, 0.f, 0.f};
        cur = nxt; cA = nA; cB = nB; ++ui;
        if constexpr (ALIGN_EPI) { if (wr == 1) PG8_BAR; }
    }
    PG8_WAIT_V(0);
    if constexpr (!ALIGN_EPI) { if (wr == 0) PG8_BAR; }
    PG8_BAR;
    if constexpr (Epi::AFTER_DRAIN) { E.fused(acc, cur, wr, wc, fr, fq, lds, wid, lane); S.done(cur); }
#undef PG8_SA
#undef PG8_SB
#undef PG8_STAGE
#undef PG8_LDA
#undef PG8_LDB
#undef PG8_MMA
#undef PG8_WAIT_V
#undef PG8_WAIT_L
#undef PG8_BAR
#undef PG8_SCHED
}
}

#ifndef MK_N_LAUNCHES
#define MK_N_LAUNCHES 1
#endif
constexpr int NWAVES = 8;
constexpr int BATCH = 2, SEQ = 8192, D = 1024, FF = 2816, M = BATCH * SEQ, DEPTH = 4;
constexpr int NIN_CONV = 2560, NQKV = 3072, NHEAD = 16;
constexpr size_t MiB = 1u << 20;
constexpr size_t WS_CTL = 0, CTL_ZERO_BYTES = 2 * MiB;
constexpr size_t WS_SS = 64 * 1024;
constexpr size_t WS_LSE = 2 * MiB;
constexpr size_t WS_W = 8 * MiB, W_STRIDE = 44 * MiB;
constexpr size_t WS_XB = 96 * MiB;
constexpr size_t WS_ACT = 128 * MiB;
constexpr size_t WS_OG = 224 * MiB;
constexpr size_t WS_MG = 320 * MiB;
constexpr size_t WS_END = 352 * MiB;
constexpr size_t OW_GU1 = 0, OW_D1 = OW_GU1 + (size_t)2 * FF * D, OW_MI = OW_D1 + (size_t)D * FF, OW_MO = OW_MI + (size_t)NQKV * D, OW_GU2 = OW_MO + (size_t)D * D, OW_D2 = OW_GU2 + (size_t)2 * FF * D, OW_END = OW_D2 + (size_t)D * FF;
static_assert(OW_END * 2 <= W_STRIDE, "weight buffer");
constexpr int LDS_BYTES = 147456;
constexpr int CW_BAR = 4096;
constexpr int MISC_OFF = 131072 + 320;

#define LAS __attribute__((address_space(3)))
typedef unsigned short bf16;
typedef unsigned v4u __attribute__((ext_vector_type(4)));
typedef unsigned v2u __attribute__((ext_vector_type(2)));
typedef float f32x4 __attribute__((ext_vector_type(4)));
typedef short bf16x8 __attribute__((ext_vector_type(8)));
typedef short s16x4 __attribute__((ext_vector_type(4)));
#define LDS_WAIT() asm volatile("s_waitcnt lgkmcnt(0)" ::: "memory")
__device__ __forceinline__ unsigned pk2(float lo, float hi) { return pg8::cvt_pk_bf16(lo, hi); }
__device__ __forceinline__ int opq(int x) { asm volatile("" : "+v"(x)); return x; }
__device__ __forceinline__ float bf_lo(unsigned u) { return __uint_as_float(u << 16); }
__device__ __forceinline__ float bf_hi(unsigned u) { return __uint_as_float(u & 0xffff0000u); }
__device__ __forceinline__ float wave_sum(float v) {
#pragma unroll
    for (int o = 1; o < 64; o <<= 1) v += __shfl_xor(v, o);
    return v;
}

__device__ __forceinline__ void cvt_item(const float* __restrict__ W, int K, int N, bf16* WT, int dst_row0, int k0, int n0, const float* __restrict__ g, float cs, LAS float* scr, int lane) {
#pragma unroll 8
    for (int i = 0; i < 32; ++i) { const int kk = 2 * i + (lane >> 5); const float gk = g ? g[k0 + kk] * cs : cs; scr[kk * 33 + (lane & 31)] = W[(size_t)(k0 + kk) * N + n0 + (lane & 31)] * gk; }
    LDS_WAIT(); asm volatile("" ::: "memory");
    const int c = lane & 7;
#pragma unroll
    for (int j = 0; j < 4; ++j) { const int n = (lane >> 3) + 8 * j; const LAS float* s = scr + (8 * c) * 33 + n;
        v4u o; o.x = pk2(s[0 * 33], s[1 * 33]); o.y = pk2(s[2 * 33], s[3 * 33]); o.z = pk2(s[4 * 33], s[5 * 33]); o.w = pk2(s[6 * 33], s[7 * 33]);
        *(v4u*)(WT + (size_t)(dst_row0 + n) * K + k0 + 8 * c) = o; }
    LDS_WAIT(); asm volatile("" ::: "memory");
}
struct LayerW { const float *gu1, *d1, *mi, *mo, *gu2, *d2, *g1, *gm, *g2; int even; };
__device__ __forceinline__ void convert_layer(const LayerW& w, bf16* WB, LAS unsigned char* lds, int gw, int NGW, int wave, int lane) {
    LAS float* scr = (LAS float*)(lds + wave * 16384);
    const int nmi = w.even ? NIN_CONV : NQKV;
    const int I_GU = (D / 64) * (2 * FF / 32), I_D = (FF / 64) * (D / 32), I_MI = (D / 64) * (nmi / 32), I_MO = (D / 64) * (D / 32);
    const int NITEMS = 2 * I_GU + 2 * I_D + I_MI + I_MO;
    for (int it = gw; it < NITEMS; it += NGW) {
        int r = it;
        if (r < 2 * I_GU) { const int second = r >= I_GU; if (second) r -= I_GU;
            const int nblk = 2 * FF / 32, kb = r / nblk, nb = r % nblk, n0 = nb * 32;
            const int j0 = n0 < FF ? n0 : n0 - FF; const int dst = (j0 >> 7) * 256 + (n0 < FF ? 0 : 128) + (j0 & 127);
            cvt_item(second ? w.gu2 : w.gu1, D, 2 * FF, WB + (second ? OW_GU2 : OW_GU1), dst, kb * 64, n0, second ? w.g2 : w.g1, 1.0f, scr, lane); continue; }
        r -= 2 * I_GU;
        if (r < 2 * I_D) { const int second = r >= I_D; if (second) r -= I_D;
            const int nblk = D / 32, kb = r / nblk, nb = r % nblk;
            cvt_item(second ? w.d2 : w.d1, FF, D, WB + (second ? OW_D2 : OW_D1), nb * 32, kb * 64, nb * 32, nullptr, 1.0f, scr, lane); continue; }
        r -= 2 * I_D;
        if (r < I_MI) { const int nblk = nmi / 32, kb = r / nblk, nb = r % nblk, n0 = nb * 32;
            const float cs = (!w.even && n0 < D) ? 0.125f * 1.4426950408889634f : 1.0f;
            cvt_item(w.mi, D, nmi, WB + OW_MI, n0, kb * 64, n0, w.gm, cs, scr, lane); continue; }
        r -= I_MI;
        { const int nblk = D / 32, kb = r / nblk, nb = r % nblk; cvt_item(w.mo, D, D, WB + OW_MO, nb * 32, kb * 64, nb * 32, nullptr, 1.0f, scr, lane); }
    }
}

constexpr int KP = 144;
constexpr int ATT_K = 0, ATT_V = 272 * KP;
__device__ __forceinline__ void attn_phase(LAS unsigned char* lds, const bf16* __restrict__ QKV, bf16* OG, float* LSE, int G, int vcu) {
    const int tid = opq(threadIdx.x), lane = tid & 63, wid = __builtin_amdgcn_readfirstlane(tid >> 6), fr = lane & 15, fq = lane >> 4;
    for (int i = tid; i < 2 * 144; i += 512) { const int which = i / 144, c = i % 144; *(LAS v4u*)(lds + (which ? ATT_V : ATT_K) + 256 * KP + c * 16) = (v4u){0u, 0u, 0u, 0u}; }
    const int total = 3 * BATCH * NHEAD * 64;
    const int per = (total + G - 1) / G, u_beg = vcu * per, u_end = (u_beg + per < total) ? u_beg + per : total;
    v4u kreg[4], vreg[4];
#define ATT_DECODE(u) const int g_ = (u) >> 11, rem_ = (u) & 2047, b_ = rem_ >> 10, h_ = (rem_ >> 6) & 15, rb_ = rem_ & 63, sh_ = 2 * g_, nl_ = 6 - sh_, r_ = rb_ >> nl_, n_ = rb_ & ((1 << nl_) - 1)
#define ATT_PREFETCH(u) do { ATT_DECODE(u); _Pragma("unroll") for (int i = 0; i < 4; ++i) { const int idx = tid + 512 * i, k = idx >> 3, ch = idx & 7; const int j = 128 * (n_ - 1) + k; \
        if (j >= 0) { const bf16* src = QKV + ((size_t)(b_ * SEQ + (j << sh_) + r_)) * NQKV + D + h_ * 64 + ch * 8; kreg[i] = *(const v4u*)src; vreg[i] = *(const v4u*)(src + D); } \
        else { kreg[i] = (v4u){0u, 0u, 0u, 0u}; vreg[i] = (v4u){0u, 0u, 0u, 0u}; } } } while (0)
    if (u_beg < u_end) ATT_PREFETCH(u_beg);
    for (int u = u_beg; u < u_end; ++u) {
        __syncthreads();
#pragma unroll
        for (int i = 0; i < 4; ++i) { const int idx = tid + 512 * i, k = idx >> 3, ch = idx & 7; *(LAS v4u*)(lds + ATT_K + k * KP + ch * 16) = kreg[i]; *(LAS v4u*)(lds + ATT_V + k * KP + ch * 16) = vreg[i]; }
        __syncthreads();
        ATT_DECODE(u);
        const int dil = 1 << sh_;
        const size_t qrow = (size_t)(b_ * SEQ + ((128 * n_ + 16 * wid + fr) << sh_) + r_);
        const bf16* qp = QKV + qrow * NQKV + h_ * 64 + fq * 8;
        const bf16x8 qf0 = *(const bf16x8*)qp, qf1 = *(const bf16x8*)(qp + 32);
        if (u + 1 < u_end) ATT_PREFETCH(u + 1);
        f32x4 s[10];
        const LAS unsigned char* kb = lds + ATT_K + (16 * wid + fr) * KP + fq * 16;
#pragma unroll
        for (int j = 0; j < 10; ++j) { const bf16x8 k0 = *(const LAS bf16x8*)(kb + j * 16 * KP), k1 = *(const LAS bf16x8*)(kb + j * 16 * KP + 64);
            f32x4 a = (f32x4){0.f, 0.f, 0.f, 0.f}; a = __builtin_amdgcn_mfma_f32_16x16x32_bf16(k0, qf0, a, 0, 0, 0); s[j] = __builtin_amdgcn_mfma_f32_16x16x32_bf16(k1, qf1, a, 0, 0, 0); }
        const float cb = __builtin_amdgcn_exp2f(-0.5f * (float)(h_ + 1)) * (float)dil * 1.4426950408889634f;
        const int kmin = (n_ > 0) ? 0 : 128;
        float mx = -1e30f;
#pragma unroll
        for (int j = 0; j < 10; ++j)
#pragma unroll
            for (int r = 0; r < 4; ++r) { const int rel = 128 + fr - 16 * j - 4 * fq - r, k = 16 * wid + 16 * j + 4 * fq + r; const bool ok = (rel >= 0) && (rel <= 128) && (k >= kmin);
                const float v = ok ? s[j][r] - cb * (float)rel : -1e30f; s[j][r] = v; mx = fmaxf(mx, v); }
        mx = fmaxf(mx, __shfl_xor(mx, 16)); mx = fmaxf(mx, __shfl_xor(mx, 32));
        float l = 0.f;
#pragma unroll
        for (int j = 0; j < 10; ++j)
#pragma unroll
            for (int r = 0; r < 4; ++r) { const float p = __builtin_amdgcn_exp2f(s[j][r] - mx); s[j][r] = p; l += p; }
        l += __shfl_xor(l, 16); l += __shfl_xor(l, 32);
        f32x4 o[4];
#pragma unroll
        for (int dt = 0; dt < 4; ++dt) o[dt] = (f32x4){0.f, 0.f, 0.f, 0.f};
        const LAS unsigned char* vb = lds + ATT_V + (16 * wid + 4 * fq + (fr >> 2)) * KP + (fr & 3) * 8;
#pragma unroll
        for (int gk = 0; gk < 5; ++gk) {
            v4u pw; pw.x = pk2(s[2 * gk][0], s[2 * gk][1]); pw.y = pk2(s[2 * gk][2], s[2 * gk][3]); pw.z = pk2(s[2 * gk + 1][0], s[2 * gk + 1][1]); pw.w = pk2(s[2 * gk + 1][2], s[2 * gk + 1][3]);
            const bf16x8 pb = __builtin_bit_cast(bf16x8, pw);
#pragma unroll
            for (int dt = 0; dt < 4; ++dt) {
                const s16x4 lo = __builtin_bit_cast(s16x4, __builtin_amdgcn_ds_read_tr16_b64_v4i16((LAS s16x4*)(vb + gk * 32 * KP + dt * 32)));
                const s16x4 hi = __builtin_bit_cast(s16x4, __builtin_amdgcn_ds_read_tr16_b64_v4i16((LAS s16x4*)(vb + gk * 32 * KP + 16 * KP + dt * 32)));
                const bf16x8 vf = (bf16x8){lo[0], lo[1], lo[2], lo[3], hi[0], hi[1], hi[2], hi[3]};
                o[dt] = __builtin_amdgcn_mfma_f32_16x16x32_bf16(vf, pb, o[dt], 0, 0, 0);
            }
        }
        const float il = __builtin_amdgcn_rcpf(l);
        bf16* op = OG + (size_t)g_ * M * D + qrow * D + h_ * 64 + 4 * fq;
#pragma unroll
        for (int dt = 0; dt < 4; ++dt) { v2u w; w.x = pk2(o[dt][0] * il, o[dt][1] * il); w.y = pk2(o[dt][2] * il, o[dt][3] * il); *(v2u*)(op + dt * 16) = w; }
        if (fq == 0) LSE[(size_t)g_ * M * NHEAD + qrow * NHEAD + h_] = mx + __builtin_amdgcn_logf(l);
    }
#undef ATT_DECODE
#undef ATT_PREFETCH
}
__device__ __forceinline__ void merge_phase(const bf16* __restrict__ OG, const float* __restrict__ LSE, bf16* MG, int G, int bid) {
    const size_t nth = (size_t)G * 512;
    const int tid = opq(threadIdx.x);
    for (size_t idx = (size_t)bid * 512 + tid; idx < (size_t)M * 128; idx += nth) {
        const size_t row = idx >> 7; const int c = (int)(idx & 127), h = c >> 3;
        const float l0 = LSE[row * NHEAD + h], l1 = LSE[(size_t)M * NHEAD + row * NHEAD + h], l2 = LSE[(size_t)2 * M * NHEAD + row * NHEAD + h];
        const float mx = fmaxf(l0, fmaxf(l1, l2));
        float w0 = __builtin_amdgcn_exp2f(l0 - mx), w1 = __builtin_amdgcn_exp2f(l1 - mx), w2 = __builtin_amdgcn_exp2f(l2 - mx);
        const float inv = __builtin_amdgcn_rcpf(w0 + w1 + w2); w0 *= inv; w1 *= inv; w2 *= inv;
        const v4u a = *(const v4u*)(OG + row * D + c * 8), b = *(const v4u*)(OG + (size_t)M * D + row * D + c * 8), cc = *(const v4u*)(OG + (size_t)2 * M * D + row * D + c * 8);
        v4u o;
#pragma unroll
        for (int i = 0; i < 4; ++i) o[i] = pk2(w0 * bf_lo(a[i]) + w1 * bf_lo(b[i]) + w2 * bf_lo(cc[i]), w0 * bf_hi(a[i]) + w1 * bf_hi(b[i]) + w2 * bf_hi(cc[i]));
        *(v4u*)(MG + row * D + c * 8) = o;
    }
}

__device__ __forceinline__ float sigmoidf_(float x) { return __builtin_amdgcn_rcpf(1.0f + __builtin_amdgcn_exp2f(x * -1.4426950408889634f)); }
__device__ __forceinline__ void conv_phase(LAS unsigned char* lds, const bf16* __restrict__ Z, bf16* CAT, const float* __restrict__ wa, const float* __restrict__ wb, const float* __restrict__ bias,
                                           const float* __restrict__ lng, const float* __restrict__ lnb, int G, int vcu) {
    const int tid = opq(threadIdx.x), lane = tid & 63, wid = __builtin_amdgcn_readfirstlane(tid >> 6), cp = tid & 255, th = tid >> 8;
    LAS float* red = (LAS float*)(lds + 62 * 1024);
    for (int unit = vcu; unit < M / 32; unit += G) {
        const int row0 = unit * 32, s0 = row0 & (SEQ - 1);
        __syncthreads();
        for (int it = tid; it < 62 * 64; it += 512) { const int lr = it >> 6, ch = it & 63; v4u o = (v4u){0u, 0u, 0u, 0u};
            if (s0 - 30 + lr >= 0) { const bf16* zp = Z + (size_t)(row0 - 30 + lr) * NIN_CONV + 1536 + ch * 8; const v4u bv = *(const v4u*)zp, bg = *(const v4u*)(zp + 512);
#pragma unroll
                for (int i = 0; i < 4; ++i) o[i] = pk2(bf_lo(bv[i]) * sigmoidf_(bf_lo(bg[i])), bf_hi(bv[i]) * sigmoidf_(bf_hi(bg[i]))); }
            *(LAS v4u*)(lds + lr * 1024 + ch * 16) = o; }
        __syncthreads();
        float acc[16][2];
        { const float b0 = bias[2 * cp], b1 = bias[2 * cp + 1];
#pragma unroll
          for (int t = 0; t < 16; ++t) { acc[t][0] = b0; acc[t][1] = b1; } }
        const LAS unsigned char* up = lds + (th * 16) * 1024 + cp * 4;
#pragma unroll 1
        for (int k = 0; k < 31; ++k) { const float w0 = wb[k * 512 + 2 * cp], w1 = wb[k * 512 + 2 * cp + 1];
#pragma unroll
            for (int t = 0; t < 16; ++t) { const unsigned uu = *(const LAS unsigned*)(up + (t + k) * 1024); acc[t][0] += w0 * bf_lo(uu); acc[t][1] += w1 * bf_hi(uu); } }
#pragma unroll
        for (int t = 0; t < 16; ++t) { const float s1 = wave_sum(acc[t][0] + acc[t][1]), s2 = wave_sum(acc[t][0] * acc[t][0] + acc[t][1] * acc[t][1]);
            if (lane == 0) { red[(wid * 16 + t) * 2] = s1; red[(wid * 16 + t) * 2 + 1] = s2; } }
        __syncthreads();
        { const float g0 = lng[2 * cp], g1 = lng[2 * cp + 1], c0 = lnb[2 * cp], c1 = lnb[2 * cp + 1];
#pragma unroll
          for (int t = 0; t < 16; ++t) { float s1 = 0.f, s2 = 0.f;
#pragma unroll
              for (int w = 0; w < 4; ++w) { s1 += red[((th * 4 + w) * 16 + t) * 2]; s2 += red[((th * 4 + w) * 16 + t) * 2 + 1]; }
              const float mean = s1 * (1.0f / 512.0f), var = fmaxf(s2 * (1.0f / 512.0f) - mean * mean, 0.f), rstd = __builtin_amdgcn_rsqf(var + 1e-5f);
              const float y0 = (acc[t][0] - mean) * rstd * g0 + c0, y1 = (acc[t][1] - mean) * rstd * g1 + c1;
              *(unsigned*)(CAT + (size_t)(row0 + th * 16 + t) * D + 512 + 2 * cp) = pk2(y0 * sigmoidf_(y0), y1 * sigmoidf_(y1)); } }
        { const float a00 = wa[2 * cp], a01 = wa[2 * cp + 1], a10 = wa[512 + 2 * cp], a11 = wa[512 + 2 * cp + 1], a20 = wa[1024 + 2 * cp], a21 = wa[1024 + 2 * cp + 1];
          float p2x = 0.f, p2y = 0.f, p1x = 0.f, p1y = 0.f;
#pragma unroll
          for (int t = -2; t < 16; ++t) { const int s = s0 + th * 16 + t; float px = 0.f, py = 0.f;
              const bf16* zp = Z + (size_t)(row0 + th * 16 + t) * NIN_CONV + 2 * cp;
              if (s >= 0) { const unsigned c = *(const unsigned*)(zp + 512), x = *(const unsigned*)(zp + 1024); px = bf_lo(c) * bf_lo(x); py = bf_hi(c) * bf_hi(x); }
              if (t >= 0) { const unsigned bb = *(const unsigned*)zp;
                  const float y0 = bf_lo(bb) * (a00 * p2x + a10 * p1x + a20 * px), y1 = bf_hi(bb) * (a01 * p2y + a11 * p1y + a21 * py);
                  *(unsigned*)(CAT + (size_t)(row0 + th * 16 + t) * D + 2 * cp) = pk2(y0, y1); }
              p2x = p1x; p2y = p1y; p1x = px; p1y = py; } }
    }
}

typedef __attribute__((address_space(1))) unsigned gu32;
#define XB_TMO      128
#define XB_XCNT(j)  (256  + 64 * (j))
#define XB_XSUB(j)  (1280 + 64 * (j))
#define XB_XGEN(j)  (2304 + 64 * (j))
#define XB_TOP      3328
#define XB_TOPGEN   3392
#define XCD_BAR_WORDS 3456
#define XB_SPIN_CAP (1u << 18)

__device__ __forceinline__ unsigned xb_ld(unsigned* p)              { return __hip_atomic_load(p, __ATOMIC_RELAXED, __HIP_MEMORY_SCOPE_AGENT); }
__device__ __forceinline__ unsigned xb_add(unsigned* p, unsigned v) { return __hip_atomic_fetch_add(p, v, __ATOMIC_RELAXED, __HIP_MEMORY_SCOPE_AGENT); }
__device__ __forceinline__ unsigned xb_xcc_id() { return (unsigned)__builtin_amdgcn_s_getreg((3 << 11) | 20) & 0xFu; }
#define XB_SPIN(cond, bar) do { unsigned _sp = 0; while (cond) { __builtin_amdgcn_s_sleep(1); \
    if ((++_sp & 255u) == 0u) { if (xb_ld(&(bar)[XB_TMO])) break; if (_sp > XB_SPIN_CAP) { atomicAdd(&(bar)[XB_TMO], 1u); break; } } } } while (0)

struct XcdBarrier {
    unsigned* bar; unsigned x;
    volatile LAS unsigned* st;
};

__device__ __forceinline__ XcdBarrier xcd_barrier_post(unsigned* bar, volatile LAS unsigned* st) {
    XcdBarrier b; b.bar = bar; b.x = xb_xcc_id(); b.st = st;
    if (threadIdx.x == 0) (void)xb_add(&bar[XB_XCNT(b.x)], 1u);
    return b;
}
__device__ __forceinline__ void xcd_barrier_complete(unsigned* bar, unsigned x, unsigned& nloc, unsigned& nx) {
    const unsigned G = gridDim.x * gridDim.y * gridDim.z;
    unsigned sum, cnt, mine, sp = 0u;
    for (;;) {
        sum = 0u; cnt = 0u; mine = 0u;
#pragma unroll
        for (unsigned j = 0; j < 16; ++j) { const unsigned c = xb_ld(&bar[XB_XCNT(j)]); sum += c; cnt += (c > 0u) ? 1u : 0u; mine = (j == x) ? c : mine; }
        if (sum == G) break;
        __builtin_amdgcn_s_sleep(1);
        if ((++sp & 255u) == 0u) { if (xb_ld(&bar[XB_TMO])) break; if (sp > XB_SPIN_CAP) { atomicAdd(&bar[XB_TMO], 1u); break; } }
    }
    nloc = mine > 0u ? mine : 1u; nx = cnt > 0u ? cnt : 1u;
}

__device__ __forceinline__ void xcd_barrier(const XcdBarrier& b) {
    asm volatile("s_waitcnt vmcnt(0)" ::: "memory");
    __syncthreads();
    if (threadIdx.x == 0) {
        unsigned* bar = b.bar;
        __builtin_amdgcn_s_waitcnt(0);
        unsigned nloc = b.st[0], nx = b.st[1];
        if (nloc == 0u) { xcd_barrier_complete(bar, b.x, nloc, nx); b.st[0] = nloc; b.st[1] = nx; }
        const unsigned old = xb_add(&bar[XB_XSUB(b.x)], 1u);
        const unsigned gen = old / nloc;
        if (old + 1u == (gen + 1u) * nloc) {
            __builtin_amdgcn_fence(__ATOMIC_RELEASE, "agent");
            asm volatile("s_waitcnt vmcnt(0)" ::: "memory");
            const unsigned og = xb_add(&bar[XB_TOP], 1u);
            const unsigned tg = og / nx;
            if (og + 1u == (tg + 1u) * nx) xb_add(&bar[XB_TOPGEN], 1u);
            else XB_SPIN(xb_ld(&bar[XB_TOPGEN]) == tg, bar);
            __builtin_amdgcn_fence(__ATOMIC_ACQUIRE, "agent");
            xb_add(&bar[XB_XGEN(b.x)], 1u);
            asm volatile("s_waitcnt vmcnt(0)" ::: "memory");
        } else {
            XB_SPIN(xb_ld(&bar[XB_XGEN(b.x)]) == gen, bar);
            __builtin_amdgcn_fence(__ATOMIC_ACQUIRE, "agent");
            asm volatile("s_waitcnt vmcnt(0)" ::: "memory");
        }
    }
    __syncthreads();
}

struct Args { const float* in[18]; float* out; unsigned char* ws; int ph_lo, ph_hi; };
__global__ void __launch_bounds__(NWAVES * 64, 2) mk_fwd(Args args) {
    extern __shared__ __attribute__((aligned(16))) unsigned char lds_raw[];
    LAS unsigned char* lds = (LAS unsigned char*)lds_raw;
    cg::grid_group grid = cg::this_grid();
    for (int u = threadIdx.x; u < (LDS_BYTES - 131072) / 4; u += NWAVES * 64) ((LAS unsigned*)(lds + 131072))[u] = 0u;
    __syncthreads();
    const XcdBarrier xbar = xcd_barrier_post((unsigned*)(args.ws + WS_CTL) + CW_BAR, (volatile LAS unsigned*)(lds + MISC_OFF) + 8);
    const int G = gridDim.x, bx = blockIdx.x, vcu = (G % 8 == 0) ? (bx % 8) * (G / 8) + bx / 8 : bx;
    const int NGW = G * NWAVES;
#define TID_VARS const int tid = opq(threadIdx.x), lane = tid & 63, wave = __builtin_amdgcn_readfirstlane(tid >> 6), gw = vcu * NWAVES + wave; (void)gw; (void)lane
    unsigned char* ws = args.ws;
    float* X = args.out;
    pg8::ss_t* SS = (pg8::ss_t*)(ws + WS_SS); float* LSE = (float*)(ws + WS_LSE);
    bf16* XB = (bf16*)(ws + WS_XB); bf16* ACT = (bf16*)(ws + WS_ACT); bf16* OG = (bf16*)(ws + WS_OG); bf16* MG = (bf16*)(ws + WS_MG);
    const int lo = args.ph_lo, hi = args.ph_hi;
    int ph = 0;
#define PH_ON (ph >= lo && ph < hi)
#define GRID_BAR() do { asm volatile("s_waitcnt vmcnt(0)" ::: "memory"); grid.sync(); __builtin_amdgcn_fence(__ATOMIC_ACQUIRE, "agent"); asm volatile("s_waitcnt vmcnt(0)" ::: "memory"); } while (0)
#ifdef DUP_BAR
#define PH_END do { if (PH_ON && ph + 1 < hi) { GRID_BAR(); GRID_BAR(); } ++ph; } while (0)
#else
#define PH_END do { if (PH_ON && ph + 1 < hi) { if (ph == 0) GRID_BAR(); else xcd_barrier(xbar); } ++ph; } while (0)
#endif
#define MAKE_LW(lw, L) LayerW lw; { const int L_ = (L), i_ = L_ >> 1; lw.even = !(L_ & 1); \
        lw.gu1 = args.in[2] + (size_t)L_ * D * 2 * FF; lw.d1 = args.in[3] + (size_t)L_ * FF * D; lw.gu2 = args.in[6] + (size_t)L_ * D * 2 * FF; lw.d2 = args.in[7] + (size_t)L_ * FF * D; \
        lw.g1 = args.in[1] + L_ * D; lw.gm = args.in[4] + L_ * D; lw.g2 = args.in[5] + L_ * D; \
        lw.mi = lw.even ? args.in[8] + (size_t)i_ * D * NIN_CONV : args.in[15] + (size_t)i_ * D * NQKV; lw.mo = lw.even ? args.in[14] + (size_t)i_ * D * D : args.in[16] + (size_t)i_ * D * D; }

    if (PH_ON) {
        TID_VARS;
        const float* x = args.in[0];
        for (int m = gw; m < M; m += NGW) { const f32x4* xr = (const f32x4*)(x + (size_t)m * D) + lane; f32x4 v[4]; float s = 0.f;
#pragma unroll
            for (int j = 0; j < 4; ++j) { v[j] = xr[64 * j]; s += (v[j].x * v[j].x + v[j].y * v[j].y) + (v[j].z * v[j].z + v[j].w * v[j].w); }
            s = wave_sum(s);
            f32x4* xo = (f32x4*)(X + (size_t)m * D) + lane; v2u* bo = (v2u*)(XB + (size_t)m * D) + lane;
#pragma unroll
            for (int j = 0; j < 4; ++j) { xo[64 * j] = v[j]; v2u w; w.x = pk2(v[j].x, v[j].y); w.y = pk2(v[j].z, v[j].w); bo[64 * j] = w; }
            if (lane == 0) SS[m] = (pg8::ss_t)(s * pg8::SS_SCALE); }
        MAKE_LW(lw, 0); convert_layer(lw, (bf16*)(ws + WS_W), lds, gw, NGW, wave, lane);
    }
    PH_END;

    for (int sb = 0; sb < 3 * DEPTH; ++sb) {
        const int L = sb / 3, kind = sb % 3, even = !(L & 1);
        bf16* WB = (bf16*)(ws + WS_W + (size_t)(L & 1) * W_STRIDE);
        pg8::ss_t* ss_in = SS + (size_t)sb * M; pg8::ss_t* ss_out = SS + (size_t)(sb + 1) * M;
        if (kind != 1) {
            if (PH_ON) { pg8::Gemm g{XB, WB + (kind ? OW_GU2 : OW_GU1), M, 2 * FF, D}; pg8::StaticOrder S; S.init(M, 2 * FF, G, bx);
                pg8::EpiSwiglu E{ACT, FF, ss_in};

#ifndef NO_G1
                pg8::gemm_phase<pg8::EpiSwiglu, pg8::StaticOrder, true, true>(lds, g, S, E);
#endif
            }
            PH_END;
            if (PH_ON) { pg8::Gemm g{ACT, WB + (kind ? OW_D2 : OW_D1), M, D, FF}; pg8::StaticOrder S; S.init(M, D, G, bx);
                pg8::EpiResid E{X, XB, ss_out, 0.5f};
#ifndef NO_G2
                pg8::gemm_phase<pg8::EpiResid, pg8::StaticOrder, true, true>(lds, g, S, E);
#endif
            }
            PH_END;
        } else {
            const int nmi = even ? NIN_CONV : NQKV;
            if (PH_ON) { pg8::Gemm g{XB, WB + OW_MI, M, nmi, D}; pg8::StaticOrder S; S.init(M, nmi, G, bx);
                pg8::EpiScale E{ACT, nmi, ss_in};

#ifndef NO_G3
                pg8::gemm_phase<pg8::EpiScale, pg8::StaticOrder, true, true>(lds, g, S, E);
#endif
            }
            PH_END;
            if (PH_ON) {
                const int i = L >> 1;
                if (even) {
#ifndef NO_CONV
                    conv_phase(lds, ACT, OG, args.in[9] + i * 3 * 512, args.in[10] + i * 31 * 512, args.in[11] + i * 512, args.in[12] + i * 512, args.in[13] + i * 512, G, vcu);
#endif
#ifdef DUP_CONV
                    __syncthreads(); conv_phase(lds, ACT, OG, args.in[9] + i * 3 * 512, args.in[10] + i * 31 * 512, args.in[11] + i * 512, args.in[12] + i * 512, args.in[13] + i * 512, G, vcu);
#endif
                } else {
#ifndef NO_ATT
                    attn_phase(lds, ACT, OG, LSE, G, vcu);
#endif
#ifdef DUP_ATT
                    __syncthreads(); attn_phase(lds, ACT, OG, LSE, G, vcu);
#endif
                }
                if (L + 1 < DEPTH) { __syncthreads(); TID_VARS; MAKE_LW(lw, L + 1); convert_layer(lw, (bf16*)(ws + WS_W + (size_t)((L + 1) & 1) * W_STRIDE), lds, gw, NGW, wave, lane);
#ifdef DUP_CVT
                    convert_layer(lw, (bf16*)(ws + WS_W + (size_t)((L + 1) & 1) * W_STRIDE), lds, gw, NGW, wave, lane);
#endif
                }
            }
            PH_END;
            if (!even) { if (PH_ON) merge_phase(OG, LSE, MG, G, vcu); PH_END; }
            if (PH_ON) { pg8::Gemm g{even ? OG : MG, WB + OW_MO, M, D, D}; pg8::StaticOrder S; S.init(M, D, G, bx);
                pg8::EpiResid E{X, XB, ss_out, 1.0f};
#ifndef NO_G4
                pg8::gemm_phase<pg8::EpiResid, pg8::StaticOrder, true, true>(lds, g, S, E);
#endif
            }
            PH_END;
        }
    }
    if (PH_ON) {
        TID_VARS;
        const float* gf = args.in[17]; const pg8::ss_t* ssf = SS + (size_t)12 * M;
        f32x4 gv[4];
#pragma unroll
        for (int j = 0; j < 4; ++j) gv[j] = ((const f32x4*)gf)[64 * j + lane];
        for (int m = gw; m < M; m += NGW) { f32x4* xr = (f32x4*)(X + (size_t)m * D) + lane; const float rs = pg8::rstd_of(ssf, m);
#pragma unroll
            for (int j = 0; j < 4; ++j) { const f32x4 v = xr[64 * j]; xr[64 * j] = v * rs * gv[j]; } }
    }
    ++ph;
}
constexpr int N_PHASES = 1 + 2 * (2 + 3 + 2) + 2 * (2 + 4 + 2) + 1;

extern "C" void kernel_launch(void* const* d_in, const int* in_sizes, int n_in, void* d_out, int out_size, void* d_ws, size_t ws_size, hipStream_t stream) {
    static int grid = 0;
    if (grid == 0) {
        if (n_in != 18 || in_sizes[0] != M * D || out_size != M * D || ws_size < WS_END) { fprintf(stderr, "kernel_launch: unexpected shapes (n_in %d, in0 %d, out %d, ws %zu)\n", n_in, n_in > 0 ? in_sizes[0] : -1, out_size, ws_size); grid = -1; return; }
        int dev = 0, cus = 0, per_cu = 0;
        hipGetDevice(&dev); hipDeviceGetAttribute(&cus, hipDeviceAttributeMultiprocessorCount, dev);
        if (hipFuncSetAttribute((const void*)mk_fwd, hipFuncAttributeMaxDynamicSharedMemorySize, LDS_BYTES) != hipSuccess) { fprintf(stderr, "kernel_launch: hipFuncSetAttribute failed\n"); grid = -1; return; }
        if (hipOccupancyMaxActiveBlocksPerMultiprocessor(&per_cu, (const void*)mk_fwd, NWAVES * 64, LDS_BYTES) != hipSuccess || per_cu < 1) { fprintf(stderr, "kernel_launch: occupancy query says %d\n", per_cu); per_cu = 1; }
        (void)hipGetLastError();
        grid = cus * (per_cu > 1 ? 1 : per_cu);
    }
    if (grid < 0) return;
    hipMemsetAsync((char*)d_ws + WS_CTL, 0, CTL_ZERO_BYTES, stream);
    Args a{};
    for (int i = 0; i < 18; ++i) a.in[i] = (const float*)d_in[i];
    a.out = (float*)d_out; a.ws = (unsigned char*)d_ws;
#if MK_N_LAUNCHES == 1
    a.ph_lo = 0; a.ph_hi = N_PHASES;
    void* kargs[] = {&a};
    hipError_t e = hipLaunchCooperativeKernel((const void*)mk_fwd, dim3(grid), dim3(NWAVES * 64), kargs, LDS_BYTES, stream);
    if (e != hipSuccess) fprintf(stderr, "kernel_launch: cooperative launch failed: %s (grid %d)\n", hipGetErrorString(e), grid);
#else
    for (int p = 0; p < N_PHASES; ++p) { a.ph_lo = p; a.ph_hi = p + 1; hipLaunchKernelGGL(mk_fwd, dim3(grid), dim3(NWAVES * 64), LDS_BYTES, stream, a); }
#endif
}
```

```cpp
#include <hip/hip_runtime.h>
#include <hip/hip_cooperative_groups.h>
#include <cstdio>
#include <cstdint>
namespace cg = cooperative_groups;
namespace pg8 {
#define PG8_LAS __attribute__((address_space(3)))
typedef unsigned short bf16_t;
typedef short bf16x8 __attribute__((ext_vector_type(8)));
typedef float f32x4 __attribute__((ext_vector_type(4)));
typedef unsigned u32x4 __attribute__((ext_vector_type(4)));
constexpr int BM = 256, BK = 64, HALF = 128, HTB = HALF * BK * 2  , STAGE_BYTES = 8 * HTB, NXCD = 8, WGM = 8;

__host__ __device__ __forceinline__ int lds_byte(int r, int c) { const int st = (r >> 4) * 2 + (c >> 5), rr = r & 15, cc = c & 31, ob = rr * 64 + cc * 2; return st * 1024 + (ob ^ (((ob >> 9) & 1) << 5)); }
__host__ __device__ __forceinline__ void stage_rc(int b, int& R, int& C) { const int st = b / 1024, sb = b % 1024, swz = sb ^ (((sb >> 9) & 1) << 5); R = (st >> 1) * 16 + swz / 64; C = (st & 1) * 32 + (swz % 64) / 2; }
__host__ __device__ __forceinline__ int perm32(int rho) { const int n = rho >> 4, i = rho & 15; return 8 * (i >> 2) + 4 * n + (i & 3); }

struct Unit { int pm, pn; };
struct Gemm { const bf16_t* A; const bf16_t* Bt; int M, N, K; };

struct StaticOrder {
    int nM, nN, nwg, G, c;
    __host__ __device__ void init(int M, int N, int G_, int c_) { nM = M / BM; nN = N / BM; nwg = nM * nN; G = G_; c = c_; }
    __host__ __device__ bool next(int i, Unit& u) const {
        const long L = (long)i * G + c; if (L >= nwg) return false;
        int wgid = (int)L; { const int q = nwg / NXCD, r = nwg % NXCD, xcd = wgid % NXCD, off = wgid / NXCD; wgid = (xcd < r ? xcd * (q + 1) : r * (q + 1) + (xcd - r) * q) + off; }
        const int nig = WGM * nN, gid = wgid / nig, fm = gid * WGM, gsz = (nM - fm) < WGM ? (nM - fm) : WGM;
        u.pm = fm + ((wgid % nig) % gsz); u.pn = (wgid % nig) / gsz; return true;
    }
    __device__ __forceinline__ void a_ready(const Unit&) const {}
    __device__ __forceinline__ void done(const Unit&) const {}
};

__device__ __forceinline__ unsigned cvt_pk_bf16(float lo, float hi) { unsigned r; asm volatile("v_cvt_pk_bf16_f32 %0, %1, %2" : "=v"(r) : "v"(lo), "v"(hi)); return r; }
typedef float f32x2 __attribute__((ext_vector_type(2)));
typedef unsigned long long ss_t;
constexpr float SS_SCALE = 1048576.0f;
__device__ __forceinline__ float rstd_of(const ss_t* ss, int row) { return __builtin_amdgcn_rsqf((float)ss[row] * (1.0f / (1024.0f * SS_SCALE)) + 1e-6f); }
struct EpiScale {
    static constexpr bool PERM = true, AFTER_DRAIN = false;
    bf16_t* O; int ldc; const ss_t* ss;
    __device__ __forceinline__ void operator()(const f32x4 (&acc)[2][2][4][2], const Unit& u, int wr, int wc, int fr, int fq) const {
        const int row0 = u.pm * BM + wr * 64 + fr, col0 = u.pn * BM + wc * 32 + 8 * fq;
#pragma unroll
        for (int ai = 0; ai < 2; ++ai)
#pragma unroll
            for (int m = 0; m < 4; ++m) { const int row = row0 + ai * HALF + m * 16; const float rs = rstd_of(ss, row); bf16_t* rowp = O + (size_t)row * ldc + col0;
#pragma unroll
                for (int bj = 0; bj < 2; ++bj) { const f32x4 v0 = acc[ai][bj][m][0] * rs, v1 = acc[ai][bj][m][1] * rs;
                    u32x4 w; w.x = cvt_pk_bf16(v0[0], v0[1]); w.y = cvt_pk_bf16(v0[2], v0[3]); w.z = cvt_pk_bf16(v1[0], v1[1]); w.w = cvt_pk_bf16(v1[2], v1[3]);
                    *(u32x4*)(rowp + bj * HALF) = w; }
                asm volatile("" ::: "memory"); }
    }
};
__device__ __forceinline__ float silu_mul(float g, float u) { const float e = __builtin_amdgcn_exp2f(g * -1.4426950408889634f); return g * u * __builtin_amdgcn_rcpf(1.0f + e); }
struct EpiSwiglu {
    static constexpr bool PERM = true, AFTER_DRAIN = false;
    bf16_t* H; int ldh; const ss_t* ss;
    __device__ __forceinline__ void operator()(const f32x4 (&acc)[2][2][4][2], const Unit& u, int wr, int wc, int fr, int fq) const {
        const int row0 = u.pm * BM + wr * 64 + fr, col0 = u.pn * HALF + wc * 32 + 8 * fq;
#pragma unroll
        for (int ai = 0; ai < 2; ++ai)
#pragma unroll
            for (int m = 0; m < 4; ++m) { const int row = row0 + ai * HALF + m * 16; const float rs = rstd_of(ss, row);
                const f32x4 g0 = acc[ai][0][m][0] * rs, g1 = acc[ai][0][m][1] * rs, u0 = acc[ai][1][m][0] * rs, u1 = acc[ai][1][m][1] * rs;
                u32x4 w; w.x = cvt_pk_bf16(silu_mul(g0[0], u0[0]), silu_mul(g0[1], u0[1])); w.y = cvt_pk_bf16(silu_mul(g0[2], u0[2]), silu_mul(g0[3], u0[3]));
                w.z = cvt_pk_bf16(silu_mul(g1[0], u1[0]), silu_mul(g1[1], u1[1])); w.w = cvt_pk_bf16(silu_mul(g1[2], u1[2]), silu_mul(g1[3], u1[3]));
                *(u32x4*)(H + (size_t)row * ldh + col0) = w; asm volatile("" ::: "memory"); }
    }
};
struct EpiResid {
    static constexpr bool PERM = true, AFTER_DRAIN = false;
    float* X; bf16_t* XB; ss_t* ssn; float alpha;
    __device__ __forceinline__ void operator()(const f32x4 (&acc)[2][2][4][2], const Unit& u, int wr, int wc, int fr, int fq) const {
        const int row0 = u.pm * BM + wr * 64 + fr, col0 = u.pn * BM + wc * 32 + 8 * fq;
#pragma unroll
        for (int ai = 0; ai < 2; ++ai)
#pragma unroll
            for (int m = 0; m < 4; ++m) { const int row = row0 + ai * HALF + m * 16; float* xp = X + (size_t)row * 1024 + col0; bf16_t* bp = XB + (size_t)row * 1024 + col0; float q = 0.f;
#pragma unroll
                for (int bj = 0; bj < 2; ++bj) { const f32x4 x0 = *(const f32x4*)(xp + bj * HALF), x1 = *(const f32x4*)(xp + bj * HALF + 4);
                    const f32x4 y0 = x0 + acc[ai][bj][m][0] * alpha, y1 = x1 + acc[ai][bj][m][1] * alpha;
                    *(f32x4*)(xp + bj * HALF) = y0; *(f32x4*)(xp + bj * HALF + 4) = y1;
                    u32x4 w; w.x = cvt_pk_bf16(y0[0], y0[1]); w.y = cvt_pk_bf16(y0[2], y0[3]); w.z = cvt_pk_bf16(y1[0], y1[1]); w.w = cvt_pk_bf16(y1[2], y1[3]);
                    *(u32x4*)(bp + bj * HALF) = w;
                    q += (y0[0] * y0[0] + y0[1] * y0[1]) + (y0[2] * y0[2] + y0[3] * y0[3]) + (y1[0] * y1[0] + y1[1] * y1[1]) + (y1[2] * y1[2] + y1[3] * y1[3]); }
                q += __shfl_xor(q, 16); q += __shfl_xor(q, 32);
                if (fq == 0) __hip_atomic_fetch_add(ssn + row, (ss_t)(q * SS_SCALE), __ATOMIC_RELAXED, __HIP_MEMORY_SCOPE_AGENT); asm volatile("" ::: "memory"); }
    }
};
template <class Epi, class Sched, bool ALIGN_EPI = false, bool SP2 = false>
__device__ __forceinline__ void gemm_phase(PG8_LAS unsigned char* lds, const Gemm g, const Sched& S, const Epi& E) {
    int tid = threadIdx.x; asm volatile("" : "+v"(tid)); const int wid = __builtin_amdgcn_readfirstlane(tid >> 6), lane = tid & 63, wr = wid >> 2, wc = wid & 3, fr = lane & 15, fq = lane >> 4;
    const int K = g.K, nt = K / BK;
    unsigned voffA[2], voffB[2];
#pragma unroll
    for (int i = 0; i < 2; ++i) { int R, C; stage_rc(tid * 16 + i * 8192, R, C); const int Rb = Epi::PERM ? ((R & ~31) + perm32(R & 31)) : R;
        voffA[i] = (unsigned)(R * K + C) * 2u; voffB[i] = (unsigned)(Rb * K + C) * 2u; }
    const size_t kstep = (size_t)(BK * 2);
    const size_t hstep = (size_t)HALF * K * 2;
    const size_t tstep = 2 * hstep;
    const unsigned ldsw = (unsigned)wid * 1024u;
    const int aoff = lds_byte(wr * 64 + fr, fq * 8), boff = lds_byte(wc * 32 + fr, fq * 8);
#define PG8_SA(b, h) (((b) * 2 + (h)) * HTB)
#define PG8_SB(b, h) ((4 + (b) * 2 + (h)) * HTB)
#define PG8_STAGE(bufoff, gbase, voff) do { _Pragma("unroll") for (int _i = 0; _i < 2; ++_i) \
        __builtin_amdgcn_global_load_lds((const unsigned*)((const char*)(gbase) + (voff)[_i]), (PG8_LAS unsigned*)(lds + (bufoff) + ldsw + _i * 8192), 16, 0, 0); } while (0)
#define PG8_LDA(dst, b, h) do { _Pragma("unroll") for (int m = 0; m < 4; ++m) _Pragma("unroll") for (int k = 0; k < 2; ++k) dst[m][k] = *(const PG8_LAS bf16x8*)(lds + PG8_SA(b, h) + aoff + m * 2048 + k * 1024); } while (0)
#define PG8_LDB(dst, b, h) do { _Pragma("unroll") for (int n = 0; n < 2; ++n) _Pragma("unroll") for (int k = 0; k < 2; ++k) dst[n][k] = *(const PG8_LAS bf16x8*)(lds + PG8_SB(b, h) + boff + n * 2048 + k * 1024); } while (0)
#define PG8_MMA(ai, bj, At, Bt) do { __builtin_amdgcn_s_setprio(1); _Pragma("unroll") for (int m = 0; m < 4; ++m) _Pragma("unroll") for (int n = 0; n < 2; ++n) _Pragma("unroll") for (int k = 0; k < 2; ++k) \
        acc[ai][bj][m][n] = __builtin_amdgcn_mfma_f32_16x16x32_bf16(Bt[n][k], At[m][k], acc[ai][bj][m][n], 0, 0, 0); __builtin_amdgcn_s_setprio(0); } while (0)
#define PG8_WAIT_V(n) asm volatile("s_waitcnt vmcnt(" #n ")" ::: "memory")
#define PG8_WAIT_L(n) asm volatile("s_waitcnt lgkmcnt(" #n ")" ::: "memory")
#define PG8_BAR __builtin_amdgcn_s_barrier()
#define PG8_SCHED __builtin_amdgcn_sched_barrier(0)
    Unit cur, nxt; int ui = 0;
    if (!S.next(0, cur)) return;
    f32x4 acc[2][2][4][2];
#pragma unroll
    for (int a = 0; a < 2; ++a)
#pragma unroll
        for (int b = 0; b < 2; ++b)
#pragma unroll
            for (int m = 0; m < 4; ++m)
#pragma unroll
                for (int n = 0; n < 2; ++n) acc[a][b][m][n] = (f32x4){0.f, 0.f, 0.f, 0.f};
    bf16x8 At[4][2], B0[2][2], B1[2][2];
    const char* cA = (const char*)g.A + (size_t)cur.pm * tstep; const char* cB = (const char*)g.Bt + (size_t)cur.pn * tstep;
    S.a_ready(cur);
    if constexpr (SP2) {
        PG8_STAGE(PG8_SB(0, 0), cB, voffB); PG8_STAGE(PG8_SB(0, 1), cB + hstep, voffB); PG8_STAGE(PG8_SA(0, 0), cA, voffA); PG8_STAGE(PG8_SA(0, 1), cA + hstep, voffA);
        if (wr == 1) PG8_BAR;
        PG8_WAIT_V(2); PG8_BAR;
        PG8_STAGE(PG8_SB(1, 0), cB + kstep, voffB); PG8_STAGE(PG8_SA(1, 0), cA + kstep, voffA); PG8_STAGE(PG8_SB(1, 1), cB + hstep + kstep, voffB);
        PG8_WAIT_V(6); PG8_BAR;
    } else {
        PG8_STAGE(PG8_SB(0, 0), cB, voffB); PG8_STAGE(PG8_SA(0, 0), cA, voffA); PG8_STAGE(PG8_SB(0, 1), cB + hstep, voffB); PG8_STAGE(PG8_SA(0, 1), cA + hstep, voffA);
        if (wr == 1) PG8_BAR;
        PG8_WAIT_V(4); PG8_BAR;
        PG8_STAGE(PG8_SB(1, 0), cB + kstep, voffB); PG8_STAGE(PG8_SA(1, 0), cA + kstep, voffA); PG8_STAGE(PG8_SB(1, 1), cB + hstep + kstep, voffB);
        PG8_WAIT_V(6); PG8_BAR;
    }
    for (;;) {
        const bool has_next = S.next(ui + 1, nxt);
        const char* nA = has_next ? (const char*)g.A + (size_t)nxt.pm * tstep : cA; const char* nB = has_next ? (const char*)g.Bt + (size_t)nxt.pn * tstep : cB;
        for (int t = 0; t < nt; t += 2) {
            const bool last = (t == nt - 2);
            const char* a1 = cA + (size_t)(t + 1) * kstep;
            const char* a2 = last ? nA : cA + (size_t)(t + 2) * kstep; const char* b2 = last ? nB : cB + (size_t)(t + 2) * kstep;
            const char* a3 = a2 + kstep; const char* b3 = b2 + kstep;
            if (last && has_next) S.a_ready(nxt);
            if constexpr (SP2) {
            PG8_LDB(B0, 0, 0); PG8_LDB(B1, 0, 1); PG8_SCHED; PG8_LDA(At, 0, 0); PG8_STAGE(PG8_SA(1, 1), a1 + hstep, voffA);
            PG8_WAIT_V(8); PG8_WAIT_L(0); PG8_BAR; PG8_MMA(0, 0, At, B0); PG8_MMA(0, 1, At, B1); PG8_BAR; PG8_SCHED;
            PG8_LDA(At, 0, 1); PG8_STAGE(PG8_SB(0, 0), b2, voffB); PG8_STAGE(PG8_SB(0, 1), b2 + hstep, voffB); PG8_STAGE(PG8_SA(0, 0), a2, voffA);
            PG8_WAIT_V(8); PG8_WAIT_L(0); PG8_BAR; PG8_MMA(1, 0, At, B0); PG8_MMA(1, 1, At, B1); PG8_BAR; PG8_SCHED;
            PG8_LDB(B0, 1, 0); PG8_LDB(B1, 1, 1); PG8_SCHED; PG8_LDA(At, 1, 0); PG8_STAGE(PG8_SA(0, 1), a2 + hstep, voffA);
            PG8_WAIT_V(8); PG8_WAIT_L(0); PG8_BAR; PG8_MMA(0, 0, At, B0); PG8_MMA(0, 1, At, B1); PG8_BAR; PG8_SCHED;
            PG8_LDA(At, 1, 1); PG8_STAGE(PG8_SB(1, 0), b3, voffB); PG8_STAGE(PG8_SB(1, 1), b3 + hstep, voffB); PG8_STAGE(PG8_SA(1, 0), a3, voffA);
            PG8_WAIT_V(8); PG8_WAIT_L(0); PG8_BAR; PG8_MMA(1, 0, At, B0); PG8_MMA(1, 1, At, B1); PG8_BAR; PG8_SCHED;
            } else {
            PG8_LDB(B0, 0, 0); PG8_SCHED; PG8_LDA(At, 0, 0); PG8_STAGE(PG8_SA(1, 1), a1 + hstep, voffA);
            PG8_WAIT_L(8); PG8_BAR; PG8_WAIT_L(0); PG8_MMA(0, 0, At, B0); PG8_BAR; PG8_SCHED;
            PG8_LDB(B1, 0, 1); PG8_STAGE(PG8_SB(0, 0), b2, voffB);
            PG8_BAR; PG8_WAIT_L(0); PG8_MMA(0, 1, At, B1); PG8_BAR;
            PG8_LDA(At, 0, 1); PG8_STAGE(PG8_SA(0, 0), a2, voffA);
            PG8_BAR; PG8_WAIT_L(0); PG8_MMA(1, 0, At, B0); PG8_BAR; PG8_SCHED;
            PG8_STAGE(PG8_SB(0, 1), b2 + hstep, voffB);
            PG8_WAIT_V(6); PG8_BAR; PG8_MMA(1, 1, At, B1); PG8_BAR;
            PG8_LDB(B0, 1, 0); PG8_SCHED; PG8_LDA(At, 1, 0); PG8_STAGE(PG8_SA(0, 1), a2 + hstep, voffA);
            PG8_WAIT_L(8); PG8_BAR; PG8_WAIT_L(0); PG8_MMA(0, 0, At, B0); PG8_BAR; PG8_SCHED;
            PG8_LDB(B1, 1, 1); PG8_STAGE(PG8_SB(1, 0), b3, voffB);
            PG8_BAR; PG8_WAIT_L(0); PG8_MMA(0, 1, At, B1); PG8_BAR;
            PG8_LDA(At, 1, 1); PG8_STAGE(PG8_SA(1, 0), a3, voffA);
            PG8_BAR; PG8_WAIT_L(0); PG8_MMA(1, 0, At, B0); PG8_BAR; PG8_SCHED;
            PG8_STAGE(PG8_SB(1, 1), b3 + hstep, voffB);
            PG8_WAIT_V(6); PG8_BAR; PG8_MMA(1, 1, At, B1); PG8_BAR;
            }
        }
        if constexpr (ALIGN_EPI) { if (wr == 0) PG8_BAR; }
        if constexpr (!Epi::AFTER_DRAIN) { E(acc, cur, wr, wc, fr, fq); S.done(cur); }
        if (!has_next) break;
#pragma unroll
        for (int a = 0; a < 2; ++a)
#pragma unroll
            for (int b = 0; b < 2; ++b)
#pragma unroll
                for (int m = 0; m < 4; ++m)
#pragma unroll
                    for (int n = 0; n < 2; ++n) acc[a][b][m][n] = (f32x4){0.f, 0.f, 0.f, 0.f};
        cur = nxt; cA = nA; cB = nB; ++ui;
        if constexpr (ALIGN_EPI) { if (wr == 1) PG8_BAR; }
    }
    PG8_WAIT_V(0);
    if constexpr (!ALIGN_EPI) { if (wr == 0) PG8_BAR; }
    PG8_BAR;
    if constexpr (Epi::AFTER_DRAIN) { E.fused(acc, cur, wr, wc, fr, fq, lds, wid, lane); S.done(cur); }
#undef PG8_SA
#undef PG8_SB
#undef PG8_STAGE
#undef PG8_LDA
#undef PG8_LDB
#undef PG8_MMA
#undef PG8_WAIT_V
#undef PG8_WAIT_L
#undef PG8_BAR
#undef PG8_SCHED
}
}

#ifndef MK_N_LAUNCHES
#define MK_N_LAUNCHES 1
#endif
constexpr int NWAVES = 8;
constexpr int BATCH = 2, SEQ = 8192, D = 1024, FF = 2816, M = BATCH * SEQ, DEPTH = 4;
constexpr int NIN_CONV = 2560, NQKV = 3072, NHEAD = 16;
constexpr size_t MiB = 1u << 20;
constexpr size_t WS_CTL = 0, CTL_ZERO_BYTES = 2 * MiB;
constexpr size_t WS_SS = 64 * 1024;
constexpr size_t WS_LSE = 2 * MiB;
constexpr size_t WS_W = 8 * MiB, W_STRIDE = 44 * MiB;
constexpr size_t WS_XB = 96 * MiB;
constexpr size_t WS_ACT = 128 * MiB;
constexpr size_t WS_OG = 224 * MiB;
constexpr size_t WS_MG = 320 * MiB;
constexpr size_t WS_END = 352 * MiB;
constexpr size_t OW_GU1 = 0, OW_D1 = OW_GU1 + (size_t)2 * FF * D, OW_MI = OW_D1 + (size_t)D * FF, OW_MO = OW_MI + (size_t)NQKV * D, OW_GU2 = OW_MO + (size_t)D * D, OW_D2 = OW_GU2 + (size_t)2 * FF * D, OW_END = OW_D2 + (size_t)D * FF;
static_assert(OW_END * 2 <= W_STRIDE, "weight buffer");
constexpr int LDS_BYTES = 147456;
constexpr int CW_BAR = 4096;
constexpr int MISC_OFF = 131072 + 320;

#define LAS __attribute__((address_space(3)))
typedef unsigned short bf16;
typedef unsigned v4u __attribute__((ext_vector_type(4)));
typedef unsigned v2u __attribute__((ext_vector_type(2)));
typedef float f32x4 __attribute__((ext_vector_type(4)));
typedef short bf16x8 __attribute__((ext_vector_type(8)));
typedef short s16x4 __attribute__((ext_vector_type(4)));
#define LDS_WAIT() asm volatile("s_waitcnt lgkmcnt(0)" ::: "memory")
__device__ __forceinline__ unsigned pk2(float lo, float hi) { return pg8::cvt_pk_bf16(lo, hi); }
__device__ __forceinline__ int opq(int x) { asm volatile("" : "+v"(x)); return x; }
__device__ __forceinline__ float bf_lo(unsigned u) { return __uint_as_float(u << 16); }
__device__ __forceinline__ float bf_hi(unsigned u) { return __uint_as_float(u & 0xffff0000u); }
__device__ __forceinline__ float wave_sum(float v) {
#pragma unroll
    for (int o = 1; o < 64; o <<= 1) v += __shfl_xor(v, o);
    return v;
}

__device__ __forceinline__ void cvt_item(const float* __restrict__ W, int K, int N, bf16* WT, int dst_row0, int k0, int n0, const float* __restrict__ g, float cs, LAS float* scr, int lane) {
    float wv[32];
#pragma unroll
    for (int i = 0; i < 32; ++i) { const int kk = 2 * i + (lane >> 5); wv[i] = W[(size_t)(k0 + kk) * N + n0 + (lane & 31)]; }
#pragma unroll
    for (int i = 0; i < 32; ++i) { const int kk = 2 * i + (lane >> 5); const float gk = g ? g[k0 + kk] * cs : cs; scr[kk * 33 + (lane & 31)] = wv[i] * gk; }
    LDS_WAIT(); asm volatile("" ::: "memory");
    const int c = lane & 7;
#pragma unroll
    for (int j = 0; j < 4; ++j) { const int n = (lane >> 3) + 8 * j; const LAS float* s = scr + (8 * c) * 33 + n;
        v4u o; o.x = pk2(s[0 * 33], s[1 * 33]); o.y = pk2(s[2 * 33], s[3 * 33]); o.z = pk2(s[4 * 33], s[5 * 33]); o.w = pk2(s[6 * 33], s[7 * 33]);
        *(v4u*)(WT + (size_t)(dst_row0 + n) * K + k0 + 8 * c) = o; }
    LDS_WAIT(); asm volatile("" ::: "memory");
}
struct LayerW { const float *gu1, *d1, *mi, *mo, *gu2, *d2, *g1, *gm, *g2; int even; };
__device__ __forceinline__ void convert_layer(const LayerW& w, bf16* WB, int part, LAS unsigned char* lds, int gw, int NGW, int wave, int lane) {
    LAS float* scr = (LAS float*)(lds + wave * 16384);
    const int nmi = w.even ? NIN_CONV : NQKV;
    const int I_GU = (D / 64) * (2 * FF / 32), I_D = (FF / 64) * (D / 32), I_MI = (D / 64) * (nmi / 32), I_MO = (D / 64) * (D / 32);
    const int NITEMS = part == 0 ? I_GU + I_D : I_GU + I_D + I_MI + I_MO;
    for (int it = gw; it < NITEMS; it += NGW) {
        int r = it;
        if (r < I_GU) { const int nblk = 2 * FF / 32, kb = r / nblk, nb = r % nblk, n0 = nb * 32;
            const int j0 = n0 < FF ? n0 : n0 - FF; const int dst = (j0 >> 7) * 256 + (n0 < FF ? 0 : 128) + (j0 & 127);
            cvt_item(part ? w.gu2 : w.gu1, D, 2 * FF, WB + (part ? OW_GU2 : OW_GU1), dst, kb * 64, n0, part ? w.g2 : w.g1, 1.0f, scr, lane); continue; }
        r -= I_GU;
        if (r < I_D) { const int nblk = D / 32, kb = r / nblk, nb = r % nblk;
            cvt_item(part ? w.d2 : w.d1, FF, D, WB + (part ? OW_D2 : OW_D1), nb * 32, kb * 64, nb * 32, nullptr, 1.0f, scr, lane); continue; }
        r -= I_D;
        if (r < I_MI) { const int nblk = nmi / 32, kb = r / nblk, nb = r % nblk, n0 = nb * 32;
            const float cs = (!w.even && n0 < D) ? 0.125f * 1.4426950408889634f : 1.0f;
            cvt_item(w.mi, D, nmi, WB + OW_MI, n0, kb * 64, n0, w.gm, cs, scr, lane); continue; }
        r -= I_MI;
        { const int nblk = D / 32, kb = r / nblk, nb = r % nblk; cvt_item(w.mo, D, D, WB + OW_MO, nb * 32, kb * 64, nb * 32, nullptr, 1.0f, scr, lane); }
    }
}

constexpr int KP = 144;
constexpr int ATT_K = 0, ATT_V = 272 * KP;
__device__ __forceinline__ void attn_phase(LAS unsigned char* lds, const bf16* __restrict__ QKV, bf16* OG, float* LSE, int G, int vcu) {
    const int tid = opq(threadIdx.x), lane = tid & 63, wid = __builtin_amdgcn_readfirstlane(tid >> 6), fr = lane & 15, fq = lane >> 4;
    const unsigned z1 = (unsigned)opq(0); const v4u zero4 = (v4u){z1, z1, z1, z1};
    for (int i = tid; i < 2 * 144; i += 512) { const int which = i / 144, c = i % 144; *(LAS v4u*)(lds + (which ? ATT_V : ATT_K) + 256 * KP + c * 16) = zero4; }
    const int total = 3 * BATCH * NHEAD * 64;
    const int per = (total + G - 1) / G, u_beg = vcu * per, u_end = (u_beg + per < total) ? u_beg + per : total;
    v4u kreg[4], vreg[4];
#define ATT_DECODE(u) const int g_ = (u) >> 11, rem_ = (u) & 2047, b_ = rem_ >> 10, h_ = (rem_ >> 6) & 15, rb_ = rem_ & 63, sh_ = 2 * g_, nl_ = 6 - sh_, r_ = rb_ >> nl_, n_ = rb_ & ((1 << nl_) - 1)
#define ATT_PREFETCH(u) do { ATT_DECODE(u); _Pragma("unroll") for (int i = 0; i < 4; ++i) { const int idx = tid + 512 * i, k = idx >> 3, ch = idx & 7; const int j = 128 * (n_ - 1) + k; \
        if (j >= 0) { const bf16* src = QKV + ((size_t)(b_ * SEQ + (j << sh_) + r_)) * NQKV + D + h_ * 64 + ch * 8; kreg[i] = *(const v4u*)src; vreg[i] = *(const v4u*)(src + D); } \
        else { kreg[i] = zero4; vreg[i] = zero4; } } } while (0)
    if (u_beg < u_end) ATT_PREFETCH(u_beg);
    for (int u = u_beg; u < u_end; ++u) {
        __syncthreads();
#pragma unroll
        for (int i = 0; i < 4; ++i) { const int idx = tid + 512 * i, k = idx >> 3, ch = idx & 7; *(LAS v4u*)(lds + ATT_K + k * KP + ch * 16) = kreg[i]; *(LAS v4u*)(lds + ATT_V + k * KP + ch * 16) = vreg[i]; }
        __syncthreads();
        ATT_DECODE(u);
        const int dil = 1 << sh_;
        const size_t qrow = (size_t)(b_ * SEQ + ((128 * n_ + 16 * wid + fr) << sh_) + r_);
        const bf16* qp = QKV + qrow * NQKV + h_ * 64 + fq * 8;
        const bf16x8 qf0 = *(const bf16x8*)qp, qf1 = *(const bf16x8*)(qp + 32);
        if (u + 1 < u_end) ATT_PREFETCH(u + 1);
        f32x4 s[10];
        const LAS unsigned char* kb = lds + ATT_K + (16 * wid + fr) * KP + fq * 16;
#pragma unroll
        for (int j = 0; j < 10; ++j) { const bf16x8 k0 = *(const LAS bf16x8*)(kb + j * 16 * KP), k1 = *(const LAS bf16x8*)(kb + j * 16 * KP + 64);
            f32x4 a = (f32x4){0.f, 0.f, 0.f, 0.f}; a = __builtin_amdgcn_mfma_f32_16x16x32_bf16(k0, qf0, a, 0, 0, 0); s[j] = __builtin_amdgcn_mfma_f32_16x16x32_bf16(k1, qf1, a, 0, 0, 0); }
        const float cb = __builtin_amdgcn_exp2f(-0.5f * (float)(h_ + 1)) * (float)dil * 1.4426950408889634f;
        const int kmin = (n_ > 0) ? 0 : 128;
        float mx = -1e30f;
#pragma unroll
        for (int j = 0; j < 10; ++j)
#pragma unroll
            for (int r = 0; r < 4; ++r) { const int rel = 128 + fr - 16 * j - 4 * fq - r, k = 16 * wid + 16 * j + 4 * fq + r; const bool ok = (rel >= 0) && (rel <= 128) && (k >= kmin);
                const float v = ok ? s[j][r] - cb * (float)rel : -1e30f; s[j][r] = v; mx = fmaxf(mx, v); }
        mx = fmaxf(mx, __shfl_xor(mx, 16)); mx = fmaxf(mx, __shfl_xor(mx, 32));
        float l = 0.f;
#pragma unroll
        for (int j = 0; j < 10; ++j)
#pragma unroll
            for (int r = 0; r < 4; ++r) { const float p = __builtin_amdgcn_exp2f(s[j][r] - mx); s[j][r] = p; l += p; }
        l += __shfl_xor(l, 16); l += __shfl_xor(l, 32);
        f32x4 o[4];
#pragma unroll
        for (int dt = 0; dt < 4; ++dt) o[dt] = (f32x4){0.f, 0.f, 0.f, 0.f};
        const LAS unsigned char* vb = lds + ATT_V + (16 * wid + 4 * fq + (fr >> 2)) * KP + (fr & 3) * 8;
#pragma unroll
        for (int gk = 0; gk < 5; ++gk) {
            v4u pw; pw.x = pk2(s[2 * gk][0], s[2 * gk][1]); pw.y = pk2(s[2 * gk][2], s[2 * gk][3]); pw.z = pk2(s[2 * gk + 1][0], s[2 * gk + 1][1]); pw.w = pk2(s[2 * gk + 1][2], s[2 * gk + 1][3]);
            const bf16x8 pb = __builtin_bit_cast(bf16x8, pw);
#pragma unroll
            for (int dt = 0; dt < 4; ++dt) {
                const s16x4 lo = __builtin_bit_cast(s16x4, __builtin_amdgcn_ds_read_tr16_b64_v4i16((LAS s16x4*)(vb + gk * 32 * KP + dt * 32)));
                const s16x4 hi = __builtin_bit_cast(s16x4, __builtin_amdgcn_ds_read_tr16_b64_v4i16((LAS s16x4*)(vb + gk * 32 * KP + 16 * KP + dt * 32)));
                const bf16x8 vf = (bf16x8){lo[0], lo[1], lo[2], lo[3], hi[0], hi[1], hi[2], hi[3]};
                o[dt] = __builtin_amdgcn_mfma_f32_16x16x32_bf16(vf, pb, o[dt], 0, 0, 0);
            }
        }
        const float il = __builtin_amdgcn_rcpf(l);
        bf16* op = OG + (size_t)g_ * M * D + qrow * D + h_ * 64 + 4 * fq;
#pragma unroll
        for (int dt = 0; dt < 4; ++dt) { v2u w; w.x = pk2(o[dt][0] * il, o[dt][1] * il); w.y = pk2(o[dt][2] * il, o[dt][3] * il); *(v2u*)(op + dt * 16) = w; }
        if (fq == 0) LSE[(size_t)g_ * M * NHEAD + qrow * NHEAD + h_] = mx + __builtin_amdgcn_logf(l);
    }
#undef ATT_DECODE
#undef ATT_PREFETCH
}
__device__ __forceinline__ void merge_phase(const bf16* __restrict__ OG, const float* __restrict__ LSE, bf16* MG, int G, int bid) {
    const size_t nth = (size_t)G * 512;
    const int tid = opq(threadIdx.x);
    for (size_t idx = (size_t)bid * 512 + tid; idx < (size_t)M * 128; idx += nth) {
        const size_t row = idx >> 7; const int c = (int)(idx & 127), h = c >> 3;
        const float l0 = LSE[row * NHEAD + h], l1 = LSE[(size_t)M * NHEAD + row * NHEAD + h], l2 = LSE[(size_t)2 * M * NHEAD + row * NHEAD + h];
        const float mx = fmaxf(l0, fmaxf(l1, l2));
        float w0 = __builtin_amdgcn_exp2f(l0 - mx), w1 = __builtin_amdgcn_exp2f(l1 - mx), w2 = __builtin_amdgcn_exp2f(l2 - mx);
        const float inv = __builtin_amdgcn_rcpf(w0 + w1 + w2); w0 *= inv; w1 *= inv; w2 *= inv;
        const v4u a = *(const v4u*)(OG + row * D + c * 8), b = *(const v4u*)(OG + (size_t)M * D + row * D + c * 8), cc = *(const v4u*)(OG + (size_t)2 * M * D + row * D + c * 8);
        v4u o;
#pragma unroll
        for (int i = 0; i < 4; ++i) o[i] = pk2(w0 * bf_lo(a[i]) + w1 * bf_lo(b[i]) + w2 * bf_lo(cc[i]), w0 * bf_hi(a[i]) + w1 * bf_hi(b[i]) + w2 * bf_hi(cc[i]));
        *(v4u*)(MG + row * D + c * 8) = o;
    }
}

__device__ __forceinline__ float sigmoidf_(float x) { return __builtin_amdgcn_rcpf(1.0f + __builtin_amdgcn_exp2f(x * -1.4426950408889634f)); }
__device__ __forceinline__ void conv_phase(LAS unsigned char* lds, const bf16* __restrict__ Z, bf16* CAT, const float* __restrict__ wa, const float* __restrict__ wb, const float* __restrict__ bias,
                                           const float* __restrict__ lng, const float* __restrict__ lnb, int G, int vcu) {
    const int tid = opq(threadIdx.x), lane = tid & 63, wid = __builtin_amdgcn_readfirstlane(tid >> 6), cp = tid & 255, th = tid >> 8;
    LAS float* red = (LAS float*)(lds + 62 * 1024);
    const unsigned z1 = (unsigned)opq(0); const v4u zero4 = (v4u){z1, z1, z1, z1};
    float w0[31], w1[31];
#pragma unroll
    for (int k = 0; k < 31; ++k) { const v2u w = *(const v2u*)(wb + k * 512 + 2 * cp); w0[k] = __uint_as_float(w.x); w1[k] = __uint_as_float(w.y); }
    for (int unit = vcu; unit < M / 32; unit += G) {
        const int row0 = unit * 32, s0 = row0 & (SEQ - 1);
        __syncthreads();
#pragma unroll 1
        for (int hb = 0; hb < 2; ++hb) { v4u bv[4], bg[4];
#pragma unroll
          for (int i = 0; i < 4; ++i) { const int it = tid + 512 * (4 * hb + i), lr = it >> 6, ch = it & 63; bv[i] = zero4; bg[i] = zero4;
              if (it < 62 * 64 && s0 - 30 + lr >= 0) { const bf16* zp = Z + (size_t)(row0 - 30 + lr) * NIN_CONV + 1536 + ch * 8; bv[i] = *(const v4u*)zp; bg[i] = *(const v4u*)(zp + 512); } }
#pragma unroll
          for (int i = 0; i < 4; ++i) { const int it = tid + 512 * (4 * hb + i), lr = it >> 6, ch = it & 63; v4u o;
#pragma unroll
              for (int e = 0; e < 4; ++e) o[e] = pk2(bf_lo(bv[i][e]) * sigmoidf_(bf_lo(bg[i][e])), bf_hi(bv[i][e]) * sigmoidf_(bf_hi(bg[i][e])));
              if (it < 62 * 64) *(LAS v4u*)(lds + lr * 1024 + ch * 16) = o; } }
        __syncthreads();
        float acc[16][2];
        { const v2u b = *(const v2u*)(bias + 2 * cp); const float b0 = __uint_as_float(b.x), b1 = __uint_as_float(b.y);
#pragma unroll
          for (int t = 0; t < 16; ++t) { acc[t][0] = b0; acc[t][1] = b1; } }
        const LAS unsigned char* up = lds + (th * 16) * 1024 + cp * 4;
#pragma unroll
        for (int j = 0; j < 46; ++j) { const unsigned uu = *(const LAS unsigned*)(up + j * 1024); const float ul = bf_lo(uu), uh = bf_hi(uu);
#pragma unroll
            for (int t = 0; t < 16; ++t) { const int k = j - t; if (k >= 0 && k < 31) { acc[t][0] += w0[k] * ul; acc[t][1] += w1[k] * uh; } } }
#pragma unroll
        for (int t = 0; t < 16; ++t) { const float s1 = wave_sum(acc[t][0] + acc[t][1]), s2 = wave_sum(acc[t][0] * acc[t][0] + acc[t][1] * acc[t][1]);
            if (lane == 0) { red[(wid * 16 + t) * 2] = s1; red[(wid * 16 + t) * 2 + 1] = s2; } }
        __syncthreads();
        { const float g0 = lng[2 * cp], g1 = lng[2 * cp + 1], c0 = lnb[2 * cp], c1 = lnb[2 * cp + 1];
#pragma unroll
          for (int t = 0; t < 16; ++t) { float s1 = 0.f, s2 = 0.f;
#pragma unroll
              for (int w = 0; w < 4; ++w) { s1 += red[((th * 4 + w) * 16 + t) * 2]; s2 += red[((th * 4 + w) * 16 + t) * 2 + 1]; }
              const float mean = s1 * (1.0f / 512.0f), var = fmaxf(s2 * (1.0f / 512.0f) - mean * mean, 0.f), rstd = __builtin_amdgcn_rsqf(var + 1e-5f);
              const float y0 = (acc[t][0] - mean) * rstd * g0 + c0, y1 = (acc[t][1] - mean) * rstd * g1 + c1;
              *(unsigned*)(CAT + (size_t)(row0 + th * 16 + t) * D + 512 + 2 * cp) = pk2(y0 * sigmoidf_(y0), y1 * sigmoidf_(y1)); } }
        { const float a00 = wa[2 * cp], a01 = wa[2 * cp + 1], a10 = wa[512 + 2 * cp], a11 = wa[512 + 2 * cp + 1], a20 = wa[1024 + 2 * cp], a21 = wa[1024 + 2 * cp + 1];
          unsigned zc[18], zx[18], zb[16];
#pragma unroll
          for (int t = -2; t < 16; ++t) { const int s = s0 + th * 16 + t; const bf16* zp = Z + (size_t)(row0 + th * 16 + t) * NIN_CONV + 2 * cp; zc[t + 2] = 0u; zx[t + 2] = 0u;
              if (s >= 0) { zc[t + 2] = *(const unsigned*)(zp + 512); zx[t + 2] = *(const unsigned*)(zp + 1024); }
              if (t >= 0) zb[t] = *(const unsigned*)zp; }
          float p2x = 0.f, p2y = 0.f, p1x = 0.f, p1y = 0.f;
#pragma unroll
          for (int t = -2; t < 16; ++t) { const float px = bf_lo(zc[t + 2]) * bf_lo(zx[t + 2]), py = bf_hi(zc[t + 2]) * bf_hi(zx[t + 2]);
              if (t >= 0) { const float y0 = bf_lo(zb[t]) * (a00 * p2x + a10 * p1x + a20 * px), y1 = bf_hi(zb[t]) * (a01 * p2y + a11 * p1y + a21 * py);
                  *(unsigned*)(CAT + (size_t)(row0 + th * 16 + t) * D + 2 * cp) = pk2(y0, y1); }
              p2x = p1x; p2y = p1y; p1x = px; p1y = py; } }
    }
}

typedef __attribute__((address_space(1))) unsigned gu32;
#define XB_TMO      128
#define XB_XCNT(j)  (256  + 64 * (j))
#define XB_XSUB(j)  (1280 + 64 * (j))
#define XB_XGEN(j)  (2304 + 64 * (j))
#define XB_TOP      3328
#define XB_TOPGEN   3392
#define XCD_BAR_WORDS 3456
#define XB_SPIN_CAP (1u << 18)

__device__ __forceinline__ unsigned xb_ld(unsigned* p)              { return __hip_atomic_load(p, __ATOMIC_RELAXED, __HIP_MEMORY_SCOPE_AGENT); }
__device__ __forceinline__ unsigned xb_add(unsigned* p, unsigned v) { return __hip_atomic_fetch_add(p, v, __ATOMIC_RELAXED, __HIP_MEMORY_SCOPE_AGENT); }
__device__ __forceinline__ unsigned xb_xcc_id() { return (unsigned)__builtin_amdgcn_s_getreg((3 << 11) | 20) & 0xFu; }
#define XB_SPIN(cond, bar) do { unsigned _sp = 0; while (cond) { __builtin_amdgcn_s_sleep(1); \
    if ((++_sp & 255u) == 0u) { if (xb_ld(&(bar)[XB_TMO])) break; if (_sp > XB_SPIN_CAP) { atomicAdd(&(bar)[XB_TMO], 1u); break; } } } } while (0)

struct XcdBarrier {
    unsigned* bar; unsigned x;
    volatile LAS unsigned* st;
};

__device__ __forceinline__ XcdBarrier xcd_barrier_post(unsigned* bar, volatile LAS unsigned* st) {
    XcdBarrier b; b.bar = bar; b.x = xb_xcc_id(); b.st = st;
    if (threadIdx.x == 0) (void)xb_add(&bar[XB_XCNT(b.x)], 1u);
    return b;
}
__device__ __forceinline__ void xcd_barrier_complete(unsigned* bar, unsigned x, unsigned& nloc, unsigned& nx) {
    const unsigned G = gridDim.x * gridDim.y * gridDim.z;
    unsigned sum, cnt, mine, sp = 0u;
    for (;;) {
        sum = 0u; cnt = 0u; mine = 0u;
#pragma unroll
        for (unsigned j = 0; j < 16; ++j) { const unsigned c = xb_ld(&bar[XB_XCNT(j)]); sum += c; cnt += (c > 0u) ? 1u : 0u; mine = (j == x) ? c : mine; }
        if (sum == G) break;
        __builtin_amdgcn_s_sleep(1);
        if ((++sp & 255u) == 0u) { if (xb_ld(&bar[XB_TMO])) break; if (sp > XB_SPIN_CAP) { atomicAdd(&bar[XB_TMO], 1u); break; } }
    }
    nloc = mine > 0u ? mine : 1u; nx = cnt > 0u ? cnt : 1u;
}

__device__ __forceinline__ void xcd_barrier(const XcdBarrier& b) {
    asm volatile("s_waitcnt vmcnt(0)" ::: "memory");
    __syncthreads();
    if (threadIdx.x == 0) {
        unsigned* bar = b.bar;
        __builtin_amdgcn_s_waitcnt(0);
        unsigned nloc = b.st[0], nx = b.st[1];
        if (nloc == 0u) { xcd_barrier_complete(bar, b.x, nloc, nx); b.st[0] = nloc; b.st[1] = nx; }
        const unsigned old = xb_add(&bar[XB_XSUB(b.x)], 1u);
        const unsigned gen = old / nloc;
        if (old + 1u == (gen + 1u) * nloc) {
            __builtin_amdgcn_fence(__ATOMIC_RELEASE, "agent");
            asm volatile("s_waitcnt vmcnt(0)" ::: "memory");
            const unsigned og = xb_add(&bar[XB_TOP], 1u);
            const unsigned tg = og / nx;
            if (og + 1u == (tg + 1u) * nx) xb_add(&bar[XB_TOPGEN], 1u);
            else XB_SPIN(xb_ld(&bar[XB_TOPGEN]) == tg, bar);
            __builtin_amdgcn_fence(__ATOMIC_ACQUIRE, "agent");
            xb_add(&bar[XB_XGEN(b.x)], 1u);
            asm volatile("s_waitcnt vmcnt(0)" ::: "memory");
        } else {
            XB_SPIN(xb_ld(&bar[XB_XGEN(b.x)]) == gen, bar);
            __builtin_amdgcn_fence(__ATOMIC_ACQUIRE, "agent");
            asm volatile("s_waitcnt vmcnt(0)" ::: "memory");
        }
    }
    __syncthreads();
}

struct Args { const float* in[18]; float* out; unsigned char* ws; int ph_lo, ph_hi; };
__global__ void __launch_bounds__(NWAVES * 64, 2) mk_fwd(Args args) {
    extern __shared__ __attribute__((aligned(16))) unsigned char lds_raw[];
    LAS unsigned char* lds = (LAS unsigned char*)lds_raw;
    cg::grid_group grid = cg::this_grid();
    for (int u = threadIdx.x; u < (LDS_BYTES - 131072) / 4; u += NWAVES * 64) ((LAS unsigned*)(lds + 131072))[u] = 0u;
    __syncthreads();
    const XcdBarrier xbar = xcd_barrier_post((unsigned*)(args.ws + WS_CTL) + CW_BAR, (volatile LAS unsigned*)(lds + MISC_OFF) + 8);
    const int G = gridDim.x, bx = blockIdx.x, vcu = (G % 8 == 0) ? (bx % 8) * (G / 8) + bx / 8 : bx;
    const int NGW = G * NWAVES;
#define TID_VARS const int tid = opq(threadIdx.x), lane = tid & 63, wave = __builtin_amdgcn_readfirstlane(tid >> 6), gw = vcu * NWAVES + wave; (void)gw; (void)lane
    unsigned char* ws = args.ws;
    float* X = args.out;
    pg8::ss_t* SS = (pg8::ss_t*)(ws + WS_SS); float* LSE = (float*)(ws + WS_LSE);
    bf16* XB = (bf16*)(ws + WS_XB); bf16* ACT = (bf16*)(ws + WS_ACT); bf16* OG = (bf16*)(ws + WS_OG); bf16* MG = (bf16*)(ws + WS_MG);
    const int lo = args.ph_lo, hi = args.ph_hi;
    int ph = 0;
#define PH_ON (ph >= lo && ph < hi)
#define GRID_BAR() do { asm volatile("s_waitcnt vmcnt(0)" ::: "memory"); grid.sync(); __builtin_amdgcn_fence(__ATOMIC_ACQUIRE, "agent"); asm volatile("s_waitcnt vmcnt(0)" ::: "memory"); } while (0)
#ifdef DUP_BAR
#define PH_END do { if (PH_ON && ph + 1 < hi) { GRID_BAR(); GRID_BAR(); } ++ph; } while (0)
#else
#define PH_END do { if (PH_ON && ph + 1 < hi) { if (ph == 0) GRID_BAR(); else xcd_barrier(xbar); } ++ph; } while (0)
#endif
#define MAKE_LW(lw, L) LayerW lw; { const int L_ = (L), i_ = L_ >> 1; lw.even = !(L_ & 1); \
        lw.gu1 = args.in[2] + (size_t)L_ * D * 2 * FF; lw.d1 = args.in[3] + (size_t)L_ * FF * D; lw.gu2 = args.in[6] + (size_t)L_ * D * 2 * FF; lw.d2 = args.in[7] + (size_t)L_ * FF * D; \
        lw.g1 = args.in[1] + L_ * D; lw.gm = args.in[4] + L_ * D; lw.g2 = args.in[5] + L_ * D; \
        lw.mi = lw.even ? args.in[8] + (size_t)i_ * D * NIN_CONV : args.in[15] + (size_t)i_ * D * NQKV; lw.mo = lw.even ? args.in[14] + (size_t)i_ * D * D : args.in[16] + (size_t)i_ * D * D; }

    if (PH_ON) {
        TID_VARS;
        const float* x = args.in[0];
        for (int m = gw; m < M; m += NGW) { const f32x4* xr = (const f32x4*)(x + (size_t)m * D) + lane; f32x4 v[4]; float s = 0.f;
#pragma unroll
            for (int j = 0; j < 4; ++j) { v[j] = xr[64 * j]; s += (v[j].x * v[j].x + v[j].y * v[j].y) + (v[j].z * v[j].z + v[j].w * v[j].w); }
            s = wave_sum(s);
            f32x4* xo = (f32x4*)(X + (size_t)m * D) + lane; v2u* bo = (v2u*)(XB + (size_t)m * D) + lane;
#pragma unroll
            for (int j = 0; j < 4; ++j) { xo[64 * j] = v[j]; v2u w; w.x = pk2(v[j].x, v[j].y); w.y = pk2(v[j].z, v[j].w); bo[64 * j] = w; }
            if (lane == 0) SS[m] = (pg8::ss_t)(s * pg8::SS_SCALE); }
        MAKE_LW(lw, 0); convert_layer(lw, (bf16*)(ws + WS_W), 0, lds, gw, NGW, wave, lane);
    }
    PH_END;

    for (int sb = 0; sb < 3 * DEPTH; ++sb) {
        const int L = sb / 3, kind = sb % 3, even = !(L & 1);
        bf16* WB = (bf16*)(ws + WS_W + (size_t)(L & 1) * W_STRIDE);
        pg8::ss_t* ss_in = SS + (size_t)sb * M; pg8::ss_t* ss_out = SS + (size_t)(sb + 1) * M;
        if (kind != 1) {
            if (PH_ON) { pg8::Gemm g{XB, WB + (kind ? OW_GU2 : OW_GU1), M, 2 * FF, D}; pg8::StaticOrder S; S.init(M, 2 * FF, G, bx);
                pg8::EpiSwiglu E{ACT, FF, ss_in};

#ifndef NO_G1
                pg8::gemm_phase<pg8::EpiSwiglu, pg8::StaticOrder, true, true>(lds, g, S, E);
#endif
#ifdef DUP_G1
                xcd_barrier(xbar); pg8::gemm_phase<pg8::EpiSwiglu, pg8::StaticOrder, true, true>(lds, g, S, E);
#endif
                { const int nwg = (M / 256) * (2 * FF / 256), ntail = nwg % G, cl = (kind == 0) ? L : L + 1;
                  if (ntail > 0 && bx >= ntail && cl < DEPTH) { TID_VARS; MAKE_LW(lw, cl);
                      convert_layer(lw, (bf16*)(ws + WS_W + (size_t)(cl & 1) * W_STRIDE), kind == 0 ? 1 : 0, lds, (bx - ntail) * NWAVES + wave, (G - ntail) * NWAVES, wave, lane); }
                  else if (ntail == 0 && cl < DEPTH) { TID_VARS; MAKE_LW(lw, cl); convert_layer(lw, (bf16*)(ws + WS_W + (size_t)(cl & 1) * W_STRIDE), kind == 0 ? 1 : 0, lds, gw, NGW, wave, lane); } }
            }
            PH_END;
            if (PH_ON) { pg8::Gemm g{ACT, WB + (kind ? OW_D2 : OW_D1), M, D, FF}; pg8::StaticOrder S; S.init(M, D, G, bx);
                pg8::EpiResid E{X, XB, ss_out, 0.5f};
#ifndef NO_G2
                pg8::gemm_phase<pg8::EpiResid, pg8::StaticOrder, true, true>(lds, g, S, E);
#endif
#ifdef DUP_G2
                xcd_barrier(xbar); { pg8::EpiResid E2{X, XB, SS + (size_t)13 * M, 0.0f}; pg8::gemm_phase<pg8::EpiResid, pg8::StaticOrder, true, true>(lds, g, S, E2); }
#endif
            }
            PH_END;
        } else {
            const int nmi = even ? NIN_CONV : NQKV;
            if (PH_ON) { pg8::Gemm g{XB, WB + OW_MI, M, nmi, D}; pg8::StaticOrder S; S.init(M, nmi, G, bx);
                pg8::EpiScale E{ACT, nmi, ss_in};

#ifndef NO_G3
                pg8::gemm_phase<pg8::EpiScale, pg8::StaticOrder, true, true>(lds, g, S, E);
#endif
            }
            PH_END;
            if (PH_ON) {
                const int i = L >> 1;
                if (even) {
#ifndef NO_CONV
                    conv_phase(lds, ACT, OG, args.in[9] + i * 3 * 512, args.in[10] + i * 31 * 512, args.in[11] + i * 512, args.in[12] + i * 512, args.in[13] + i * 512, G, vcu);
#endif
#ifdef DUP_CONV
                    __syncthreads(); conv_phase(lds, ACT, OG, args.in[9] + i * 3 * 512, args.in[10] + i * 31 * 512, args.in[11] + i * 512, args.in[12] + i * 512, args.in[13] + i * 512, G, vcu);
#endif
                } else {
#ifndef NO_ATT
                    attn_phase(lds, ACT, OG, LSE, G, vcu);
#endif
#ifdef DUP_ATT
                    __syncthreads(); attn_phase(lds, ACT, OG, LSE, G, vcu);
#endif
                }
            }
            PH_END;
            if (!even) { if (PH_ON) merge_phase(OG, LSE, MG, G, vcu); PH_END; }
            if (PH_ON) { pg8::Gemm g{even ? OG : MG, WB + OW_MO, M, D, D}; pg8::StaticOrder S; S.init(M, D, G, bx);
                pg8::EpiResid E{X, XB, ss_out, 1.0f};
#ifndef NO_G4
                pg8::gemm_phase<pg8::EpiResid, pg8::StaticOrder, true, true>(lds, g, S, E);
#endif
            }
            PH_END;
        }
    }
    if (PH_ON) {
        TID_VARS;
        const float* gf = args.in[17]; const pg8::ss_t* ssf = SS + (size_t)12 * M;
        f32x4 gv[4];
#pragma unroll
        for (int j = 0; j < 4; ++j) gv[j] = ((const f32x4*)gf)[64 * j + lane];
        for (int m = gw; m < M; m += NGW) { f32x4* xr = (f32x4*)(X + (size_t)m * D) + lane; const float rs = pg8::rstd_of(ssf, m);
#pragma unroll
            for (int j = 0; j < 4; ++j) { const f32x4 v = xr[64 * j]; xr[64 * j] = v * rs * gv[j]; } }
    }
    ++ph;
}
constexpr int N_PHASES = 1 + 2 * (2 + 3 + 2) + 2 * (2 + 4 + 2) + 1;

extern "C" void kernel_launch(void* const* d_in, const int* in_sizes, int n_in, void* d_out, int out_size, void* d_ws, size_t ws_size, hipStream_t stream) {
    static int grid = 0;
    if (grid == 0) {
        if (n_in != 18 || in_sizes[0] != M * D || out_size != M * D || ws_size < WS_END) { fprintf(stderr, "kernel_launch: unexpected shapes (n_in %d, in0 %d, out %d, ws %zu)\n", n_in, n_in > 0 ? in_sizes[0] : -1, out_size, ws_size); grid = -1; return; }
        int dev = 0, cus = 0, per_cu = 0;
        hipGetDevice(&dev); hipDeviceGetAttribute(&cus, hipDeviceAttributeMultiprocessorCount, dev);
        if (hipFuncSetAttribute((const void*)mk_fwd, hipFuncAttributeMaxDynamicSharedMemorySize, LDS_BYTES) != hipSuccess) { fprintf(stderr, "kernel_launch: hipFuncSetAttribute failed\n"); grid = -1; return; }
        if (hipOccupancyMaxActiveBlocksPerMultiprocessor(&per_cu, (const void*)mk_fwd, NWAVES * 64, LDS_BYTES) != hipSuccess || per_cu < 1) { fprintf(stderr, "kernel_launch: occupancy query says %d\n", per_cu); per_cu = 1; }
        (void)hipGetLastError();
        grid = cus * (per_cu > 1 ? 1 : per_cu);
    }
    if (grid < 0) return;
    hipMemsetAsync((char*)d_ws + WS_CTL, 0, CTL_ZERO_BYTES, stream);
    Args a{};
    for (int i = 0; i < 18; ++i) a.in[i] = (const float*)d_in[i];
    a.out = (float*)d_out; a.ws = (unsigned char*)d_ws;
#if MK_N_LAUNCHES == 1
    a.ph_lo = 0; a.ph_hi = N_PHASES;
    void* kargs[] = {&a};
    hipError_t e = hipLaunchCooperativeKernel((const void*)mk_fwd, dim3(grid), dim3(NWAVES * 64), kargs, LDS_BYTES, stream);
    if (e != hipSuccess) fprintf(stderr, "kernel_launch: cooperative launch failed: %s (grid %d)\n", hipGetErrorString(e), grid);
#else
    for (int p = 0; p < N_PHASES; ++p) { a.ph_lo = p; a.ph_hi = p + 1; hipLaunchKernelGGL(mk_fwd, dim3(grid), dim3(NWAVES * 64), LDS_BYTES, stream, a); }
#endif
}
```

```cpp
#include <hip/hip_runtime.h>
#include <hip/hip_cooperative_groups.h>
#include <cstdio>
#include <cstdint>
namespace cg = cooperative_groups;
namespace pg8 {
#define PG8_LAS __attribute__((address_space(3)))
typedef unsigned short bf16_t;
typedef short bf16x8 __attribute__((ext_vector_type(8)));
typedef float f32x4 __attribute__((ext_vector_type(4)));
typedef unsigned u32x4 __attribute__((ext_vector_type(4)));
constexpr int BM = 256, BK = 64, HALF = 128, HTB = HALF * BK * 2  , STAGE_BYTES = 8 * HTB, NXCD = 8, WGM = 8;

__host__ __device__ __forceinline__ int lds_byte(int r, int c) { const int st = (r >> 4) * 2 + (c >> 5), rr = r & 15, cc = c & 31, ob = rr * 64 + cc * 2; return st * 1024 + (ob ^ (((ob >> 9) & 1) << 5)); }
__host__ __device__ __forceinline__ void stage_rc(int b, int& R, int& C) { const int st = b / 1024, sb = b % 1024, swz = sb ^ (((sb >> 9) & 1) << 5); R = (st >> 1) * 16 + swz / 64; C = (st & 1) * 32 + (swz % 64) / 2; }
__host__ __device__ __forceinline__ int perm32(int rho) { const int n = rho >> 4, i = rho & 15; return 8 * (i >> 2) + 4 * n + (i & 3); }

struct Unit { int pm, pn; };
struct Gemm { const bf16_t* A; const bf16_t* Bt; int M, N, K; };

struct StaticOrder {
    int nM, nN, nwg, G, c;
    __host__ __device__ void init(int M, int N, int G_, int c_) { nM = M / BM; nN = N / BM; nwg = nM * nN; G = G_; c = c_; }
    __host__ __device__ bool next(int i, Unit& u) const {
        const long L = (long)i * G + c; if (L >= nwg) return false;
        int wgid = (int)L; { const int q = nwg / NXCD, r = nwg % NXCD, xcd = wgid % NXCD, off = wgid / NXCD; wgid = (xcd < r ? xcd * (q + 1) : r * (q + 1) + (xcd - r) * q) + off; }
        const int nig = WGM * nN, gid = wgid / nig, fm = gid * WGM, gsz = (nM - fm) < WGM ? (nM - fm) : WGM;
        u.pm = fm + ((wgid % nig) % gsz); u.pn = (wgid % nig) / gsz; return true;
    }
    __device__ __forceinline__ void a_ready(const Unit&) const {}
    __device__ __forceinline__ void done(const Unit&) const {}
};

__device__ __forceinline__ unsigned cvt_pk_bf16(float lo, float hi) { unsigned r; asm volatile("v_cvt_pk_bf16_f32 %0, %1, %2" : "=v"(r) : "v"(lo), "v"(hi)); return r; }
typedef float f32x2 __attribute__((ext_vector_type(2)));
typedef unsigned long long ss_t;
constexpr float SS_SCALE = 1048576.0f;
__device__ __forceinline__ float rstd_of(const ss_t* ss, int row) { return __builtin_amdgcn_rsqf((float)ss[row] * (1.0f / (1024.0f * SS_SCALE)) + 1e-6f); }
struct EpiScale {
    static constexpr bool PERM = true, AFTER_DRAIN = false;
    bf16_t* O; int ldc; const ss_t* ss;
    __device__ __forceinline__ void operator()(const f32x4 (&acc)[2][2][4][2], const Unit& u, int wr, int wc, int fr, int fq) const {
        const int row0 = u.pm * BM + wr * 64 + fr, col0 = u.pn * BM + wc * 32 + 8 * fq;
        float rsv[2][4];
#pragma unroll
        for (int ai = 0; ai < 2; ++ai)
#pragma unroll
            for (int m = 0; m < 4; ++m) rsv[ai][m] = rstd_of(ss, row0 + ai * HALF + m * 16);
#pragma unroll
        for (int ai = 0; ai < 2; ++ai)
#pragma unroll
            for (int m = 0; m < 4; ++m) { const int row = row0 + ai * HALF + m * 16; const float rs = rsv[ai][m]; bf16_t* rowp = O + (size_t)row * ldc + col0;
#pragma unroll
                for (int bj = 0; bj < 2; ++bj) { const f32x4 v0 = acc[ai][bj][m][0] * rs, v1 = acc[ai][bj][m][1] * rs;
                    u32x4 w; w.x = cvt_pk_bf16(v0[0], v0[1]); w.y = cvt_pk_bf16(v0[2], v0[3]); w.z = cvt_pk_bf16(v1[0], v1[1]); w.w = cvt_pk_bf16(v1[2], v1[3]);
                    *(u32x4*)(rowp + bj * HALF) = w; }
                asm volatile("" ::: "memory"); }
    }
};
__device__ __forceinline__ float silu_mul(float g, float u) { const float e = __builtin_amdgcn_exp2f(g * -1.4426950408889634f); return g * u * __builtin_amdgcn_rcpf(1.0f + e); }
struct EpiSwiglu {
    static constexpr bool PERM = true, AFTER_DRAIN = false;
    bf16_t* H; int ldh; const ss_t* ss;
    __device__ __forceinline__ void operator()(const f32x4 (&acc)[2][2][4][2], const Unit& u, int wr, int wc, int fr, int fq) const {
        const int row0 = u.pm * BM + wr * 64 + fr, col0 = u.pn * HALF + wc * 32 + 8 * fq;
        float rsv[2][4];
#pragma unroll
        for (int ai = 0; ai < 2; ++ai)
#pragma unroll
            for (int m = 0; m < 4; ++m) rsv[ai][m] = rstd_of(ss, row0 + ai * HALF + m * 16);
#pragma unroll
        for (int ai = 0; ai < 2; ++ai)
#pragma unroll
            for (int m = 0; m < 4; ++m) { const int row = row0 + ai * HALF + m * 16; const float rs = rsv[ai][m];
                const f32x4 g0 = acc[ai][0][m][0] * rs, g1 = acc[ai][0][m][1] * rs, u0 = acc[ai][1][m][0] * rs, u1 = acc[ai][1][m][1] * rs;
                u32x4 w; w.x = cvt_pk_bf16(silu_mul(g0[0], u0[0]), silu_mul(g0[1], u0[1])); w.y = cvt_pk_bf16(silu_mul(g0[2], u0[2]), silu_mul(g0[3], u0[3]));
                w.z = cvt_pk_bf16(silu_mul(g1[0], u1[0]), silu_mul(g1[1], u1[1])); w.w = cvt_pk_bf16(silu_mul(g1[2], u1[2]), silu_mul(g1[3], u1[3]));
                *(u32x4*)(H + (size_t)row * ldh + col0) = w; asm volatile("" ::: "memory"); }
    }
};
__device__ __forceinline__ float bfl(unsigned u) { return __builtin_bit_cast(float, u << 16); }
__device__ __forceinline__ float bfh(unsigned u) { return __builtin_bit_cast(float, u & 0xffff0000u); }
struct EpiResid {
    static constexpr bool PERM = true, AFTER_DRAIN = false;
    bf16_t* XB; ss_t* ssn; float alpha;
    __device__ __forceinline__ void operator()(const f32x4 (&acc)[2][2][4][2], const Unit& u, int wr, int wc, int fr, int fq) const {
        const int row0 = u.pm * BM + wr * 64 + fr, col0 = u.pn * BM + wc * 32 + 8 * fq;
        u32x4 xv[2][4][2];
#pragma unroll
        for (int ai = 0; ai < 2; ++ai)
#pragma unroll
            for (int m = 0; m < 4; ++m) { const bf16_t* bp = XB + (size_t)(row0 + ai * HALF + m * 16) * 1024 + col0; xv[ai][m][0] = *(const u32x4*)bp; xv[ai][m][1] = *(const u32x4*)(bp + HALF); }
#pragma unroll
        for (int ai = 0; ai < 2; ++ai)
#pragma unroll
            for (int m = 0; m < 4; ++m) { const int row = row0 + ai * HALF + m * 16; bf16_t* bp = XB + (size_t)row * 1024 + col0; float q = 0.f;
#pragma unroll
                for (int bj = 0; bj < 2; ++bj) { const u32x4 x = xv[ai][m][bj]; const f32x4 a0 = acc[ai][bj][m][0] * alpha, a1 = acc[ai][bj][m][1] * alpha;
                    const float y0 = bfl(x.x) + a0[0], y1 = bfh(x.x) + a0[1], y2 = bfl(x.y) + a0[2], y3 = bfh(x.y) + a0[3], y4 = bfl(x.z) + a1[0], y5 = bfh(x.z) + a1[1], y6 = bfl(x.w) + a1[2], y7 = bfh(x.w) + a1[3];
                    u32x4 w; w.x = cvt_pk_bf16(y0, y1); w.y = cvt_pk_bf16(y2, y3); w.z = cvt_pk_bf16(y4, y5); w.w = cvt_pk_bf16(y6, y7);
                    *(u32x4*)(bp + bj * HALF) = w;
                    q += (y0 * y0 + y1 * y1) + (y2 * y2 + y3 * y3) + (y4 * y4 + y5 * y5) + (y6 * y6 + y7 * y7); }
                q += __shfl_xor(q, 16); q += __shfl_xor(q, 32);
                if (fq == 0) __hip_atomic_fetch_add(ssn + row, (ss_t)(q * SS_SCALE), __ATOMIC_RELAXED, __HIP_MEMORY_SCOPE_AGENT); }
    }
};
template <class Epi, class Sched, bool ALIGN_EPI = false, bool SP2 = false>
__device__ __forceinline__ void gemm_phase(PG8_LAS unsigned char* lds, const Gemm g, const Sched& S, const Epi& E) {
    int tid = threadIdx.x; asm volatile("" : "+v"(tid)); const int wid = __builtin_amdgcn_readfirstlane(tid >> 6), lane = tid & 63, wr = wid >> 2, wc = wid & 3, fr = lane & 15, fq = lane >> 4;
    const int K = g.K, nt = K / BK;
    unsigned voffA[2], voffB[2];
#pragma unroll
    for (int i = 0; i < 2; ++i) { int R, C; stage_rc(tid * 16 + i * 8192, R, C); const int Rb = Epi::PERM ? ((R & ~31) + perm32(R & 31)) : R;
        voffA[i] = (unsigned)(R * K + C) * 2u; voffB[i] = (unsigned)(Rb * K + C) * 2u; }
    const size_t kstep = (size_t)(BK * 2);
    const size_t hstep = (size_t)HALF * K * 2;
    const size_t tstep = 2 * hstep;
    const unsigned ldsw = (unsigned)wid * 1024u;
    const int aoff = lds_byte(wr * 64 + fr, fq * 8), boff = lds_byte(wc * 32 + fr, fq * 8);
#define PG8_SA(b, h) (((b) * 2 + (h)) * HTB)
#define PG8_SB(b, h) ((4 + (b) * 2 + (h)) * HTB)
#define PG8_STAGE(bufoff, gbase, voff) do { _Pragma("unroll") for (int _i = 0; _i < 2; ++_i) \
        __builtin_amdgcn_global_load_lds((const unsigned*)((const char*)(gbase) + (voff)[_i]), (PG8_LAS unsigned*)(lds + (bufoff) + ldsw + _i * 8192), 16, 0, 0); } while (0)
#define PG8_LDA(dst, b, h) do { _Pragma("unroll") for (int m = 0; m < 4; ++m) _Pragma("unroll") for (int k = 0; k < 2; ++k) dst[m][k] = *(const PG8_LAS bf16x8*)(lds + PG8_SA(b, h) + aoff + m * 2048 + k * 1024); } while (0)
#define PG8_LDB(dst, b, h) do { _Pragma("unroll") for (int n = 0; n < 2; ++n) _Pragma("unroll") for (int k = 0; k < 2; ++k) dst[n][k] = *(const PG8_LAS bf16x8*)(lds + PG8_SB(b, h) + boff + n * 2048 + k * 1024); } while (0)
#define PG8_MMA(ai, bj, At, Bt) do { __builtin_amdgcn_s_setprio(1); _Pragma("unroll") for (int m = 0; m < 4; ++m) _Pragma("unroll") for (int n = 0; n < 2; ++n) _Pragma("unroll") for (int k = 0; k < 2; ++k) \
        acc[ai][bj][m][n] = __builtin_amdgcn_mfma_f32_16x16x32_bf16(Bt[n][k], At[m][k], acc[ai][bj][m][n], 0, 0, 0); __builtin_amdgcn_s_setprio(0); } while (0)
#define PG8_WAIT_V(n) asm volatile("s_waitcnt vmcnt(" #n ")" ::: "memory")
#define PG8_WAIT_L(n) asm volatile("s_waitcnt lgkmcnt(" #n ")" ::: "memory")
#define PG8_BAR __builtin_amdgcn_s_barrier()
#define PG8_SCHED __builtin_amdgcn_sched_barrier(0)
    Unit cur, nxt; int ui = 0;
    if (!S.next(0, cur)) return;
    f32x4 acc[2][2][4][2];
#pragma unroll
    for (int a = 0; a < 2; ++a)
#pragma unroll
        for (int b = 0; b < 2; ++b)
#pragma unroll
            for (int m = 0; m < 4; ++m)
#pragma unroll
                for (int n = 0; n < 2; ++n) acc[a][b][m][n] = (f32x4){0.f, 0.f, 0.f, 0.f};
    bf16x8 At[4][2], B0[2][2], B1[2][2];
    const char* cA = (const char*)g.A + (size_t)cur.pm * tstep; const char* cB = (const char*)g.Bt + (size_t)cur.pn * tstep;
    S.a_ready(cur);
    if constexpr (SP2) {
        PG8_STAGE(PG8_SB(0, 0), cB, voffB); PG8_STAGE(PG8_SB(0, 1), cB + hstep, voffB); PG8_STAGE(PG8_SA(0, 0), cA, voffA); PG8_STAGE(PG8_SA(0, 1), cA + hstep, voffA);
        if (wr == 1) PG8_BAR;
        PG8_WAIT_V(2); PG8_BAR;
        PG8_STAGE(PG8_SB(1, 0), cB + kstep, voffB); PG8_STAGE(PG8_SA(1, 0), cA + kstep, voffA); PG8_STAGE(PG8_SB(1, 1), cB + hstep + kstep, voffB);
        PG8_WAIT_V(6); PG8_BAR;
    } else {
        PG8_STAGE(PG8_SB(0, 0), cB, voffB); PG8_STAGE(PG8_SA(0, 0), cA, voffA); PG8_STAGE(PG8_SB(0, 1), cB + hstep, voffB); PG8_STAGE(PG8_SA(0, 1), cA + hstep, voffA);
        if (wr == 1) PG8_BAR;
        PG8_WAIT_V(4); PG8_BAR;
        PG8_STAGE(PG8_SB(1, 0), cB + kstep, voffB); PG8_STAGE(PG8_SA(1, 0), cA + kstep, voffA); PG8_STAGE(PG8_SB(1, 1), cB + hstep + kstep, voffB);
        PG8_WAIT_V(6); PG8_BAR;
    }
    for (;;) {
        const bool has_next = S.next(ui + 1, nxt);
        const char* nA = has_next ? (const char*)g.A + (size_t)nxt.pm * tstep : cA; const char* nB = has_next ? (const char*)g.Bt + (size_t)nxt.pn * tstep : cB;
        for (int t = 0; t < nt; t += 2) {
            const bool last = (t == nt - 2);
            const char* a1 = cA + (size_t)(t + 1) * kstep;
            const char* a2 = last ? nA : cA + (size_t)(t + 2) * kstep; const char* b2 = last ? nB : cB + (size_t)(t + 2) * kstep;
            const char* a3 = a2 + kstep; const char* b3 = b2 + kstep;
            if (last && has_next) S.a_ready(nxt);
            if constexpr (SP2) {
            PG8_LDB(B0, 0, 0); PG8_LDB(B1, 0, 1); PG8_SCHED; PG8_LDA(At, 0, 0); PG8_STAGE(PG8_SA(1, 1), a1 + hstep, voffA);
            PG8_WAIT_V(8); PG8_WAIT_L(0); PG8_BAR; PG8_MMA(0, 0, At, B0); PG8_MMA(0, 1, At, B1); PG8_BAR; PG8_SCHED;
            PG8_LDA(At, 0, 1); PG8_STAGE(PG8_SB(0, 0), b2, voffB); PG8_STAGE(PG8_SB(0, 1), b2 + hstep, voffB); PG8_STAGE(PG8_SA(0, 0), a2, voffA);
            PG8_WAIT_V(8); PG8_WAIT_L(0); PG8_BAR; PG8_MMA(1, 0, At, B0); PG8_MMA(1, 1, At, B1); PG8_BAR; PG8_SCHED;
            PG8_LDB(B0, 1, 0); PG8_LDB(B1, 1, 1); PG8_SCHED; PG8_LDA(At, 1, 0); PG8_STAGE(PG8_SA(0, 1), a2 + hstep, voffA);
            PG8_WAIT_V(8); PG8_WAIT_L(0); PG8_BAR; PG8_MMA(0, 0, At, B0); PG8_MMA(0, 1, At, B1); PG8_BAR; PG8_SCHED;
            PG8_LDA(At, 1, 1); PG8_STAGE(PG8_SB(1, 0), b3, voffB); PG8_STAGE(PG8_SB(1, 1), b3 + hstep, voffB); PG8_STAGE(PG8_SA(1, 0), a3, voffA);
            PG8_WAIT_V(8); PG8_WAIT_L(0); PG8_BAR; PG8_MMA(1, 0, At, B0); PG8_MMA(1, 1, At, B1); PG8_BAR; PG8_SCHED;
            } else {
            PG8_LDB(B0, 0, 0); PG8_SCHED; PG8_LDA(At, 0, 0); PG8_STAGE(PG8_SA(1, 1), a1 + hstep, voffA);
            PG8_WAIT_L(8); PG8_BAR; PG8_WAIT_L(0); PG8_MMA(0, 0, At, B0); PG8_BAR; PG8_SCHED;
            PG8_LDB(B1, 0, 1); PG8_STAGE(PG8_SB(0, 0), b2, voffB);
            PG8_BAR; PG8_WAIT_L(0); PG8_MMA(0, 1, At, B1); PG8_BAR;
            PG8_LDA(At, 0, 1); PG8_STAGE(PG8_SA(0, 0), a2, voffA);
            PG8_BAR; PG8_WAIT_L(0); PG8_MMA(1, 0, At, B0); PG8_BAR; PG8_SCHED;
            PG8_STAGE(PG8_SB(0, 1), b2 + hstep, voffB);
            PG8_WAIT_V(6); PG8_BAR; PG8_MMA(1, 1, At, B1); PG8_BAR;
            PG8_LDB(B0, 1, 0); PG8_SCHED; PG8_LDA(At, 1, 0); PG8_STAGE(PG8_SA(0, 1), a2 + hstep, voffA);
            PG8_WAIT_L(8); PG8_BAR; PG8_WAIT_L(0); PG8_MMA(0, 0, At, B0); PG8_BAR; PG8_SCHED;
            PG8_LDB(B1, 1, 1); PG8_STAGE(PG8_SB(1, 0), b3, voffB);
            PG8_BAR; PG8_WAIT_L(0); PG8_MMA(0, 1, At, B1); PG8_BAR;
            PG8_LDA(At, 1, 1); PG8_STAGE(PG8_SA(1, 0), a3, voffA);
            PG8_BAR; PG8_WAIT_L(0); PG8_MMA(1, 0, At, B0); PG8_BAR; PG8_SCHED;
            PG8_STAGE(PG8_SB(1, 1), b3 + hstep, voffB);
            PG8_WAIT_V(6); PG8_BAR; PG8_MMA(1, 1, At, B1); PG8_BAR;
            }
        }
        if constexpr (ALIGN_EPI) { if (wr == 0) PG8_BAR; }
        if constexpr (!Epi::AFTER_DRAIN) { E(acc, cur, wr, wc, fr, fq); S.done(cur); }
        if (!has_next) break;
#pragma unroll
        for (int a = 0; a < 2; ++a)
#pragma unroll
            for (int b = 0; b < 2; ++b)
#pragma unroll
                for (int m = 0; m < 4; ++m)
#pragma unroll
                    for (int n = 0; n < 2; ++n) acc[a][b][m][n] = (f32x4){0.f, 0.f, 0.f, 0.f};
        cur = nxt; cA = nA; cB = nB; ++ui;
        if constexpr (ALIGN_EPI) { if (wr == 1) PG8_BAR; }
    }
    PG8_WAIT_V(0);
    if constexpr (!ALIGN_EPI) { if (wr == 0) PG8_BAR; }
    PG8_BAR;
    if constexpr (Epi::AFTER_DRAIN) { E.fused(acc, cur, wr, wc, fr, fq, lds, wid, lane); S.done(cur); }
#undef PG8_SA
#undef PG8_SB
#undef PG8_STAGE
#undef PG8_LDA
#undef PG8_LDB
#undef PG8_MMA
#undef PG8_WAIT_V
#undef PG8_WAIT_L
#undef PG8_BAR
#undef PG8_SCHED
}
}

#ifndef MK_N_LAUNCHES
#define MK_N_LAUNCHES 1
#endif
constexpr int NWAVES = 8;
constexpr int BATCH = 2, SEQ = 8192, D = 1024, FF = 2816, M = BATCH * SEQ, DEPTH = 4;
constexpr int NIN_CONV = 2560, NQKV = 3072, NHEAD = 16;
constexpr size_t MiB = 1u << 20;
constexpr size_t WS_CTL = 0, CTL_ZERO_BYTES = 2 * MiB;
constexpr size_t WS_SS = 64 * 1024;
constexpr size_t WS_LSE = 2 * MiB;
constexpr size_t WS_W = 8 * MiB, W_STRIDE = 44 * MiB;
constexpr size_t WS_XB = 96 * MiB;
constexpr size_t WS_ACT = 128 * MiB;
constexpr size_t WS_OG = 224 * MiB;
constexpr size_t WS_MG = 320 * MiB;
constexpr size_t WS_END = 352 * MiB;
constexpr size_t OW_GU1 = 0, OW_D1 = OW_GU1 + (size_t)2 * FF * D, OW_MI = OW_D1 + (size_t)D * FF, OW_MO = OW_MI + (size_t)NQKV * D, OW_GU2 = OW_MO + (size_t)D * D, OW_D2 = OW_GU2 + (size_t)2 * FF * D, OW_END = OW_D2 + (size_t)D * FF;
static_assert(OW_END * 2 <= W_STRIDE, "weight buffer");
constexpr int LDS_BYTES = 147456;
constexpr int CW_BAR = 4096;
constexpr int MISC_OFF = 131072 + 320;

#define LAS __attribute__((address_space(3)))
typedef unsigned short bf16;
typedef unsigned v4u __attribute__((ext_vector_type(4)));
typedef unsigned v2u __attribute__((ext_vector_type(2)));
typedef float f32x4 __attribute__((ext_vector_type(4)));
typedef short bf16x8 __attribute__((ext_vector_type(8)));
typedef short s16x4 __attribute__((ext_vector_type(4)));
#define LDS_WAIT() asm volatile("s_waitcnt lgkmcnt(0)" ::: "memory")
__device__ __forceinline__ unsigned pk2(float lo, float hi) { return pg8::cvt_pk_bf16(lo, hi); }
__device__ __forceinline__ int opq(int x) { asm volatile("" : "+v"(x)); return x; }
__device__ __forceinline__ float bf_lo(unsigned u) { return __uint_as_float(u << 16); }
__device__ __forceinline__ float bf_hi(unsigned u) { return __uint_as_float(u & 0xffff0000u); }
__device__ __forceinline__ float wave_sum(float v) {
#pragma unroll
    for (int o = 1; o < 64; o <<= 1) v += __shfl_xor(v, o);
    return v;
}

__device__ __forceinline__ void cvt_item(const float* __restrict__ W, int K, int N, bf16* WT, int dst_row0, int k0, int n0, const float* __restrict__ g, float cs, LAS float* scr, int lane) {
    float wv[32];
#pragma unroll
    for (int i = 0; i < 32; ++i) { const int kk = 2 * i + (lane >> 5); wv[i] = W[(size_t)(k0 + kk) * N + n0 + (lane & 31)]; }
#pragma unroll
    for (int i = 0; i < 32; ++i) { const int kk = 2 * i + (lane >> 5); const float gk = g ? g[k0 + kk] * cs : cs; scr[kk * 33 + (lane & 31)] = wv[i] * gk; }
    LDS_WAIT(); asm volatile("" ::: "memory");
    const int c = lane & 7;
#pragma unroll
    for (int j = 0; j < 4; ++j) { const int n = (lane >> 3) + 8 * j; const LAS float* s = scr + (8 * c) * 33 + n;
        v4u o; o.x = pk2(s[0 * 33], s[1 * 33]); o.y = pk2(s[2 * 33], s[3 * 33]); o.z = pk2(s[4 * 33], s[5 * 33]); o.w = pk2(s[6 * 33], s[7 * 33]);
        *(v4u*)(WT + (size_t)(dst_row0 + n) * K + k0 + 8 * c) = o; }
    LDS_WAIT(); asm volatile("" ::: "memory");
}
struct LayerW { const float *gu1, *d1, *mi, *mo, *gu2, *d2, *g1, *gm, *g2; int even; };
__device__ __forceinline__ void convert_layer(const LayerW& w, bf16* WB, int part, LAS unsigned char* lds, int gw, int NGW, int wave, int lane) {
    LAS float* scr = (LAS float*)(lds + wave * 16384);
    const int nmi = w.even ? NIN_CONV : NQKV;
    const int I_GU = (D / 64) * (2 * FF / 32), I_D = (FF / 64) * (D / 32), I_MI = (D / 64) * (nmi / 32), I_MO = (D / 64) * (D / 32);
    const int NITEMS = part == 0 ? I_GU + I_D : I_GU + I_D + I_MI + I_MO;
    for (int it = gw; it < NITEMS; it += NGW) {
        int r = it;
        if (r < I_GU) { const int nblk = 2 * FF / 32, kb = r / nblk, nb = r % nblk, n0 = nb * 32;
            const int j0 = n0 < FF ? n0 : n0 - FF; const int dst = (j0 >> 7) * 256 + (n0 < FF ? 0 : 128) + (j0 & 127);
            cvt_item(part ? w.gu2 : w.gu1, D, 2 * FF, WB + (part ? OW_GU2 : OW_GU1), dst, kb * 64, n0, part ? w.g2 : w.g1, 1.0f, scr, lane); continue; }
        r -= I_GU;
        if (r < I_D) { const int nblk = D / 32, kb = r / nblk, nb = r % nblk;
            cvt_item(part ? w.d2 : w.d1, FF, D, WB + (part ? OW_D2 : OW_D1), nb * 32, kb * 64, nb * 32, nullptr, 1.0f, scr, lane); continue; }
        r -= I_D;
        if (r < I_MI) { const int nblk = nmi / 32, kb = r / nblk, nb = r % nblk, n0 = nb * 32;
            const float cs = (!w.even && n0 < D) ? 0.125f * 1.4426950408889634f : 1.0f;
            cvt_item(w.mi, D, nmi, WB + OW_MI, n0, kb * 64, n0, w.gm, cs, scr, lane); continue; }
        r -= I_MI;
        { const int nblk = D / 32, kb = r / nblk, nb = r % nblk; cvt_item(w.mo, D, D, WB + OW_MO, nb * 32, kb * 64, nb * 32, nullptr, 1.0f, scr, lane); }
    }
}

constexpr int KP = 144;
constexpr int ATT_K = 0, ATT_V = 272 * KP;
__device__ __forceinline__ void attn_phase(LAS unsigned char* lds, const bf16* __restrict__ QKV, bf16* OG, float* LSE, int G, int vcu) {
    const int tid = opq(threadIdx.x), lane = tid & 63, wid = __builtin_amdgcn_readfirstlane(tid >> 6), fr = lane & 15, fq = lane >> 4;
    const unsigned z1 = (unsigned)opq(0); const v4u zero4 = (v4u){z1, z1, z1, z1};
    for (int i = tid; i < 2 * 144; i += 512) { const int which = i / 144, c = i % 144; *(LAS v4u*)(lds + (which ? ATT_V : ATT_K) + 256 * KP + c * 16) = zero4; }
    f32x4 relf[9];
#pragma unroll
    for (int j = 0; j < 9; ++j)
#pragma unroll
        for (int r = 0; r < 4; ++r) { const int rel = 128 + fr - 16 * j - 4 * fq - r; relf[j][r] = (rel >= 0 && rel <= 128) ? (float)rel : 1e30f; }
    const int total = 3 * BATCH * NHEAD * 64;
    const int per = (total + G - 1) / G, u_beg = vcu * per, u_end = (u_beg + per < total) ? u_beg + per : total;
    v4u kreg[4], vreg[4];
#define ATT_DECODE(u) const int g_ = (u) >> 11, rem_ = (u) & 2047, b_ = rem_ >> 10, h_ = (rem_ >> 6) & 15, rb_ = rem_ & 63, sh_ = 2 * g_, nl_ = 6 - sh_, r_ = rb_ >> nl_, n_ = rb_ & ((1 << nl_) - 1)
#define ATT_PREFETCH(u) do { ATT_DECODE(u); _Pragma("unroll") for (int i = 0; i < 4; ++i) { const int idx = tid + 512 * i, k = idx >> 3, ch = idx & 7; const int j = 128 * (n_ - 1) + k; \
        if (j >= 0) { const bf16* src = QKV + ((size_t)(b_ * SEQ + (j << sh_) + r_)) * NQKV + D + h_ * 64 + ch * 8; kreg[i] = *(const v4u*)src; vreg[i] = *(const v4u*)(src + D); } \
        else { kreg[i] = zero4; vreg[i] = zero4; } } } while (0)
    if (u_beg < u_end) ATT_PREFETCH(u_beg);
    for (int u = u_beg; u < u_end; ++u) {
        __syncthreads();
#pragma unroll
        for (int i = 0; i < 4; ++i) { const int idx = tid + 512 * i, k = idx >> 3, ch = idx & 7; *(LAS v4u*)(lds + ATT_K + k * KP + ch * 16) = kreg[i]; *(LAS v4u*)(lds + ATT_V + k * KP + ch * 16) = vreg[i]; }
        __syncthreads();
        ATT_DECODE(u);
        const int dil = 1 << sh_;
        const size_t qrow = (size_t)(b_ * SEQ + ((128 * n_ + 16 * wid + fr) << sh_) + r_);
        const bf16* qp = QKV + qrow * NQKV + h_ * 64 + fq * 8;
        const bf16x8 qf0 = *(const bf16x8*)qp, qf1 = *(const bf16x8*)(qp + 32);
        if (u + 1 < u_end) ATT_PREFETCH(u + 1);
        const float ncb = -__builtin_amdgcn_exp2f(-0.5f * (float)(h_ + 1)) * (float)dil * 1.4426950408889634f;
        f32x4 s[9];
        const LAS unsigned char* kb = lds + ATT_K + (16 * wid + fr) * KP + fq * 16;
        float mx = -3.0e38f;
#pragma unroll
        for (int j = 0; j < 9; ++j) { const bf16x8 k0 = *(const LAS bf16x8*)(kb + j * 16 * KP), k1 = *(const LAS bf16x8*)(kb + j * 16 * KP + 64);
            f32x4 a = relf[j] * ncb;
            a = __builtin_amdgcn_mfma_f32_16x16x32_bf16(k0, qf0, a, 0, 0, 0); a = __builtin_amdgcn_mfma_f32_16x16x32_bf16(k1, qf1, a, 0, 0, 0);
            if (n_ == 0 && wid + j < 8) a = (f32x4){-1e30f, -1e30f, -1e30f, -1e30f};
            s[j] = a; mx = fmaxf(fmaxf(mx, fmaxf(a[0], a[1])), fmaxf(a[2], a[3])); }
        mx = fmaxf(mx, __shfl_xor(mx, 16)); mx = fmaxf(mx, __shfl_xor(mx, 32));
        float l = 0.f;
#pragma unroll
        for (int j = 0; j < 9; ++j)
#pragma unroll
            for (int r = 0; r < 4; ++r) { const float p = __builtin_amdgcn_exp2f(s[j][r] - mx); s[j][r] = p; l += p; }
        l += __shfl_xor(l, 16); l += __shfl_xor(l, 32);
        f32x4 o[4];
#pragma unroll
        for (int dt = 0; dt < 4; ++dt) o[dt] = (f32x4){0.f, 0.f, 0.f, 0.f};
        const LAS unsigned char* vb = lds + ATT_V + (16 * wid + 4 * fq + (fr >> 2)) * KP + (fr & 3) * 8;
#pragma unroll
        for (int gk = 0; gk < 5; ++gk) {
            v4u pw; pw.x = pk2(s[2 * gk][0], s[2 * gk][1]); pw.y = pk2(s[2 * gk][2], s[2 * gk][3]);
            if (gk < 4) { pw.z = pk2(s[(2 * gk + 1) % 9][0], s[(2 * gk + 1) % 9][1]); pw.w = pk2(s[(2 * gk + 1) % 9][2], s[(2 * gk + 1) % 9][3]); } else { pw.z = 0u; pw.w = 0u; }
            const bf16x8 pb = __builtin_bit_cast(bf16x8, pw);
#pragma unroll
            for (int dt = 0; dt < 4; ++dt) {
                const s16x4 lo = __builtin_bit_cast(s16x4, __builtin_amdgcn_ds_read_tr16_b64_v4i16((LAS s16x4*)(vb + gk * 32 * KP + dt * 32)));
                const s16x4 hi = __builtin_bit_cast(s16x4, __builtin_amdgcn_ds_read_tr16_b64_v4i16((LAS s16x4*)(vb + gk * 32 * KP + 16 * KP + dt * 32)));
                const bf16x8 vf = (bf16x8){lo[0], lo[1], lo[2], lo[3], hi[0], hi[1], hi[2], hi[3]};
                o[dt] = __builtin_amdgcn_mfma_f32_16x16x32_bf16(vf, pb, o[dt], 0, 0, 0);
            }
        }
        const float il = __builtin_amdgcn_rcpf(l);
        bf16* op = OG + (size_t)g_ * M * D + qrow * D + h_ * 64 + 4 * fq;
#pragma unroll
        for (int dt = 0; dt < 4; ++dt) { v2u w; w.x = pk2(o[dt][0] * il, o[dt][1] * il); w.y = pk2(o[dt][2] * il, o[dt][3] * il); *(v2u*)(op + dt * 16) = w; }
        if (fq == 0) LSE[(size_t)g_ * M * NHEAD + qrow * NHEAD + h_] = mx + __builtin_amdgcn_logf(l);
    }
#undef ATT_DECODE
#undef ATT_PREFETCH
}
__device__ __forceinline__ void merge_phase(const bf16* __restrict__ OG, const float* __restrict__ LSE, bf16* MG, int G, int bid) {
    const size_t nth = (size_t)G * 512;
    const int tid = opq(threadIdx.x);
    for (size_t idx = (size_t)bid * 512 + tid; idx < (size_t)M * 128; idx += nth) {
        const size_t row = idx >> 7; const int c = (int)(idx & 127), h = c >> 3;
        const float l0 = LSE[row * NHEAD + h], l1 = LSE[(size_t)M * NHEAD + row * NHEAD + h], l2 = LSE[(size_t)2 * M * NHEAD + row * NHEAD + h];
        const float mx = fmaxf(l0, fmaxf(l1, l2));
        float w0 = __builtin_amdgcn_exp2f(l0 - mx), w1 = __builtin_amdgcn_exp2f(l1 - mx), w2 = __builtin_amdgcn_exp2f(l2 - mx);
        const float inv = __builtin_amdgcn_rcpf(w0 + w1 + w2); w0 *= inv; w1 *= inv; w2 *= inv;
        const v4u a = *(const v4u*)(OG + row * D + c * 8), b = *(const v4u*)(OG + (size_t)M * D + row * D + c * 8), cc = *(const v4u*)(OG + (size_t)2 * M * D + row * D + c * 8);
        v4u o;
#pragma unroll
        for (int i = 0; i < 4; ++i) o[i] = pk2(w0 * bf_lo(a[i]) + w1 * bf_lo(b[i]) + w2 * bf_lo(cc[i]), w0 * bf_hi(a[i]) + w1 * bf_hi(b[i]) + w2 * bf_hi(cc[i]));
        *(v4u*)(MG + row * D + c * 8) = o;
    }
}

__device__ __forceinline__ float sigmoidf_(float x) { return __builtin_amdgcn_rcpf(1.0f + __builtin_amdgcn_exp2f(x * -1.4426950408889634f)); }
__device__ __forceinline__ void conv_phase(LAS unsigned char* lds, const bf16* __restrict__ Z, bf16* CAT, const float* __restrict__ wa, const float* __restrict__ wb, const float* __restrict__ bias,
                                           const float* __restrict__ lng, const float* __restrict__ lnb, int G, int vcu) {
    const int tid = opq(threadIdx.x), lane = tid & 63, wid = __builtin_amdgcn_readfirstlane(tid >> 6), cp = tid & 255, th = tid >> 8;
    LAS float* red = (LAS float*)(lds + 62 * 1024);
    const unsigned z1 = (unsigned)opq(0); const v4u zero4 = (v4u){z1, z1, z1, z1};
    float w0[31], w1[31];
#pragma unroll
    for (int k = 0; k < 31; ++k) { const v2u w = *(const v2u*)(wb + k * 512 + 2 * cp); w0[k] = __uint_as_float(w.x); w1[k] = __uint_as_float(w.y); }
    for (int unit = vcu; unit < M / 32; unit += G) {
        const int row0 = unit * 32, s0 = row0 & (SEQ - 1);
        __syncthreads();
#pragma unroll 1
        for (int hb = 0; hb < 2; ++hb) { v4u bv[4], bg[4];
#pragma unroll
          for (int i = 0; i < 4; ++i) { const int it = tid + 512 * (4 * hb + i), lr = it >> 6, ch = it & 63; bv[i] = zero4; bg[i] = zero4;
              if (it < 62 * 64 && s0 - 30 + lr >= 0) { const bf16* zp = Z + (size_t)(row0 - 30 + lr) * NIN_CONV + 1536 + ch * 8; bv[i] = *(const v4u*)zp; bg[i] = *(const v4u*)(zp + 512); } }
#pragma unroll
          for (int i = 0; i < 4; ++i) { const int it = tid + 512 * (4 * hb + i), lr = it >> 6, ch = it & 63; v4u o;
#pragma unroll
              for (int e = 0; e < 4; ++e) o[e] = pk2(bf_lo(bv[i][e]) * sigmoidf_(bf_lo(bg[i][e])), bf_hi(bv[i][e]) * sigmoidf_(bf_hi(bg[i][e])));
              if (it < 62 * 64) *(LAS v4u*)(lds + lr * 1024 + ch * 16) = o; } }
        __syncthreads();
        float acc[16][2];
        { const v2u b = *(const v2u*)(bias + 2 * cp); const float b0 = __uint_as_float(b.x), b1 = __uint_as_float(b.y);
#pragma unroll
          for (int t = 0; t < 16; ++t) { acc[t][0] = b0; acc[t][1] = b1; } }
        const LAS unsigned char* up = lds + (th * 16) * 1024 + cp * 4;
#pragma unroll
        for (int j = 0; j < 46; ++j) { const unsigned uu = *(const LAS unsigned*)(up + j * 1024); const float ul = bf_lo(uu), uh = bf_hi(uu);
#pragma unroll
            for (int t = 0; t < 16; ++t) { const int k = j - t; if (k >= 0 && k < 31) { acc[t][0] += w0[k] * ul; acc[t][1] += w1[k] * uh; } } }
#pragma unroll
        for (int t = 0; t < 16; ++t) { const float s1 = wave_sum(acc[t][0] + acc[t][1]), s2 = wave_sum(acc[t][0] * acc[t][0] + acc[t][1] * acc[t][1]);
            if (lane == 0) { red[(wid * 16 + t) * 2] = s1; red[(wid * 16 + t) * 2 + 1] = s2; } }
        __syncthreads();
        { const float g0 = lng[2 * cp], g1 = lng[2 * cp + 1], c0 = lnb[2 * cp], c1 = lnb[2 * cp + 1];
#pragma unroll
          for (int t = 0; t < 16; ++t) { float s1 = 0.f, s2 = 0.f;
#pragma unroll
              for (int w = 0; w < 4; ++w) { s1 += red[((th * 4 + w) * 16 + t) * 2]; s2 += red[((th * 4 + w) * 16 + t) * 2 + 1]; }
              const float mean = s1 * (1.0f / 512.0f), var = fmaxf(s2 * (1.0f / 512.0f) - mean * mean, 0.f), rstd = __builtin_amdgcn_rsqf(var + 1e-5f);
              const float y0 = (acc[t][0] - mean) * rstd * g0 + c0, y1 = (acc[t][1] - mean) * rstd * g1 + c1;
              *(unsigned*)(CAT + (size_t)(row0 + th * 16 + t) * D + 512 + 2 * cp) = pk2(y0 * sigmoidf_(y0), y1 * sigmoidf_(y1)); } }
        { const float a00 = wa[2 * cp], a01 = wa[2 * cp + 1], a10 = wa[512 + 2 * cp], a11 = wa[512 + 2 * cp + 1], a20 = wa[1024 + 2 * cp], a21 = wa[1024 + 2 * cp + 1];
          unsigned zc[18], zx[18], zb[16];
#pragma unroll
          for (int t = -2; t < 16; ++t) { const int s = s0 + th * 16 + t; const bf16* zp = Z + (size_t)(row0 + th * 16 + t) * NIN_CONV + 2 * cp; zc[t + 2] = 0u; zx[t + 2] = 0u;
              if (s >= 0) { zc[t + 2] = *(const unsigned*)(zp + 512); zx[t + 2] = *(const unsigned*)(zp + 1024); }
              if (t >= 0) zb[t] = *(const unsigned*)zp; }
          float p2x = 0.f, p2y = 0.f, p1x = 0.f, p1y = 0.f;
#pragma unroll
          for (int t = -2; t < 16; ++t) { const float px = bf_lo(zc[t + 2]) * bf_lo(zx[t + 2]), py = bf_hi(zc[t + 2]) * bf_hi(zx[t + 2]);
              if (t >= 0) { const float y0 = bf_lo(zb[t]) * (a00 * p2x + a10 * p1x + a20 * px), y1 = bf_hi(zb[t]) * (a01 * p2y + a11 * p1y + a21 * py);
                  *(unsigned*)(CAT + (size_t)(row0 + th * 16 + t) * D + 2 * cp) = pk2(y0, y1); }
              p2x = p1x; p2y = p1y; p1x = px; p1y = py; } }
    }
}

typedef __attribute__((address_space(1))) unsigned gu32;
#define XB_TMO      128
#define XB_XCNT(j)  (256  + 64 * (j))
#define XB_XSUB(j)  (1280 + 64 * (j))
#define XB_XGEN(j)  (2304 + 64 * (j))
#define XB_TOP      3328
#define XB_TOPGEN   3392
#define XCD_BAR_WORDS 3456
#define XB_SPIN_CAP (1u << 18)

__device__ __forceinline__ unsigned xb_ld(unsigned* p)              { return __hip_atomic_load(p, __ATOMIC_RELAXED, __HIP_MEMORY_SCOPE_AGENT); }
__device__ __forceinline__ unsigned xb_add(unsigned* p, unsigned v) { return __hip_atomic_fetch_add(p, v, __ATOMIC_RELAXED, __HIP_MEMORY_SCOPE_AGENT); }
__device__ __forceinline__ unsigned xb_xcc_id() { return (unsigned)__builtin_amdgcn_s_getreg((3 << 11) | 20) & 0xFu; }
#define XB_SPIN(cond, bar) do { unsigned _sp = 0; while (cond) { __builtin_amdgcn_s_sleep(1); \
    if ((++_sp & 255u) == 0u) { if (xb_ld(&(bar)[XB_TMO])) break; if (_sp > XB_SPIN_CAP) { atomicAdd(&(bar)[XB_TMO], 1u); break; } } } } while (0)

struct XcdBarrier {
    unsigned* bar; unsigned x;
    volatile LAS unsigned* st;
};

__device__ __forceinline__ XcdBarrier xcd_barrier_post(unsigned* bar, volatile LAS unsigned* st) {
    XcdBarrier b; b.bar = bar; b.x = xb_xcc_id(); b.st = st;
    if (threadIdx.x == 0) (void)xb_add(&bar[XB_XCNT(b.x)], 1u);
    return b;
}
__device__ __forceinline__ void xcd_barrier_complete(unsigned* bar, unsigned x, unsigned& nloc, unsigned& nx) {
    const unsigned G = gridDim.x * gridDim.y * gridDim.z;
    unsigned sum, cnt, mine, sp = 0u;
    for (;;) {
        sum = 0u; cnt = 0u; mine = 0u;
#pragma unroll
        for (unsigned j = 0; j < 16; ++j) { const unsigned c = xb_ld(&bar[XB_XCNT(j)]); sum += c; cnt += (c > 0u) ? 1u : 0u; mine = (j == x) ? c : mine; }
        if (sum == G) break;
        __builtin_amdgcn_s_sleep(1);
        if ((++sp & 255u) == 0u) { if (xb_ld(&bar[XB_TMO])) break; if (sp > XB_SPIN_CAP) { atomicAdd(&bar[XB_TMO], 1u); break; } }
    }
    nloc = mine > 0u ? mine : 1u; nx = cnt > 0u ? cnt : 1u;
}

__device__ __forceinline__ void xcd_barrier(const XcdBarrier& b) {
    asm volatile("s_waitcnt vmcnt(0)" ::: "memory");
    __syncthreads();
    if (threadIdx.x == 0) {
        unsigned* bar = b.bar;
        __builtin_amdgcn_s_waitcnt(0);
        unsigned nloc = b.st[0], nx = b.st[1];
        if (nloc == 0u) { xcd_barrier_complete(bar, b.x, nloc, nx); b.st[0] = nloc; b.st[1] = nx; }
        const unsigned old = xb_add(&bar[XB_XSUB(b.x)], 1u);
        const unsigned gen = old / nloc;
        if (old + 1u == (gen + 1u) * nloc) {
            __builtin_amdgcn_fence(__ATOMIC_RELEASE, "agent");
            asm volatile("s_waitcnt vmcnt(0)" ::: "memory");
            const unsigned og = xb_add(&bar[XB_TOP], 1u);
            const unsigned tg = og / nx;
            if (og + 1u == (tg + 1u) * nx) xb_add(&bar[XB_TOPGEN], 1u);
            else XB_SPIN(xb_ld(&bar[XB_TOPGEN]) == tg, bar);
            __builtin_amdgcn_fence(__ATOMIC_ACQUIRE, "agent");
            xb_add(&bar[XB_XGEN(b.x)], 1u);
            asm volatile("s_waitcnt vmcnt(0)" ::: "memory");
        } else {
            XB_SPIN(xb_ld(&bar[XB_XGEN(b.x)]) == gen, bar);
            __builtin_amdgcn_fence(__ATOMIC_ACQUIRE, "agent");
            asm volatile("s_waitcnt vmcnt(0)" ::: "memory");
        }
    }
    __syncthreads();
}

struct Args { const float* in[18]; float* out; unsigned char* ws; int ph_lo, ph_hi; };
__global__ void __launch_bounds__(NWAVES * 64, 2) mk_fwd(Args args) {
    extern __shared__ __attribute__((aligned(16))) unsigned char lds_raw[];
    LAS unsigned char* lds = (LAS unsigned char*)lds_raw;
    cg::grid_group grid = cg::this_grid();
    for (int u = threadIdx.x; u < (LDS_BYTES - 131072) / 4; u += NWAVES * 64) ((LAS unsigned*)(lds + 131072))[u] = 0u;
    __syncthreads();
    const XcdBarrier xbar = xcd_barrier_post((unsigned*)(args.ws + WS_CTL) + CW_BAR, (volatile LAS unsigned*)(lds + MISC_OFF) + 8);
    const int G = gridDim.x, bx = blockIdx.x, vcu = (G % 8 == 0) ? (bx % 8) * (G / 8) + bx / 8 : bx;
    const int NGW = G * NWAVES;
#define TID_VARS const int tid = opq(threadIdx.x), lane = tid & 63, wave = __builtin_amdgcn_readfirstlane(tid >> 6), gw = vcu * NWAVES + wave; (void)gw; (void)lane
    unsigned char* ws = args.ws;
    float* X = args.out;
    pg8::ss_t* SS = (pg8::ss_t*)(ws + WS_SS); float* LSE = (float*)(ws + WS_LSE);
    bf16* XB = (bf16*)(ws + WS_XB); bf16* ACT = (bf16*)(ws + WS_ACT); bf16* OG = (bf16*)(ws + WS_OG); bf16* MG = (bf16*)(ws + WS_MG);
    const int lo = args.ph_lo, hi = args.ph_hi;
    int ph = 0;
#define PH_ON (ph >= lo && ph < hi)
#define GRID_BAR() do { asm volatile("s_waitcnt vmcnt(0)" ::: "memory"); grid.sync(); __builtin_amdgcn_fence(__ATOMIC_ACQUIRE, "agent"); asm volatile("s_waitcnt vmcnt(0)" ::: "memory"); } while (0)
#ifdef DUP_BAR
#define PH_END do { if (PH_ON && ph + 1 < hi) { GRID_BAR(); GRID_BAR(); } ++ph; } while (0)
#else
#define PH_END do { if (PH_ON && ph + 1 < hi) { if (ph == 0) GRID_BAR(); else xcd_barrier(xbar); } ++ph; } while (0)
#endif
#define MAKE_LW(lw, L) LayerW lw; { const int L_ = (L), i_ = L_ >> 1; lw.even = !(L_ & 1); \
        lw.gu1 = args.in[2] + (size_t)L_ * D * 2 * FF; lw.d1 = args.in[3] + (size_t)L_ * FF * D; lw.gu2 = args.in[6] + (size_t)L_ * D * 2 * FF; lw.d2 = args.in[7] + (size_t)L_ * FF * D; \
        lw.g1 = args.in[1] + L_ * D; lw.gm = args.in[4] + L_ * D; lw.g2 = args.in[5] + L_ * D; \
        lw.mi = lw.even ? args.in[8] + (size_t)i_ * D * NIN_CONV : args.in[15] + (size_t)i_ * D * NQKV; lw.mo = lw.even ? args.in[14] + (size_t)i_ * D * D : args.in[16] + (size_t)i_ * D * D; }

    if (PH_ON) {
        TID_VARS;
        const float* x = args.in[0];
        for (int m = gw; m < M; m += NGW) { const f32x4* xr = (const f32x4*)(x + (size_t)m * D) + lane; f32x4 v[4]; float s = 0.f;
#pragma unroll
            for (int j = 0; j < 4; ++j) { v[j] = xr[64 * j]; s += (v[j].x * v[j].x + v[j].y * v[j].y) + (v[j].z * v[j].z + v[j].w * v[j].w); }
            s = wave_sum(s);
            v2u* bo = (v2u*)(XB + (size_t)m * D) + lane;
#pragma unroll
            for (int j = 0; j < 4; ++j) { v2u w; w.x = pk2(v[j].x, v[j].y); w.y = pk2(v[j].z, v[j].w); bo[64 * j] = w; }
            if (lane == 0) SS[m] = (pg8::ss_t)(s * pg8::SS_SCALE); }
        MAKE_LW(lw, 0); convert_layer(lw, (bf16*)(ws + WS_W), 0, lds, gw, NGW, wave, lane);
    }
    PH_END;

    for (int sb = 0; sb < 3 * DEPTH; ++sb) {
        const int L = sb / 3, kind = sb % 3, even = !(L & 1);
        bf16* WB = (bf16*)(ws + WS_W + (size_t)(L & 1) * W_STRIDE);
        pg8::ss_t* ss_in = SS + (size_t)sb * M; pg8::ss_t* ss_out = SS + (size_t)(sb + 1) * M;
        if (kind != 1) {
            if (PH_ON) { pg8::Gemm g{XB, WB + (kind ? OW_GU2 : OW_GU1), M, 2 * FF, D}; pg8::StaticOrder S; S.init(M, 2 * FF, G, bx);
                pg8::EpiSwiglu E{ACT, FF, ss_in};

#ifndef NO_G1
                pg8::gemm_phase<pg8::EpiSwiglu, pg8::StaticOrder, true, true>(lds, g, S, E);
#endif
#ifdef DUP_G1
                xcd_barrier(xbar); pg8::gemm_phase<pg8::EpiSwiglu, pg8::StaticOrder, true, true>(lds, g, S, E);
#endif
                { const int nwg = (M / 256) * (2 * FF / 256), ntail = nwg % G, cl = (kind == 0) ? L : L + 1;
                  if (ntail > 0 && bx >= ntail && cl < DEPTH) { TID_VARS; MAKE_LW(lw, cl);
                      convert_layer(lw, (bf16*)(ws + WS_W + (size_t)(cl & 1) * W_STRIDE), kind == 0 ? 1 : 0, lds, (bx - ntail) * NWAVES + wave, (G - ntail) * NWAVES, wave, lane); }
                  else if (ntail == 0 && cl < DEPTH) { TID_VARS; MAKE_LW(lw, cl); convert_layer(lw, (bf16*)(ws + WS_W + (size_t)(cl & 1) * W_STRIDE), kind == 0 ? 1 : 0, lds, gw, NGW, wave, lane); } }
            }
            PH_END;
            if (PH_ON) { pg8::Gemm g{ACT, WB + (kind ? OW_D2 : OW_D1), M, D, FF}; pg8::StaticOrder S; S.init(M, D, G, bx);
                pg8::EpiResid E{XB, ss_out, 0.5f};
#ifndef NO_G2
                pg8::gemm_phase<pg8::EpiResid, pg8::StaticOrder, true, true>(lds, g, S, E);
#endif
#ifdef DUP_G2
                xcd_barrier(xbar); { pg8::EpiResid E2{XB, SS + (size_t)13 * M, 0.0f}; pg8::gemm_phase<pg8::EpiResid, pg8::StaticOrder, true, true>(lds, g, S, E2); }
#endif
            }
            PH_END;
        } else {
            const int nmi = even ? NIN_CONV : NQKV;
            if (PH_ON) { pg8::Gemm g{XB, WB + OW_MI, M, nmi, D}; pg8::StaticOrder S; S.init(M, nmi, G, bx);
                pg8::EpiScale E{ACT, nmi, ss_in};

#ifndef NO_G3
                pg8::gemm_phase<pg8::EpiScale, pg8::StaticOrder, true, true>(lds, g, S, E);
#endif
#ifdef DUP_G3
                xcd_barrier(xbar); pg8::gemm_phase<pg8::EpiScale, pg8::StaticOrder, true, true>(lds, g, S, E);
#endif
            }
            PH_END;
            if (PH_ON) {
                const int i = L >> 1;
                if (even) {
#ifndef NO_CONV
                    conv_phase(lds, ACT, OG, args.in[9] + i * 3 * 512, args.in[10] + i * 31 * 512, args.in[11] + i * 512, args.in[12] + i * 512, args.in[13] + i * 512, G, vcu);
#endif
#ifdef DUP_CONV
                    __syncthreads(); conv_phase(lds, ACT, OG, args.in[9] + i * 3 * 512, args.in[10] + i * 31 * 512, args.in[11] + i * 512, args.in[12] + i * 512, args.in[13] + i * 512, G, vcu);
#endif
                } else {
#ifndef NO_ATT
                    attn_phase(lds, ACT, OG, LSE, G, vcu);
#endif
#ifdef DUP_ATT
                    __syncthreads(); attn_phase(lds, ACT, OG, LSE, G, vcu);
#endif
                }
            }
            PH_END;
            if (!even) { if (PH_ON) { merge_phase(OG, LSE, MG, G, vcu);
#ifdef DUP_MERGE
                xcd_barrier(xbar); merge_phase(OG, LSE, MG, G, vcu);
#endif
            } PH_END; }
            if (PH_ON) { pg8::Gemm g{even ? OG : MG, WB + OW_MO, M, D, D}; pg8::StaticOrder S; S.init(M, D, G, bx);
                pg8::EpiResid E{XB, ss_out, 1.0f};
#ifndef NO_G4
                pg8::gemm_phase<pg8::EpiResid, pg8::StaticOrder, true, true>(lds, g, S, E);
#endif
#ifdef DUP_G4
                xcd_barrier(xbar); { pg8::EpiResid E2{XB, SS + (size_t)13 * M, 0.0f}; pg8::gemm_phase<pg8::EpiResid, pg8::StaticOrder, true, true>(lds, g, S, E2); }
#endif
            }
            PH_END;
        }
    }
    if (PH_ON) {
        TID_VARS;
        const float* gf = args.in[17]; const pg8::ss_t* ssf = SS + (size_t)12 * M;
        f32x4 gv[4];
#pragma unroll
        for (int j = 0; j < 4; ++j) gv[j] = ((const f32x4*)gf)[64 * j + lane];
        for (int m = gw; m < M; m += NGW) { f32x4* xo = (f32x4*)(X + (size_t)m * D) + lane; const v2u* xb = (const v2u*)(XB + (size_t)m * D) + lane; const float rs = pg8::rstd_of(ssf, m);
#pragma unroll
            for (int j = 0; j < 4; ++j) { const v2u w = xb[64 * j]; const f32x4 v = (f32x4){bf_lo(w.x), bf_hi(w.x), bf_lo(w.y), bf_hi(w.y)}; xo[64 * j] = v * rs * gv[j]; } }
    }
    ++ph;
}
constexpr int N_PHASES = 1 + 2 * (2 + 3 + 2) + 2 * (2 + 4 + 2) + 1;

extern "C" void kernel_launch(void* const* d_in, const int* in_sizes, int n_in, void* d_out, int out_size, void* d_ws, size_t ws_size, hipStream_t stream) {
    static int grid = 0;
    if (grid == 0) {
        if (n_in != 18 || in_sizes[0] != M * D || out_size != M * D || ws_size < WS_END) { fprintf(stderr, "kernel_launch: unexpected shapes (n_in %d, in0 %d, out %d, ws %zu)\n", n_in, n_in > 0 ? in_sizes[0] : -1, out_size, ws_size); grid = -1; return; }
        int dev = 0, cus = 0, per_cu = 0;
        hipGetDevice(&dev); hipDeviceGetAttribute(&cus, hipDeviceAttributeMultiprocessorCount, dev);
        if (hipFuncSetAttribute((const void*)mk_fwd, hipFuncAttributeMaxDynamicSharedMemorySize, LDS_BYTES) != hipSuccess) { fprintf(stderr, "kernel_launch: hipFuncSetAttribute failed\n"); grid = -1; return; }
        if (hipOccupancyMaxActiveBlocksPerMultiprocessor(&per_cu, (const void*)mk_fwd, NWAVES * 64, LDS_BYTES) != hipSuccess || per_cu < 1) { fprintf(stderr, "kernel_launch: occupancy query says %d\n", per_cu); per_cu = 1; }
        (void)hipGetLastError();
        grid = cus * (per_cu > 1 ? 1 : per_cu);
    }
    if (grid < 0) return;
    hipMemsetAsync((char*)d_ws + WS_CTL, 0, CTL_ZERO_BYTES, stream);
    Args a{};
    for (int i = 0; i < 18; ++i) a.in[i] = (const float*)d_in[i];
    a.out = (float*)d_out; a.ws = (unsigned char*)d_ws;
#if MK_N_LAUNCHES == 1
    a.ph_lo = 0; a.ph_hi = N_PHASES;
    void* kargs[] = {&a};
    hipError_t e = hipLaunchCooperativeKernel((const void*)mk_fwd, dim3(grid), dim3(NWAVES * 64), kargs, LDS_BYTES, stream);
    if (e != hipSuccess) fprintf(stderr, "kernel_launch: cooperative launch failed: %s (grid %d)\n", hipGetErrorString(e), grid);
#else
    for (int p = 0; p < N_PHASES; ++p) { a.ph_lo = p; a.ph_hi = p + 1; hipLaunchKernelGGL(mk_fwd, dim3(grid), dim3(NWAVES * 64), LDS_BYTES, stream, a); }
#endif
}
```

```cpp
#include <hip/hip_runtime.h>
#include <hip/hip_cooperative_groups.h>
#include <cstdio>
#include <cstdint>
namespace cg = cooperative_groups;
namespace pg8 {
#define PG8_LAS __attribute__((address_space(3)))
typedef unsigned short bf16_t;
typedef short bf16x8 __attribute__((ext_vector_type(8)));
typedef float f32x4 __attribute__((ext_vector_type(4)));
typedef unsigned u32x4 __attribute__((ext_vector_type(4)));
constexpr int BM = 256, BK = 64, HALF = 128, HTB = HALF * BK * 2  , STAGE_BYTES = 8 * HTB, NXCD = 8, WGM = 8;

__host__ __device__ __forceinline__ int lds_byte(int r, int c) { const int st = (r >> 4) * 2 + (c >> 5), rr = r & 15, cc = c & 31, ob = rr * 64 + cc * 2; return st * 1024 + (ob ^ (((ob >> 9) & 1) << 5)); }
__host__ __device__ __forceinline__ void stage_rc(int b, int& R, int& C) { const int st = b / 1024, sb = b % 1024, swz = sb ^ (((sb >> 9) & 1) << 5); R = (st >> 1) * 16 + swz / 64; C = (st & 1) * 32 + (swz % 64) / 2; }
__host__ __device__ __forceinline__ int perm32(int rho) { const int n = rho >> 4, i = rho & 15; return 8 * (i >> 2) + 4 * n + (i & 3); }

struct Unit { int pm, pn; };
struct Gemm { const bf16_t* A; const bf16_t* Bt; int M, N, K; };

struct StaticOrder {
    int nM, nN, nwg, G, c;
    __host__ __device__ void init(int M, int N, int G_, int c_) { nM = M / BM; nN = N / BM; nwg = nM * nN; G = G_; c = c_; }
    __host__ __device__ bool next(int i, Unit& u) const {
        const long L = (long)i * G + c; if (L >= nwg) return false;
        int wgid = (int)L; { const int q = nwg / NXCD, r = nwg % NXCD, xcd = wgid % NXCD, off = wgid / NXCD; wgid = (xcd < r ? xcd * (q + 1) : r * (q + 1) + (xcd - r) * q) + off; }
        const int nig = WGM * nN, gid = wgid / nig, fm = gid * WGM, gsz = (nM - fm) < WGM ? (nM - fm) : WGM;
        u.pm = fm + ((wgid % nig) % gsz); u.pn = (wgid % nig) / gsz; return true;
    }
    __device__ __forceinline__ void a_ready(const Unit&) const {}
    __device__ __forceinline__ void done(const Unit&) const {}
};

__device__ __forceinline__ unsigned cvt_pk_bf16(float lo, float hi) { unsigned r; asm volatile("v_cvt_pk_bf16_f32 %0, %1, %2" : "=v"(r) : "v"(lo), "v"(hi)); return r; }
typedef float f32x2 __attribute__((ext_vector_type(2)));
typedef unsigned long long ss_t;
constexpr float SS_SCALE = 1048576.0f;
__device__ __forceinline__ float rstd_of(const ss_t* ss, int row) { return __builtin_amdgcn_rsqf((float)ss[row] * (1.0f / (1024.0f * SS_SCALE)) + 1e-6f); }
struct EpiScale {
    static constexpr bool PERM = true, AFTER_DRAIN = false;
    bf16_t* O; int ldc; const ss_t* ss;
    __device__ __forceinline__ void operator()(const f32x4 (&acc)[2][2][4][2], const Unit& u, int wr, int wc, int fr, int fq) const {
        const int row0 = u.pm * BM + wr * 64 + fr, col0 = u.pn * BM + wc * 32 + 8 * fq;
        float rsv[2][4];
#pragma unroll
        for (int ai = 0; ai < 2; ++ai)
#pragma unroll
            for (int m = 0; m < 4; ++m) rsv[ai][m] = rstd_of(ss, row0 + ai * HALF + m * 16);
#pragma unroll
        for (int ai = 0; ai < 2; ++ai)
#pragma unroll
            for (int m = 0; m < 4; ++m) { const int row = row0 + ai * HALF + m * 16; const float rs = rsv[ai][m]; bf16_t* rowp = O + (size_t)row * ldc + col0;
#pragma unroll
                for (int bj = 0; bj < 2; ++bj) { const f32x4 v0 = acc[ai][bj][m][0] * rs, v1 = acc[ai][bj][m][1] * rs;
                    u32x4 w; w.x = cvt_pk_bf16(v0[0], v0[1]); w.y = cvt_pk_bf16(v0[2], v0[3]); w.z = cvt_pk_bf16(v1[0], v1[1]); w.w = cvt_pk_bf16(v1[2], v1[3]);
                    *(u32x4*)(rowp + bj * HALF) = w; }
                asm volatile("" ::: "memory"); }
    }
};
__device__ __forceinline__ float silu_mul(float g, float u) { const float e = __builtin_amdgcn_exp2f(g * -1.4426950408889634f); return g * u * __builtin_amdgcn_rcpf(1.0f + e); }
struct EpiSwiglu {
    static constexpr bool PERM = true, AFTER_DRAIN = false;
    bf16_t* H; int ldh; const ss_t* ss;
    __device__ __forceinline__ void operator()(const f32x4 (&acc)[2][2][4][2], const Unit& u, int wr, int wc, int fr, int fq) const {
        const int row0 = u.pm * BM + wr * 64 + fr, col0 = u.pn * HALF + wc * 32 + 8 * fq;
        float rsv[2][4];
#pragma unroll
        for (int ai = 0; ai < 2; ++ai)
#pragma unroll
            for (int m = 0; m < 4; ++m) rsv[ai][m] = rstd_of(ss, row0 + ai * HALF + m * 16);
#pragma unroll
        for (int ai = 0; ai < 2; ++ai)
#pragma unroll
            for (int m = 0; m < 4; ++m) { const int row = row0 + ai * HALF + m * 16; const float rs = rsv[ai][m];
                const f32x4 g0 = acc[ai][0][m][0] * rs, g1 = acc[ai][0][m][1] * rs, u0 = acc[ai][1][m][0] * rs, u1 = acc[ai][1][m][1] * rs;
                u32x4 w; w.x = cvt_pk_bf16(silu_mul(g0[0], u0[0]), silu_mul(g0[1], u0[1])); w.y = cvt_pk_bf16(silu_mul(g0[2], u0[2]), silu_mul(g0[3], u0[3]));
                w.z = cvt_pk_bf16(silu_mul(g1[0], u1[0]), silu_mul(g1[1], u1[1])); w.w = cvt_pk_bf16(silu_mul(g1[2], u1[2]), silu_mul(g1[3], u1[3]));
                *(u32x4*)(H + (size_t)row * ldh + col0) = w; asm volatile("" ::: "memory"); }
    }
};
__device__ __forceinline__ float bfl(unsigned u) { return __builtin_bit_cast(float, u << 16); }
__device__ __forceinline__ float bfh(unsigned u) { return __builtin_bit_cast(float, u & 0xffff0000u); }
struct EpiResid {
    static constexpr bool PERM = true, AFTER_DRAIN = false;
    bf16_t* XB; ss_t* ssn; float alpha;
    __device__ __forceinline__ void operator()(const f32x4 (&acc)[2][2][4][2], const Unit& u, int wr, int wc, int fr, int fq) const {
        const int row0 = u.pm * BM + wr * 64 + fr, col0 = u.pn * BM + wc * 32 + 8 * fq;
        u32x4 xv[2][4][2];
#pragma unroll
        for (int ai = 0; ai < 2; ++ai)
#pragma unroll
            for (int m = 0; m < 4; ++m) { const bf16_t* bp = XB + (size_t)(row0 + ai * HALF + m * 16) * 1024 + col0; xv[ai][m][0] = *(const u32x4*)bp; xv[ai][m][1] = *(const u32x4*)(bp + HALF); }
#pragma unroll
        for (int ai = 0; ai < 2; ++ai)
#pragma unroll
            for (int m = 0; m < 4; ++m) { const int row = row0 + ai * HALF + m * 16; bf16_t* bp = XB + (size_t)row * 1024 + col0; float q = 0.f;
#pragma unroll
                for (int bj = 0; bj < 2; ++bj) { const u32x4 x = xv[ai][m][bj]; const f32x4 a0 = acc[ai][bj][m][0] * alpha, a1 = acc[ai][bj][m][1] * alpha;
                    const float y0 = bfl(x.x) + a0[0], y1 = bfh(x.x) + a0[1], y2 = bfl(x.y) + a0[2], y3 = bfh(x.y) + a0[3], y4 = bfl(x.z) + a1[0], y5 = bfh(x.z) + a1[1], y6 = bfl(x.w) + a1[2], y7 = bfh(x.w) + a1[3];
                    u32x4 w; w.x = cvt_pk_bf16(y0, y1); w.y = cvt_pk_bf16(y2, y3); w.z = cvt_pk_bf16(y4, y5); w.w = cvt_pk_bf16(y6, y7);
                    *(u32x4*)(bp + bj * HALF) = w;
                    q += (y0 * y0 + y1 * y1) + (y2 * y2 + y3 * y3) + (y4 * y4 + y5 * y5) + (y6 * y6 + y7 * y7); }
                q += __shfl_xor(q, 16); q += __shfl_xor(q, 32);
                if (fq == 0) __hip_atomic_fetch_add(ssn + row, (ss_t)(q * SS_SCALE), __ATOMIC_RELAXED, __HIP_MEMORY_SCOPE_AGENT); }
    }
};
template <class Epi, class Sched, bool ALIGN_EPI = false, bool SP2 = false>
__device__ __forceinline__ void gemm_phase(PG8_LAS unsigned char* lds, const Gemm g, const Sched& S, const Epi& E) {
    int tid = threadIdx.x; asm volatile("" : "+v"(tid)); const int wid = __builtin_amdgcn_readfirstlane(tid >> 6), lane = tid & 63, wr = wid >> 2, wc = wid & 3, fr = lane & 15, fq = lane >> 4;
    const int K = g.K, nt = K / BK;
    unsigned voffA[2], voffB[2];
#pragma unroll
    for (int i = 0; i < 2; ++i) { int R, C; stage_rc(tid * 16 + i * 8192, R, C); const int Rb = Epi::PERM ? ((R & ~31) + perm32(R & 31)) : R;
        voffA[i] = (unsigned)(R * K + C) * 2u; voffB[i] = (unsigned)(Rb * K + C) * 2u; }
    const size_t kstep = (size_t)(BK * 2);
    const size_t hstep = (size_t)HALF * K * 2;
    const size_t tstep = 2 * hstep;
    const unsigned ldsw = (unsigned)wid * 1024u;
    const int aoff = lds_byte(wr * 64 + fr, fq * 8), boff = lds_byte(wc * 32 + fr, fq * 8);
#define PG8_SA(b, h) (((b) * 2 + (h)) * HTB)
#define PG8_SB(b, h) ((4 + (b) * 2 + (h)) * HTB)
#define PG8_STAGE(bufoff, gbase, voff) do { _Pragma("unroll") for (int _i = 0; _i < 2; ++_i) \
        __builtin_amdgcn_global_load_lds((const unsigned*)((const char*)(gbase) + (voff)[_i]), (PG8_LAS unsigned*)(lds + (bufoff) + ldsw + _i * 8192), 16, 0, 0); } while (0)
#define PG8_LDA(dst, b, h) do { _Pragma("unroll") for (int m = 0; m < 4; ++m) _Pragma("unroll") for (int k = 0; k < 2; ++k) dst[m][k] = *(const PG8_LAS bf16x8*)(lds + PG8_SA(b, h) + aoff + m * 2048 + k * 1024); } while (0)
#define PG8_LDB(dst, b, h) do { _Pragma("unroll") for (int n = 0; n < 2; ++n) _Pragma("unroll") for (int k = 0; k < 2; ++k) dst[n][k] = *(const PG8_LAS bf16x8*)(lds + PG8_SB(b, h) + boff + n * 2048 + k * 1024); } while (0)
#define PG8_MMA(ai, bj, At, Bt) do { __builtin_amdgcn_s_setprio(1); _Pragma("unroll") for (int m = 0; m < 4; ++m) _Pragma("unroll") for (int n = 0; n < 2; ++n) _Pragma("unroll") for (int k = 0; k < 2; ++k) \
        acc[ai][bj][m][n] = __builtin_amdgcn_mfma_f32_16x16x32_bf16(Bt[n][k], At[m][k], acc[ai][bj][m][n], 0, 0, 0); __builtin_amdgcn_s_setprio(0); } while (0)
#define PG8_WAIT_V(n) asm volatile("s_waitcnt vmcnt(" #n ")" ::: "memory")
#define PG8_WAIT_L(n) asm volatile("s_waitcnt lgkmcnt(" #n ")" ::: "memory")
#define PG8_BAR __builtin_amdgcn_s_barrier()
#define PG8_SCHED __builtin_amdgcn_sched_barrier(0)
    Unit cur, nxt; int ui = 0;
    if (!S.next(0, cur)) return;
    f32x4 acc[2][2][4][2];
#pragma unroll
    for (int a = 0; a < 2; ++a)
#pragma unroll
        for (int b = 0; b < 2; ++b)
#pragma unroll
            for (int m = 0; m < 4; ++m)
#pragma unroll
                for (int n = 0; n < 2; ++n) acc[a][b][m][n] = (f32x4){0.f, 0.f, 0.f, 0.f};
    bf16x8 At[4][2], B0[2][2], B1[2][2];
    const char* cA = (const char*)g.A + (size_t)cur.pm * tstep; const char* cB = (const char*)g.Bt + (size_t)cur.pn * tstep;
    S.a_ready(cur);
    if constexpr (SP2) {
        PG8_STAGE(PG8_SB(0, 0), cB, voffB); PG8_STAGE(PG8_SB(0, 1), cB + hstep, voffB); PG8_STAGE(PG8_SA(0, 0), cA, voffA); PG8_STAGE(PG8_SA(0, 1), cA + hstep, voffA);
        if (wr == 1) PG8_BAR;
        PG8_WAIT_V(2); PG8_BAR;
        PG8_STAGE(PG8_SB(1, 0), cB + kstep, voffB); PG8_STAGE(PG8_SA(1, 0), cA + kstep, voffA); PG8_STAGE(PG8_SB(1, 1), cB + hstep + kstep, voffB);
        PG8_WAIT_V(6); PG8_BAR;
    } else {
        PG8_STAGE(PG8_SB(0, 0), cB, voffB); PG8_STAGE(PG8_SA(0, 0), cA, voffA); PG8_STAGE(PG8_SB(0, 1), cB + hstep, voffB); PG8_STAGE(PG8_SA(0, 1), cA + hstep, voffA);
        if (wr == 1) PG8_BAR;
        PG8_WAIT_V(4); PG8_BAR;
        PG8_STAGE(PG8_SB(1, 0), cB + kstep, voffB); PG8_STAGE(PG8_SA(1, 0), cA + kstep, voffA); PG8_STAGE(PG8_SB(1, 1), cB + hstep + kstep, voffB);
        PG8_WAIT_V(6); PG8_BAR;
    }
    for (;;) {
        const bool has_next = S.next(ui + 1, nxt);
        const char* nA = has_next ? (const char*)g.A + (size_t)nxt.pm * tstep : cA; const char* nB = has_next ? (const char*)g.Bt + (size_t)nxt.pn * tstep : cB;
        for (int t = 0; t < nt; t += 2) {
            const bool last = (t == nt - 2);
            const char* a1 = cA + (size_t)(t + 1) * kstep;
            const char* a2 = last ? nA : cA + (size_t)(t + 2) * kstep; const char* b2 = last ? nB : cB + (size_t)(t + 2) * kstep;
            const char* a3 = a2 + kstep; const char* b3 = b2 + kstep;
            if (last && has_next) S.a_ready(nxt);
            if constexpr (SP2) {
            PG8_LDB(B0, 0, 0); PG8_LDB(B1, 0, 1); PG8_SCHED; PG8_LDA(At, 0, 0); PG8_STAGE(PG8_SA(1, 1), a1 + hstep, voffA);
            PG8_WAIT_V(8); PG8_WAIT_L(0); PG8_BAR; PG8_MMA(0, 0, At, B0); PG8_MMA(0, 1, At, B1); PG8_BAR; PG8_SCHED;
            PG8_LDA(At, 0, 1); PG8_STAGE(PG8_SB(0, 0), b2, voffB); PG8_STAGE(PG8_SB(0, 1), b2 + hstep, voffB); PG8_STAGE(PG8_SA(0, 0), a2, voffA);
            PG8_WAIT_V(8); PG8_WAIT_L(0); PG8_BAR; PG8_MMA(1, 0, At, B0); PG8_MMA(1, 1, At, B1); PG8_BAR; PG8_SCHED;
            PG8_LDB(B0, 1, 0); PG8_LDB(B1, 1, 1); PG8_SCHED; PG8_LDA(At, 1, 0); PG8_STAGE(PG8_SA(0, 1), a2 + hstep, voffA);
            PG8_WAIT_V(8); PG8_WAIT_L(0); PG8_BAR; PG8_MMA(0, 0, At, B0); PG8_MMA(0, 1, At, B1); PG8_BAR; PG8_SCHED;
            PG8_LDA(At, 1, 1); PG8_STAGE(PG8_SB(1, 0), b3, voffB); PG8_STAGE(PG8_SB(1, 1), b3 + hstep, voffB); PG8_STAGE(PG8_SA(1, 0), a3, voffA);
            PG8_WAIT_V(8); PG8_WAIT_L(0); PG8_BAR; PG8_MMA(1, 0, At, B0); PG8_MMA(1, 1, At, B1); PG8_BAR; PG8_SCHED;
            } else {
            PG8_LDB(B0, 0, 0); PG8_SCHED; PG8_LDA(At, 0, 0); PG8_STAGE(PG8_SA(1, 1), a1 + hstep, voffA);
            PG8_WAIT_L(8); PG8_BAR; PG8_WAIT_L(0); PG8_MMA(0, 0, At, B0); PG8_BAR; PG8_SCHED;
            PG8_LDB(B1, 0, 1); PG8_STAGE(PG8_SB(0, 0), b2, voffB);
            PG8_BAR; PG8_WAIT_L(0); PG8_MMA(0, 1, At, B1); PG8_BAR;
            PG8_LDA(At, 0, 1); PG8_STAGE(PG8_SA(0, 0), a2, voffA);
            PG8_BAR; PG8_WAIT_L(0); PG8_MMA(1, 0, At, B0); PG8_BAR; PG8_SCHED;
            PG8_STAGE(PG8_SB(0, 1), b2 + hstep, voffB);
            PG8_WAIT_V(6); PG8_BAR; PG8_MMA(1, 1, At, B1); PG8_BAR;
            PG8_LDB(B0, 1, 0); PG8_SCHED; PG8_LDA(At, 1, 0); PG8_STAGE(PG8_SA(0, 1), a2 + hstep, voffA);
            PG8_WAIT_L(8); PG8_BAR; PG8_WAIT_L(0); PG8_MMA(0, 0, At, B0); PG8_BAR; PG8_SCHED;
            PG8_LDB(B1, 1, 1); PG8_STAGE(PG8_SB(1, 0), b3, voffB);
            PG8_BAR; PG8_WAIT_L(0); PG8_MMA(0, 1, At, B1); PG8_BAR;
            PG8_LDA(At, 1, 1); PG8_STAGE(PG8_SA(1, 0), a3, voffA);
            PG8_BAR; PG8_WAIT_L(0); PG8_MMA(1, 0, At, B0); PG8_BAR; PG8_SCHED;
            PG8_STAGE(PG8_SB(1, 1), b3 + hstep, voffB);
            PG8_WAIT_V(6); PG8_BAR; PG8_MMA(1, 1, At, B1); PG8_BAR;
            }
        }
        if constexpr (ALIGN_EPI) { if (wr == 0) PG8_BAR; }
        if constexpr (!Epi::AFTER_DRAIN) { E(acc, cur, wr, wc, fr, fq); S.done(cur); }
        if (!has_next) break;
#pragma unroll
        for (int a = 0; a < 2; ++a)
#pragma unroll
            for (int b = 0; b < 2; ++b)
#pragma unroll
                for (int m = 0; m < 4; ++m)
#pragma unroll
                    for (int n = 0; n < 2; ++n) acc[a][b][m][n] = (f32x4){0.f, 0.f, 0.f, 0.f};
        cur = nxt; cA = nA; cB = nB; ++ui;
        if constexpr (ALIGN_EPI) { if (wr == 1) PG8_BAR; }
    }
    PG8_WAIT_V(0);
    if constexpr (!ALIGN_EPI) { if (wr == 0) PG8_BAR; }
    PG8_BAR;
    if constexpr (Epi::AFTER_DRAIN) { E.fused(acc, cur, wr, wc, fr, fq, lds, wid, lane); S.done(cur); }
#undef PG8_SA
#undef PG8_SB
#undef PG8_STAGE
#undef PG8_LDA
#undef PG8_LDB
#undef PG8_MMA
#undef PG8_WAIT_V
#undef PG8_WAIT_L
#undef PG8_BAR
#undef PG8_SCHED
}
}

#ifndef MK_N_LAUNCHES
#define MK_N_LAUNCHES 1
#endif
constexpr int NWAVES = 8;
constexpr int BATCH = 2, SEQ = 8192, D = 1024, FF = 2816, M = BATCH * SEQ, DEPTH = 4;
constexpr int NIN_CONV = 2560, NQKV = 3072, NHEAD = 16;
constexpr size_t MiB = 1u << 20;
constexpr size_t WS_CTL = 0, CTL_ZERO_BYTES = 2 * MiB;
constexpr size_t WS_SS = 64 * 1024;
constexpr size_t WS_LSE = 2 * MiB;
constexpr size_t WS_W = 8 * MiB, W_STRIDE = 44 * MiB;
constexpr size_t WS_XB = 96 * MiB;
constexpr size_t WS_ACT = 128 * MiB;
constexpr size_t WS_OG = 224 * MiB;
constexpr size_t WS_MG = 320 * MiB;
constexpr size_t WS_END = 352 * MiB;
constexpr size_t OW_GU1 = 0, OW_D1 = OW_GU1 + (size_t)2 * FF * D, OW_MI = OW_D1 + (size_t)D * FF, OW_MO = OW_MI + (size_t)NQKV * D, OW_GU2 = OW_MO + (size_t)D * D, OW_D2 = OW_GU2 + (size_t)2 * FF * D, OW_END = OW_D2 + (size_t)D * FF;
static_assert(OW_END * 2 <= W_STRIDE, "weight buffer");
constexpr int LDS_BYTES = 147456;
constexpr int CW_BAR = 4096;
constexpr int MISC_OFF = 131072 + 320;

#define LAS __attribute__((address_space(3)))
typedef unsigned short bf16;
typedef unsigned v4u __attribute__((ext_vector_type(4)));
typedef unsigned v2u __attribute__((ext_vector_type(2)));
typedef float f32x4 __attribute__((ext_vector_type(4)));
typedef short bf16x8 __attribute__((ext_vector_type(8)));
typedef short s16x4 __attribute__((ext_vector_type(4)));
#define LDS_WAIT() asm volatile("s_waitcnt lgkmcnt(0)" ::: "memory")
__device__ __forceinline__ unsigned pk2(float lo, float hi) { return pg8::cvt_pk_bf16(lo, hi); }
__device__ __forceinline__ int opq(int x) { asm volatile("" : "+v"(x)); return x; }
__device__ __forceinline__ float bf_lo(unsigned u) { return __uint_as_float(u << 16); }
__device__ __forceinline__ float bf_hi(unsigned u) { return __uint_as_float(u & 0xffff0000u); }
__device__ __forceinline__ float wave_sum(float v) {
#pragma unroll
    for (int o = 1; o < 64; o <<= 1) v += __shfl_xor(v, o);
    return v;
}

__device__ __forceinline__ void cvt_item(const float* __restrict__ W, int K, int N, bf16* WT, int dst_row0, int k0, int n0, const float* __restrict__ g, float cs, LAS float* scr, int lane) {
    float wv[32];
#pragma unroll
    for (int i = 0; i < 32; ++i) { const int kk = 2 * i + (lane >> 5); wv[i] = W[(size_t)(k0 + kk) * N + n0 + (lane & 31)]; }
#pragma unroll
    for (int i = 0; i < 32; ++i) { const int kk = 2 * i + (lane >> 5); const float gk = g ? g[k0 + kk] * cs : cs; scr[kk * 33 + (lane & 31)] = wv[i] * gk; }
    LDS_WAIT(); asm volatile("" ::: "memory");
    const int c = lane & 7;
#pragma unroll
    for (int j = 0; j < 4; ++j) { const int n = (lane >> 3) + 8 * j; const LAS float* s = scr + (8 * c) * 33 + n;
        v4u o; o.x = pk2(s[0 * 33], s[1 * 33]); o.y = pk2(s[2 * 33], s[3 * 33]); o.z = pk2(s[4 * 33], s[5 * 33]); o.w = pk2(s[6 * 33], s[7 * 33]);
        *(v4u*)(WT + (size_t)(dst_row0 + n) * K + k0 + 8 * c) = o; }
    LDS_WAIT(); asm volatile("" ::: "memory");
}
struct LayerW { const float *gu1, *d1, *mi, *mo, *gu2, *d2, *g1, *gm, *g2; int even; };
__device__ __forceinline__ void convert_layer(const LayerW& w, bf16* WB, int part, LAS unsigned char* lds, int gw, int NGW, int wave, int lane) {
    LAS float* scr = (LAS float*)(lds + wave * 16384);
    const int nmi = w.even ? NIN_CONV : NQKV;
    const int I_GU = (D / 64) * (2 * FF / 32), I_D = (FF / 64) * (D / 32), I_MI = (D / 64) * (nmi / 32), I_MO = (D / 64) * (D / 32);
    const int NITEMS = part == 0 ? I_GU + I_D : I_GU + I_D + I_MI + I_MO;
    for (int it = gw; it < NITEMS; it += NGW) {
        int r = it;
        if (r < I_GU) { const int nblk = 2 * FF / 32, kb = r / nblk, nb = r % nblk, n0 = nb * 32;
            const int j0 = n0 < FF ? n0 : n0 - FF; const int dst = (j0 >> 7) * 256 + (n0 < FF ? 0 : 128) + (j0 & 127);
            cvt_item(part ? w.gu2 : w.gu1, D, 2 * FF, WB + (part ? OW_GU2 : OW_GU1), dst, kb * 64, n0, part ? w.g2 : w.g1, 1.0f, scr, lane); continue; }
        r -= I_GU;
        if (r < I_D) { const int nblk = D / 32, kb = r / nblk, nb = r % nblk;
            cvt_item(part ? w.d2 : w.d1, FF, D, WB + (part ? OW_D2 : OW_D1), nb * 32, kb * 64, nb * 32, nullptr, 1.0f, scr, lane); continue; }
        r -= I_D;
        if (r < I_MI) { const int nblk = nmi / 32, kb = r / nblk, nb = r % nblk, n0 = nb * 32;
            const float cs = (!w.even && n0 < D) ? 0.125f * 1.4426950408889634f : 1.0f;
            cvt_item(w.mi, D, nmi, WB + OW_MI, n0, kb * 64, n0, w.gm, cs, scr, lane); continue; }
        r -= I_MI;
        { const int nblk = D / 32, kb = r / nblk, nb = r % nblk; cvt_item(w.mo, D, D, WB + OW_MO, nb * 32, kb * 64, nb * 32, nullptr, 1.0f, scr, lane); }
    }
}

constexpr int KP = 144;
constexpr int ATT_K = 0, ATT_V = 272 * KP;
__device__ __forceinline__ void attn_phase(LAS unsigned char* lds, const bf16* __restrict__ QKV, bf16* OG, float* LSE, int G, int vcu) {
    const int tid = opq(threadIdx.x), lane = tid & 63, wid = __builtin_amdgcn_readfirstlane(tid >> 6), fr = lane & 15, fq = lane >> 4;
    const unsigned z1 = (unsigned)opq(0); const v4u zero4 = (v4u){z1, z1, z1, z1};
    for (int i = tid; i < 2 * 272 * KP / 16; i += 512) *(LAS v4u*)(lds + i * 16) = zero4;
    f32x4 relf[9];
#pragma unroll
    for (int j = 0; j < 9; ++j)
#pragma unroll
        for (int r = 0; r < 4; ++r) { const int rel = 128 + fr - 16 * j - 4 * fq - r; relf[j][r] = (rel >= 0 && rel <= 128) ? (float)rel : 1e30f; }
    const int total = 3 * BATCH * NHEAD * 64;
    const int per = (total + G - 1) / G, u_beg = vcu * per, u_end = (u_beg + per < total) ? u_beg + per : total;
    v4u kreg[2], vreg[2];
#define ATT_DECODE(u) const int g_ = (u) >> 11, rem_ = (u) & 2047, b_ = rem_ >> 10, h_ = (rem_ >> 6) & 15, rb_ = rem_ & 63, sh_ = 2 * g_, nl_ = 6 - sh_, r_ = rb_ >> nl_, n_ = rb_ & ((1 << nl_) - 1)
#define ATT_PREFETCH(u, nb) do { ATT_DECODE(u); _Pragma("unroll") for (int i = 0; i < 2; ++i) { const int idx = tid + 512 * i, k = idx >> 3, ch = idx & 7; const int j = 128 * (n_ + (nb)) + k; \
        const bf16* src = QKV + ((size_t)(b_ * SEQ + (j << sh_) + r_)) * NQKV + D + h_ * 64 + ch * 8; kreg[i] = *(const v4u*)src; vreg[i] = *(const v4u*)(src + D); } } while (0)
#define ATT_STORE(slot) do { _Pragma("unroll") for (int i = 0; i < 2; ++i) { const int idx = tid + 512 * i, k = idx >> 3, ch = idx & 7; \
        *(LAS v4u*)(lds + ATT_K + ((slot) * 128 + k) * KP + ch * 16) = kreg[i]; *(LAS v4u*)(lds + ATT_V + ((slot) * 128 + k) * KP + ch * 16) = vreg[i]; } } while (0)
    int p = 0;
    __syncthreads();
    if (u_beg < u_end) { { ATT_DECODE(u_beg); if (n_ > 0) { ATT_PREFETCH(u_beg, -1); ATT_STORE(0); } }
        ATT_PREFETCH(u_beg, 0); }
    for (int u = u_beg; u < u_end; ++u) {
        __syncthreads();
        ATT_STORE(1 - p);
        __syncthreads();
        ATT_DECODE(u);
        const int dil = 1 << sh_;
        const size_t qrow = (size_t)(b_ * SEQ + ((128 * n_ + 16 * wid + fr) << sh_) + r_);
        const bf16* qp = QKV + qrow * NQKV + h_ * 64 + fq * 8;
        const bf16x8 qf0 = *(const bf16x8*)qp, qf1 = *(const bf16x8*)(qp + 32);
        if (u + 1 < u_end) ATT_PREFETCH(u + 1, 0);
        const float ncb = -__builtin_amdgcn_exp2f(-0.5f * (float)(h_ + 1)) * (float)dil * 1.4426950408889634f;
        f32x4 s[9];
#define ATT_ROWB(T) ((T) < 8 ? p * 128 + 16 * (T) : ((T) < 16 ? (1 - p) * 128 + 16 * ((T) - 8) : 256))
        const LAS unsigned char* kb = lds + ATT_K + fr * KP + fq * 16;
        float mx = -3.0e38f;
#pragma unroll
        for (int j = 0; j < 9; ++j) { const int rbk = ATT_ROWB(wid + j); const bf16x8 k0 = *(const LAS bf16x8*)(kb + rbk * KP), k1 = *(const LAS bf16x8*)(kb + rbk * KP + 64);
            f32x4 a = relf[j] * ncb;
            a = __builtin_amdgcn_mfma_f32_16x16x32_bf16(k0, qf0, a, 0, 0, 0); a = __builtin_amdgcn_mfma_f32_16x16x32_bf16(k1, qf1, a, 0, 0, 0);
            if (n_ == 0 && wid + j < 8) a = (f32x4){-1e30f, -1e30f, -1e30f, -1e30f};
            s[j] = a; mx = fmaxf(fmaxf(mx, fmaxf(a[0], a[1])), fmaxf(a[2], a[3])); }
        mx = fmaxf(mx, __shfl_xor(mx, 16)); mx = fmaxf(mx, __shfl_xor(mx, 32));
        float l = 0.f;
#pragma unroll
        for (int j = 0; j < 9; ++j)
#pragma unroll
            for (int r = 0; r < 4; ++r) { const float p = __builtin_amdgcn_exp2f(s[j][r] - mx); s[j][r] = p; l += p; }
        l += __shfl_xor(l, 16); l += __shfl_xor(l, 32);
        f32x4 o[4];
#pragma unroll
        for (int dt = 0; dt < 4; ++dt) o[dt] = (f32x4){0.f, 0.f, 0.f, 0.f};
        const LAS unsigned char* vb = lds + ATT_V + (4 * fq + (fr >> 2)) * KP + (fr & 3) * 8;
#pragma unroll
        for (int gk = 0; gk < 5; ++gk) {
            v4u pw; pw.x = pk2(s[2 * gk][0], s[2 * gk][1]); pw.y = pk2(s[2 * gk][2], s[2 * gk][3]);
            if (gk < 4) { pw.z = pk2(s[(2 * gk + 1) % 9][0], s[(2 * gk + 1) % 9][1]); pw.w = pk2(s[(2 * gk + 1) % 9][2], s[(2 * gk + 1) % 9][3]); } else { pw.z = 0u; pw.w = 0u; }
            const bf16x8 pb = __builtin_bit_cast(bf16x8, pw);
            const int rv0 = ATT_ROWB(wid + 2 * gk), rv1 = ATT_ROWB(wid + 2 * gk + 1);
#pragma unroll
            for (int dt = 0; dt < 4; ++dt) {
                const s16x4 lo = __builtin_bit_cast(s16x4, __builtin_amdgcn_ds_read_tr16_b64_v4i16((LAS s16x4*)(vb + rv0 * KP + dt * 32)));
                const s16x4 hi = __builtin_bit_cast(s16x4, __builtin_amdgcn_ds_read_tr16_b64_v4i16((LAS s16x4*)(vb + rv1 * KP + dt * 32)));
                const bf16x8 vf = (bf16x8){lo[0], lo[1], lo[2], lo[3], hi[0], hi[1], hi[2], hi[3]};
                o[dt] = __builtin_amdgcn_mfma_f32_16x16x32_bf16(vf, pb, o[dt], 0, 0, 0);
            }
        }
        const float il = __builtin_amdgcn_rcpf(l);
        bf16* op = OG + (size_t)g_ * M * D + qrow * D + h_ * 64 + 4 * fq;
#pragma unroll
        for (int dt = 0; dt < 4; ++dt) { v2u w; w.x = pk2(o[dt][0] * il, o[dt][1] * il); w.y = pk2(o[dt][2] * il, o[dt][3] * il); *(v2u*)(op + dt * 16) = w; }
        if (fq == 0) LSE[(size_t)g_ * M * NHEAD + qrow * NHEAD + h_] = mx + __builtin_amdgcn_logf(l);
        p ^= 1;
    }
#undef ATT_STORE
#undef ATT_ROWB
#undef ATT_DECODE
#undef ATT_PREFETCH
}
__device__ __forceinline__ void merge_phase(const bf16* __restrict__ OG, const float* __restrict__ LSE, bf16* MG, int G, int bid) {
    const size_t nth = (size_t)G * 512;
    const int tid = opq(threadIdx.x);
    for (size_t idx = (size_t)bid * 512 + tid; idx < (size_t)M * 128; idx += nth) {
        const size_t row = idx >> 7; const int c = (int)(idx & 127), h = c >> 3;
        const float l0 = LSE[row * NHEAD + h], l1 = LSE[(size_t)M * NHEAD + row * NHEAD + h], l2 = LSE[(size_t)2 * M * NHEAD + row * NHEAD + h];
        const float mx = fmaxf(l0, fmaxf(l1, l2));
        float w0 = __builtin_amdgcn_exp2f(l0 - mx), w1 = __builtin_amdgcn_exp2f(l1 - mx), w2 = __builtin_amdgcn_exp2f(l2 - mx);
        const float inv = __builtin_amdgcn_rcpf(w0 + w1 + w2); w0 *= inv; w1 *= inv; w2 *= inv;
        const v4u a = *(const v4u*)(OG + row * D + c * 8), b = *(const v4u*)(OG + (size_t)M * D + row * D + c * 8), cc = *(const v4u*)(OG + (size_t)2 * M * D + row * D + c * 8);
        v4u o;
#pragma unroll
        for (int i = 0; i < 4; ++i) o[i] = pk2(w0 * bf_lo(a[i]) + w1 * bf_lo(b[i]) + w2 * bf_lo(cc[i]), w0 * bf_hi(a[i]) + w1 * bf_hi(b[i]) + w2 * bf_hi(cc[i]));
        *(v4u*)(MG + row * D + c * 8) = o;
    }
}

__device__ __forceinline__ float sigmoidf_(float x) { return __builtin_amdgcn_rcpf(1.0f + __builtin_amdgcn_exp2f(x * -1.4426950408889634f)); }
__device__ __forceinline__ void conv_phase(LAS unsigned char* lds, const bf16* __restrict__ Z, bf16* CAT, const float* __restrict__ wa, const float* __restrict__ wb, const float* __restrict__ bias,
                                           const float* __restrict__ lng, const float* __restrict__ lnb, int G, int vcu) {
    const int tid = opq(threadIdx.x), lane = tid & 63, wid = __builtin_amdgcn_readfirstlane(tid >> 6), cp = tid & 255, th = tid >> 8;
    LAS float* red = (LAS float*)(lds + 62 * 1024);
    const unsigned z1 = (unsigned)opq(0); const v4u zero4 = (v4u){z1, z1, z1, z1};
    float w0[31], w1[31];
#pragma unroll
    for (int k = 0; k < 31; ++k) { const v2u w = *(const v2u*)(wb + k * 512 + 2 * cp); w0[k] = __uint_as_float(w.x); w1[k] = __uint_as_float(w.y); }
    for (int unit = vcu; unit < M / 32; unit += G) {
        const int row0 = unit * 32, s0 = row0 & (SEQ - 1);
        __syncthreads();
#pragma unroll 1
        for (int hb = 0; hb < 2; ++hb) { v4u bv[4], bg[4];
#pragma unroll
          for (int i = 0; i < 4; ++i) { const int it = tid + 512 * (4 * hb + i), lr = it >> 6, ch = it & 63; bv[i] = zero4; bg[i] = zero4;
              if (it < 62 * 64 && s0 - 30 + lr >= 0) { const bf16* zp = Z + (size_t)(row0 - 30 + lr) * NIN_CONV + 1536 + ch * 8; bv[i] = *(const v4u*)zp; bg[i] = *(const v4u*)(zp + 512); } }
#pragma unroll
          for (int i = 0; i < 4; ++i) { const int it = tid + 512 * (4 * hb + i), lr = it >> 6, ch = it & 63; v4u o;
#pragma unroll
              for (int e = 0; e < 4; ++e) o[e] = pk2(bf_lo(bv[i][e]) * sigmoidf_(bf_lo(bg[i][e])), bf_hi(bv[i][e]) * sigmoidf_(bf_hi(bg[i][e])));
              if (it < 62 * 64) *(LAS v4u*)(lds + lr * 1024 + ch * 16) = o; } }
        __syncthreads();
        float acc[16][2];
        { const v2u b = *(const v2u*)(bias + 2 * cp); const float b0 = __uint_as_float(b.x), b1 = __uint_as_float(b.y);
#pragma unroll
          for (int t = 0; t < 16; ++t) { acc[t][0] = b0; acc[t][1] = b1; } }
        const LAS unsigned char* up = lds + (th * 16) * 1024 + cp * 4;
#pragma unroll
        for (int j = 0; j < 46; ++j) { const unsigned uu = *(const LAS unsigned*)(up + j * 1024); const float ul = bf_lo(uu), uh = bf_hi(uu);
#pragma unroll
            for (int t = 0; t < 16; ++t) { const int k = j - t; if (k >= 0 && k < 31) { acc[t][0] += w0[k] * ul; acc[t][1] += w1[k] * uh; } } }
#pragma unroll
        for (int t = 0; t < 16; ++t) { const float s1 = wave_sum(acc[t][0] + acc[t][1]), s2 = wave_sum(acc[t][0] * acc[t][0] + acc[t][1] * acc[t][1]);
            if (lane == 0) { red[(wid * 16 + t) * 2] = s1; red[(wid * 16 + t) * 2 + 1] = s2; } }
        __syncthreads();
        { const float g0 = lng[2 * cp], g1 = lng[2 * cp + 1], c0 = lnb[2 * cp], c1 = lnb[2 * cp + 1];
#pragma unroll
          for (int t = 0; t < 16; ++t) { float s1 = 0.f, s2 = 0.f;
#pragma unroll
              for (int w = 0; w < 4; ++w) { s1 += red[((th * 4 + w) * 16 + t) * 2]; s2 += red[((th * 4 + w) * 16 + t) * 2 + 1]; }
              const float mean = s1 * (1.0f / 512.0f), var = fmaxf(s2 * (1.0f / 512.0f) - mean * mean, 0.f), rstd = __builtin_amdgcn_rsqf(var + 1e-5f);
              const float y0 = (acc[t][0] - mean) * rstd * g0 + c0, y1 = (acc[t][1] - mean) * rstd * g1 + c1;
              *(unsigned*)(CAT + (size_t)(row0 + th * 16 + t) * D + 512 + 2 * cp) = pk2(y0 * sigmoidf_(y0), y1 * sigmoidf_(y1)); } }
        { const float a00 = wa[2 * cp], a01 = wa[2 * cp + 1], a10 = wa[512 + 2 * cp], a11 = wa[512 + 2 * cp + 1], a20 = wa[1024 + 2 * cp], a21 = wa[1024 + 2 * cp + 1];
          unsigned zc[18], zx[18], zb[16];
#pragma unroll
          for (int t = -2; t < 16; ++t) { const int s = s0 + th * 16 + t; const bf16* zp = Z + (size_t)(row0 + th * 16 + t) * NIN_CONV + 2 * cp; zc[t + 2] = 0u; zx[t + 2] = 0u;
              if (s >= 0) { zc[t + 2] = *(const unsigned*)(zp + 512); zx[t + 2] = *(const unsigned*)(zp + 1024); }
              if (t >= 0) zb[t] = *(const unsigned*)zp; }
          float p2x = 0.f, p2y = 0.f, p1x = 0.f, p1y = 0.f;
#pragma unroll
          for (int t = -2; t < 16; ++t) { const float px = bf_lo(zc[t + 2]) * bf_lo(zx[t + 2]), py = bf_hi(zc[t + 2]) * bf_hi(zx[t + 2]);
              if (t >= 0) { const float y0 = bf_lo(zb[t]) * (a00 * p2x + a10 * p1x + a20 * px), y1 = bf_hi(zb[t]) * (a01 * p2y + a11 * p1y + a21 * py);
                  *(unsigned*)(CAT + (size_t)(row0 + th * 16 + t) * D + 2 * cp) = pk2(y0, y1); }
              p2x = p1x; p2y = p1y; p1x = px; p1y = py; } }
    }
}

typedef __attribute__((address_space(1))) unsigned gu32;
#define XB_TMO      128
#define XB_XCNT(j)  (256  + 64 * (j))
#define XB_XSUB(j)  (1280 + 64 * (j))
#define XB_XGEN(j)  (2304 + 64 * (j))
#define XB_TOP      3328
#define XB_TOPGEN   3392
#define XCD_BAR_WORDS 3456
#define XB_SPIN_CAP (1u << 18)

__device__ __forceinline__ unsigned xb_ld(unsigned* p)              { return __hip_atomic_load(p, __ATOMIC_RELAXED, __HIP_MEMORY_SCOPE_AGENT); }
__device__ __forceinline__ unsigned xb_add(unsigned* p, unsigned v) { return __hip_atomic_fetch_add(p, v, __ATOMIC_RELAXED, __HIP_MEMORY_SCOPE_AGENT); }
__device__ __forceinline__ unsigned xb_xcc_id() { return (unsigned)__builtin_amdgcn_s_getreg((3 << 11) | 20) & 0xFu; }
#define XB_SPIN(cond, bar) do { unsigned _sp = 0; while (cond) { __builtin_amdgcn_s_sleep(1); \
    if ((++_sp & 255u) == 0u) { if (xb_ld(&(bar)[XB_TMO])) break; if (_sp > XB_SPIN_CAP) { atomicAdd(&(bar)[XB_TMO], 1u); break; } } } } while (0)

struct XcdBarrier {
    unsigned* bar; unsigned x;
    volatile LAS unsigned* st;
};

__device__ __forceinline__ XcdBarrier xcd_barrier_post(unsigned* bar, volatile LAS unsigned* st) {
    XcdBarrier b; b.bar = bar; b.x = xb_xcc_id(); b.st = st;
    if (threadIdx.x == 0) (void)xb_add(&bar[XB_XCNT(b.x)], 1u);
    return b;
}
__device__ __forceinline__ void xcd_barrier_complete(unsigned* bar, unsigned x, unsigned& nloc, unsigned& nx) {
    const unsigned G = gridDim.x * gridDim.y * gridDim.z;
    unsigned sum, cnt, mine, sp = 0u;
    for (;;) {
        sum = 0u; cnt = 0u; mine = 0u;
#pragma unroll
        for (unsigned j = 0; j < 16; ++j) { const unsigned c = xb_ld(&bar[XB_XCNT(j)]); sum += c; cnt += (c > 0u) ? 1u : 0u; mine = (j == x) ? c : mine; }
        if (sum == G) break;
        __builtin_amdgcn_s_sleep(1);
        if ((++sp & 255u) == 0u) { if (xb_ld(&bar[XB_TMO])) break; if (sp > XB_SPIN_CAP) { atomicAdd(&bar[XB_TMO], 1u); break; } }
    }
    nloc = mine > 0u ? mine : 1u; nx = cnt > 0u ? cnt : 1u;
}

__device__ __forceinline__ void xcd_barrier(const XcdBarrier& b) {
    asm volatile("s_waitcnt vmcnt(0)" ::: "memory");
    __syncthreads();
    if (threadIdx.x == 0) {
        unsigned* bar = b.bar;
        __builtin_amdgcn_s_waitcnt(0);
        unsigned nloc = b.st[0], nx = b.st[1];
        if (nloc == 0u) { xcd_barrier_complete(bar, b.x, nloc, nx); b.st[0] = nloc; b.st[1] = nx; }
        const unsigned old = xb_add(&bar[XB_XSUB(b.x)], 1u);
        const unsigned gen = old / nloc;
        if (old + 1u == (gen + 1u) * nloc) {
            __builtin_amdgcn_fence(__ATOMIC_RELEASE, "agent");
            asm volatile("s_waitcnt vmcnt(0)" ::: "memory");
            const unsigned og = xb_add(&bar[XB_TOP], 1u);
            const unsigned tg = og / nx;
            if (og + 1u == (tg + 1u) * nx) xb_add(&bar[XB_TOPGEN], 1u);
            else XB_SPIN(xb_ld(&bar[XB_TOPGEN]) == tg, bar);
            __builtin_amdgcn_fence(__ATOMIC_ACQUIRE, "agent");
            xb_add(&bar[XB_XGEN(b.x)], 1u);
            asm volatile("s_waitcnt vmcnt(0)" ::: "memory");
        } else {
            XB_SPIN(xb_ld(&bar[XB_XGEN(b.x)]) == gen, bar);
            __builtin_amdgcn_fence(__ATOMIC_ACQUIRE, "agent");
            asm volatile("s_waitcnt vmcnt(0)" ::: "memory");
        }
    }
    __syncthreads();
}

struct Args { const float* in[18]; float* out; unsigned char* ws; int ph_lo, ph_hi; };
__global__ void __launch_bounds__(NWAVES * 64, 2) mk_fwd(Args args) {
    extern __shared__ __attribute__((aligned(16))) unsigned char lds_raw[];
    LAS unsigned char* lds = (LAS unsigned char*)lds_raw;
    cg::grid_group grid = cg::this_grid();
    for (int u = threadIdx.x; u < (LDS_BYTES - 131072) / 4; u += NWAVES * 64) ((LAS unsigned*)(lds + 131072))[u] = 0u;
    __syncthreads();
#if MK_N_LAUNCHES == 1
    grid.sync();
#endif
    const XcdBarrier xbar = xcd_barrier_post((unsigned*)(args.ws + WS_CTL) + CW_BAR, (volatile LAS unsigned*)(lds + MISC_OFF) + 8);
    const int G = gridDim.x, bx = blockIdx.x, vcu = (G % 8 == 0) ? (bx % 8) * (G / 8) + bx / 8 : bx;
    const int NGW = G * NWAVES;
#define TID_VARS const int tid = opq(threadIdx.x), lane = tid & 63, wave = __builtin_amdgcn_readfirstlane(tid >> 6), gw = vcu * NWAVES + wave; (void)gw; (void)lane
    unsigned char* ws = args.ws;
    float* X = args.out;
    pg8::ss_t* SS = (pg8::ss_t*)(ws + WS_SS); float* LSE = (float*)(ws + WS_LSE);
    bf16* XB = (bf16*)(ws + WS_XB); bf16* ACT = (bf16*)(ws + WS_ACT); bf16* OG = (bf16*)(ws + WS_OG); bf16* MG = (bf16*)(ws + WS_MG);
    const int lo = args.ph_lo, hi = args.ph_hi;
    int ph = 0;
#define PH_ON (ph >= lo && ph < hi)
#define GRID_BAR() do { asm volatile("s_waitcnt vmcnt(0)" ::: "memory"); grid.sync(); __builtin_amdgcn_fence(__ATOMIC_ACQUIRE, "agent"); asm volatile("s_waitcnt vmcnt(0)" ::: "memory"); } while (0)
#ifdef DUP_BAR
#define PH_END do { if (PH_ON && ph + 1 < hi) { if (ph == 0) GRID_BAR(); else { xcd_barrier(xbar); xcd_barrier(xbar); } } ++ph; } while (0)
#else
#define PH_END do { if (PH_ON && ph + 1 < hi) xcd_barrier(xbar); ++ph; } while (0)
#endif
#define MAKE_LW(lw, L) LayerW lw; { const int L_ = (L), i_ = L_ >> 1; lw.even = !(L_ & 1); \
        lw.gu1 = args.in[2] + (size_t)L_ * D * 2 * FF; lw.d1 = args.in[3] + (size_t)L_ * FF * D; lw.gu2 = args.in[6] + (size_t)L_ * D * 2 * FF; lw.d2 = args.in[7] + (size_t)L_ * FF * D; \
        lw.g1 = args.in[1] + L_ * D; lw.gm = args.in[4] + L_ * D; lw.g2 = args.in[5] + L_ * D; \
        lw.mi = lw.even ? args.in[8] + (size_t)i_ * D * NIN_CONV : args.in[15] + (size_t)i_ * D * NQKV; lw.mo = lw.even ? args.in[14] + (size_t)i_ * D * D : args.in[16] + (size_t)i_ * D * D; }

    if (PH_ON) {
        TID_VARS;
        const float* x = args.in[0];
        for (int m = gw; m < M; m += NGW) { const f32x4* xr = (const f32x4*)(x + (size_t)m * D) + lane; f32x4 v[4]; float s = 0.f;
#pragma unroll
            for (int j = 0; j < 4; ++j) { v[j] = xr[64 * j]; s += (v[j].x * v[j].x + v[j].y * v[j].y) + (v[j].z * v[j].z + v[j].w * v[j].w); }
            s = wave_sum(s);
            v2u* bo = (v2u*)(XB + (size_t)m * D) + lane;
#pragma unroll
            for (int j = 0; j < 4; ++j) { v2u w; w.x = pk2(v[j].x, v[j].y); w.y = pk2(v[j].z, v[j].w); bo[64 * j] = w; }
            if (lane == 0) SS[m] = (pg8::ss_t)(s * pg8::SS_SCALE); }
        MAKE_LW(lw, 0); convert_layer(lw, (bf16*)(ws + WS_W), 0, lds, gw, NGW, wave, lane);
    }
    PH_END;

    for (int sb = 0; sb < 3 * DEPTH; ++sb) {
        const int L = sb / 3, kind = sb % 3, even = !(L & 1);
        bf16* WB = (bf16*)(ws + WS_W + (size_t)(L & 1) * W_STRIDE);
        pg8::ss_t* ss_in = SS + (size_t)sb * M; pg8::ss_t* ss_out = SS + (size_t)(sb + 1) * M;
        if (kind != 1) {
            if (PH_ON) { pg8::Gemm g{XB, WB + (kind ? OW_GU2 : OW_GU1), M, 2 * FF, D}; pg8::StaticOrder S; S.init(M, 2 * FF, G, bx);
                pg8::EpiSwiglu E{ACT, FF, ss_in};

#ifndef NO_G1
                pg8::gemm_phase<pg8::EpiSwiglu, pg8::StaticOrder, true, true>(lds, g, S, E);
#endif
#ifdef DUP_G1
                xcd_barrier(xbar); pg8::gemm_phase<pg8::EpiSwiglu, pg8::StaticOrder, true, true>(lds, g, S, E);
#endif
                { const int nwg = (M / 256) * (2 * FF / 256), ntail = nwg % G, cl = (kind == 0) ? L : L + 1;
                  if (ntail > 0 && bx >= ntail && cl < DEPTH) { TID_VARS; MAKE_LW(lw, cl);
                      convert_layer(lw, (bf16*)(ws + WS_W + (size_t)(cl & 1) * W_STRIDE), kind == 0 ? 1 : 0, lds, (bx - ntail) * NWAVES + wave, (G - ntail) * NWAVES, wave, lane); }
                  else if (ntail == 0 && cl < DEPTH) { TID_VARS; MAKE_LW(lw, cl); convert_layer(lw, (bf16*)(ws + WS_W + (size_t)(cl & 1) * W_STRIDE), kind == 0 ? 1 : 0, lds, gw, NGW, wave, lane); } }
            }
            PH_END;
            if (PH_ON) { pg8::Gemm g{ACT, WB + (kind ? OW_D2 : OW_D1), M, D, FF}; pg8::StaticOrder S; S.init(M, D, G, bx);
                pg8::EpiResid E{XB, ss_out, 0.5f};
#ifndef NO_G2
                pg8::gemm_phase<pg8::EpiResid, pg8::StaticOrder, true, true>(lds, g, S, E);
#endif
#ifdef DUP_G2
                xcd_barrier(xbar); { pg8::EpiResid E2{XB, SS + (size_t)13 * M, 0.0f}; pg8::gemm_phase<pg8::EpiResid, pg8::StaticOrder, true, true>(lds, g, S, E2); }
#endif
            }
            PH_END;
        } else {
            const int nmi = even ? NIN_CONV : NQKV;
            if (PH_ON) { pg8::Gemm g{XB, WB + OW_MI, M, nmi, D}; pg8::StaticOrder S; S.init(M, nmi, G, bx);
                pg8::EpiScale E{ACT, nmi, ss_in};

#ifndef NO_G3
                pg8::gemm_phase<pg8::EpiScale, pg8::StaticOrder, true, true>(lds, g, S, E);
#endif
#ifdef DUP_G3
                xcd_barrier(xbar); pg8::gemm_phase<pg8::EpiScale, pg8::StaticOrder, true, true>(lds, g, S, E);
#endif
            }
            PH_END;
            if (PH_ON) {
                const int i = L >> 1;
                if (even) {
#ifndef NO_CONV
                    conv_phase(lds, ACT, OG, args.in[9] + i * 3 * 512, args.in[10] + i * 31 * 512, args.in[11] + i * 512, args.in[12] + i * 512, args.in[13] + i * 512, G, vcu);
#endif
#ifdef DUP_CONV
                    __syncthreads(); conv_phase(lds, ACT, OG, args.in[9] + i * 3 * 512, args.in[10] + i * 31 * 512, args.in[11] + i * 512, args.in[12] + i * 512, args.in[13] + i * 512, G, vcu);
#endif
                } else {
#ifndef NO_ATT
                    attn_phase(lds, ACT, OG, LSE, G, vcu);
#endif
#ifdef DUP_ATT
                    __syncthreads(); attn_phase(lds, ACT, OG, LSE, G, vcu);
#endif
                }
            }
            PH_END;
            if (!even) { if (PH_ON) { merge_phase(OG, LSE, MG, G, vcu);
#ifdef DUP_MERGE
                xcd_barrier(xbar); merge_phase(OG, LSE, MG, G, vcu);
#endif
            } PH_END; }
            if (PH_ON) { pg8::Gemm g{even ? OG : MG, WB + OW_MO, M, D, D}; pg8::StaticOrder S; S.init(M, D, G, bx);
                pg8::EpiResid E{XB, ss_out, 1.0f};
#ifndef NO_G4
                pg8::gemm_phase<pg8::EpiResid, pg8::StaticOrder, true, true>(lds, g, S, E);
#endif
#ifdef DUP_G4
                xcd_barrier(xbar); { pg8::EpiResid E2{XB, SS + (size_t)13 * M, 0.0f}; pg8::gemm_phase<pg8::EpiResid, pg8::StaticOrder, true, true>(lds, g, S, E2); }
#endif
            }
            PH_END;
        }
    }
    if (PH_ON) {
        TID_VARS;
        const float* gf = args.in[17]; const pg8::ss_t* ssf = SS + (size_t)12 * M;
        f32x4 gv[4];
#pragma unroll
        for (int j = 0; j < 4; ++j) gv[j] = ((const f32x4*)gf)[64 * j + lane];
        for (int m = gw; m < M; m += NGW) { f32x4* xo = (f32x4*)(X + (size_t)m * D) + lane; const v2u* xb = (const v2u*)(XB + (size_t)m * D) + lane; const float rs = pg8::rstd_of(ssf, m);
#pragma unroll
            for (int j = 0; j < 4; ++j) { const v2u w = xb[64 * j]; const f32x4 v = (f32x4){bf_lo(w.x), bf_hi(w.x), bf_lo(w.y), bf_hi(w.y)}; xo[64 * j] = v * rs * gv[j]; } }
    }
    ++ph;
}
constexpr int N_PHASES = 1 + 2 * (2 + 3 + 2) + 2 * (2 + 4 + 2) + 1;

extern "C" void kernel_launch(void* const* d_in, const int* in_sizes, int n_in, void* d_out, int out_size, void* d_ws, size_t ws_size, hipStream_t stream) {
    static int grid = 0;
    if (grid == 0) {
        if (n_in != 18 || in_sizes[0] != M * D || out_size != M * D || ws_size < WS_END) { fprintf(stderr, "kernel_launch: unexpected shapes (n_in %d, in0 %d, out %d, ws %zu)\n", n_in, n_in > 0 ? in_sizes[0] : -1, out_size, ws_size); grid = -1; return; }
        int dev = 0, cus = 0, per_cu = 0;
        hipGetDevice(&dev); hipDeviceGetAttribute(&cus, hipDeviceAttributeMultiprocessorCount, dev);
        if (hipFuncSetAttribute((const void*)mk_fwd, hipFuncAttributeMaxDynamicSharedMemorySize, LDS_BYTES) != hipSuccess) { fprintf(stderr, "kernel_launch: hipFuncSetAttribute failed\n"); grid = -1; return; }
        if (hipOccupancyMaxActiveBlocksPerMultiprocessor(&per_cu, (const void*)mk_fwd, NWAVES * 64, LDS_BYTES) != hipSuccess || per_cu < 1) { fprintf(stderr, "kernel_launch: occupancy query says %d\n", per_cu); per_cu = 1; }
        (void)hipGetLastError();
        grid = cus * (per_cu > 1 ? 1 : per_cu);
    }
    if (grid < 0) return;
    hipMemsetAsync((char*)d_ws + WS_CTL, 0, CTL_ZERO_BYTES, stream);
    Args a{};
    for (int i = 0; i < 18; ++i) a.in[i] = (const float*)d_in[i];
    a.out = (float*)d_out; a.ws = (unsigned char*)d_ws;
#if MK_N_LAUNCHES == 1
    a.ph_lo = 0; a.ph_hi = N_PHASES;
    void* kargs[] = {&a};
    hipError_t e = hipLaunchCooperativeKernel((const void*)mk_fwd, dim3(grid), dim3(NWAVES * 64), kargs, LDS_BYTES, stream);
    if (e != hipSuccess) fprintf(stderr, "kernel_launch: cooperative launch failed: %s (grid %d)\n", hipGetErrorString(e), grid);
#else
    for (int p = 0; p < N_PHASES; ++p) { a.ph_lo = p; a.ph_hi = p + 1; hipLaunchKernelGGL(mk_fwd, dim3(grid), dim3(NWAVES * 64), LDS_BYTES, stream, a); }
#endif
}
```

```cpp
#include <hip/hip_runtime.h>
#include <hip/hip_cooperative_groups.h>
#include <cstdio>
#include <cstdint>
namespace cg = cooperative_groups;
namespace pg8 {
#define PG8_LAS __attribute__((address_space(3)))
typedef unsigned short bf16_t;
typedef short bf16x8 __attribute__((ext_vector_type(8)));
typedef float f32x4 __attribute__((ext_vector_type(4)));
typedef unsigned u32x4 __attribute__((ext_vector_type(4)));
constexpr int BM = 256, BK = 64, HALF = 128, HTB = HALF * BK * 2  , STAGE_BYTES = 8 * HTB, NXCD = 8, WGM = 8;

__host__ __device__ __forceinline__ int lds_byte(int r, int c) { const int st = (r >> 4) * 2 + (c >> 5), rr = r & 15, cc = c & 31, ob = rr * 64 + cc * 2; return st * 1024 + (ob ^ (((ob >> 9) & 1) << 5)); }
__host__ __device__ __forceinline__ void stage_rc(int b, int& R, int& C) { const int st = b / 1024, sb = b % 1024, swz = sb ^ (((sb >> 9) & 1) << 5); R = (st >> 1) * 16 + swz / 64; C = (st & 1) * 32 + (swz % 64) / 2; }
__host__ __device__ __forceinline__ int perm32(int rho) { const int n = rho >> 4, i = rho & 15; return 8 * (i >> 2) + 4 * n + (i & 3); }

struct Unit { int pm, pn; };
struct Gemm { const bf16_t* A; const bf16_t* Bt; int M, N, K; };

struct StaticOrder {
    int nM, nN, nwg, G, c;
    __host__ __device__ void init(int M, int N, int G_, int c_) { nM = M / BM; nN = N / BM; nwg = nM * nN; G = G_; c = c_; }
    __host__ __device__ bool next(int i, Unit& u) const {
        const long L = (long)i * G + c; if (L >= nwg) return false;
        int wgid = (int)L; { const int q = nwg / NXCD, r = nwg % NXCD, xcd = wgid % NXCD, off = wgid / NXCD; wgid = (xcd < r ? xcd * (q + 1) : r * (q + 1) + (xcd - r) * q) + off; }
        const int nig = WGM * nN, gid = wgid / nig, fm = gid * WGM, gsz = (nM - fm) < WGM ? (nM - fm) : WGM;
        u.pm = fm + ((wgid % nig) % gsz); u.pn = (wgid % nig) / gsz; return true;
    }
    __device__ __forceinline__ void a_ready(const Unit&) const {}
    __device__ __forceinline__ void done(const Unit&) const {}
};

__device__ __forceinline__ unsigned cvt_pk_bf16(float lo, float hi) { unsigned r; asm volatile("v_cvt_pk_bf16_f32 %0, %1, %2" : "=v"(r) : "v"(lo), "v"(hi)); return r; }
typedef float f32x2 __attribute__((ext_vector_type(2)));
typedef unsigned long long ss_t;
constexpr float SS_SCALE = 1048576.0f;
__device__ __forceinline__ float rstd_of(const ss_t* ss, int row) { return __builtin_amdgcn_rsqf((float)ss[row] * (1.0f / (1024.0f * SS_SCALE)) + 1e-6f); }
struct EpiScale {
    static constexpr bool PERM = true, AFTER_DRAIN = false;
    bf16_t* O; int ldc; const ss_t* ss;
    __device__ __forceinline__ void operator()(const f32x4 (&acc)[2][2][4][2], const Unit& u, int wr, int wc, int fr, int fq) const {
        const int row0 = u.pm * BM + wr * 64 + fr, col0 = u.pn * BM + wc * 32 + 8 * fq;
        float rsv[2][4];
#pragma unroll
        for (int ai = 0; ai < 2; ++ai)
#pragma unroll
            for (int m = 0; m < 4; ++m) rsv[ai][m] = rstd_of(ss, row0 + ai * HALF + m * 16);
#pragma unroll
        for (int ai = 0; ai < 2; ++ai)
#pragma unroll
            for (int m = 0; m < 4; ++m) { const int row = row0 + ai * HALF + m * 16; const float rs = rsv[ai][m]; bf16_t* rowp = O + (size_t)row * ldc + col0;
#pragma unroll
                for (int bj = 0; bj < 2; ++bj) { const f32x4 v0 = acc[ai][bj][m][0] * rs, v1 = acc[ai][bj][m][1] * rs;
                    u32x4 w; w.x = cvt_pk_bf16(v0[0], v0[1]); w.y = cvt_pk_bf16(v0[2], v0[3]); w.z = cvt_pk_bf16(v1[0], v1[1]); w.w = cvt_pk_bf16(v1[2], v1[3]);
                    *(u32x4*)(rowp + bj * HALF) = w; }
                asm volatile("" ::: "memory"); }
    }
};
__device__ __forceinline__ float silu_mul(float g, float u) { const float e = __builtin_amdgcn_exp2f(g * -1.4426950408889634f); return g * u * __builtin_amdgcn_rcpf(1.0f + e); }
struct EpiSwiglu {
    static constexpr bool PERM = true, AFTER_DRAIN = false;
    bf16_t* H; int ldh; const ss_t* ss;
    __device__ __forceinline__ void operator()(const f32x4 (&acc)[2][2][4][2], const Unit& u, int wr, int wc, int fr, int fq) const {
        const int row0 = u.pm * BM + wr * 64 + fr, col0 = u.pn * HALF + wc * 32 + 8 * fq;
        float rsv[2][4];
#pragma unroll
        for (int ai = 0; ai < 2; ++ai)
#pragma unroll
            for (int m = 0; m < 4; ++m) rsv[ai][m] = rstd_of(ss, row0 + ai * HALF + m * 16);
#pragma unroll
        for (int ai = 0; ai < 2; ++ai)
#pragma unroll
            for (int m = 0; m < 4; ++m) { const int row = row0 + ai * HALF + m * 16; const float rs = rsv[ai][m];
                const f32x4 g0 = acc[ai][0][m][0] * rs, g1 = acc[ai][0][m][1] * rs, u0 = acc[ai][1][m][0] * rs, u1 = acc[ai][1][m][1] * rs;
                u32x4 w; w.x = cvt_pk_bf16(silu_mul(g0[0], u0[0]), silu_mul(g0[1], u0[1])); w.y = cvt_pk_bf16(silu_mul(g0[2], u0[2]), silu_mul(g0[3], u0[3]));
                w.z = cvt_pk_bf16(silu_mul(g1[0], u1[0]), silu_mul(g1[1], u1[1])); w.w = cvt_pk_bf16(silu_mul(g1[2], u1[2]), silu_mul(g1[3], u1[3]));
                *(u32x4*)(H + (size_t)row * ldh + col0) = w; asm volatile("" ::: "memory"); }
    }
};
__device__ __forceinline__ float bfl(unsigned u) { return __builtin_bit_cast(float, u << 16); }
__device__ __forceinline__ float bfh(unsigned u) { return __builtin_bit_cast(float, u & 0xffff0000u); }
struct EpiResid {
    static constexpr bool PERM = true, AFTER_DRAIN = false;
    bf16_t* XB; ss_t* ssn; float alpha;
    __device__ __forceinline__ void operator()(const f32x4 (&acc)[2][2][4][2], const Unit& u, int wr, int wc, int fr, int fq) const {
        const int row0 = u.pm * BM + wr * 64 + fr, col0 = u.pn * BM + wc * 32 + 8 * fq;
        u32x4 xv[2][4][2];
#pragma unroll
        for (int ai = 0; ai < 2; ++ai)
#pragma unroll
            for (int m = 0; m < 4; ++m) { const bf16_t* bp = XB + (size_t)(row0 + ai * HALF + m * 16) * 1024 + col0; xv[ai][m][0] = *(const u32x4*)bp; xv[ai][m][1] = *(const u32x4*)(bp + HALF); }
#pragma unroll
        for (int ai = 0; ai < 2; ++ai)
#pragma unroll
            for (int m = 0; m < 4; ++m) { const int row = row0 + ai * HALF + m * 16; bf16_t* bp = XB + (size_t)row * 1024 + col0; float q = 0.f;
#pragma unroll
                for (int bj = 0; bj < 2; ++bj) { const u32x4 x = xv[ai][m][bj]; const f32x4 a0 = acc[ai][bj][m][0] * alpha, a1 = acc[ai][bj][m][1] * alpha;
                    const float y0 = bfl(x.x) + a0[0], y1 = bfh(x.x) + a0[1], y2 = bfl(x.y) + a0[2], y3 = bfh(x.y) + a0[3], y4 = bfl(x.z) + a1[0], y5 = bfh(x.z) + a1[1], y6 = bfl(x.w) + a1[2], y7 = bfh(x.w) + a1[3];
                    u32x4 w; w.x = cvt_pk_bf16(y0, y1); w.y = cvt_pk_bf16(y2, y3); w.z = cvt_pk_bf16(y4, y5); w.w = cvt_pk_bf16(y6, y7);
                    *(u32x4*)(bp + bj * HALF) = w;
                    q += (y0 * y0 + y1 * y1) + (y2 * y2 + y3 * y3) + (y4 * y4 + y5 * y5) + (y6 * y6 + y7 * y7); }
                q += __shfl_xor(q, 16); q += __shfl_xor(q, 32);
                if (fq == 0) __hip_atomic_fetch_add(ssn + row, (ss_t)(q * SS_SCALE), __ATOMIC_RELAXED, __HIP_MEMORY_SCOPE_AGENT); }
    }
};
template <class Epi, class Sched, bool ALIGN_EPI = false, bool SP2 = false>
__device__ __forceinline__ void gemm_phase(PG8_LAS unsigned char* lds, const Gemm g, const Sched& S, const Epi& E) {
    int tid = threadIdx.x; asm volatile("" : "+v"(tid)); const int wid = __builtin_amdgcn_readfirstlane(tid >> 6), lane = tid & 63, wr = wid >> 2, wc = wid & 3, fr = lane & 15, fq = lane >> 4;
    const int K = g.K, nt = K / BK;
    unsigned voffA[2], voffB[2];
#pragma unroll
    for (int i = 0; i < 2; ++i) { int R, C; stage_rc(tid * 16 + i * 8192, R, C); const int Rb = Epi::PERM ? ((R & ~31) + perm32(R & 31)) : R;
        voffA[i] = (unsigned)(R * K + C) * 2u; voffB[i] = (unsigned)(Rb * K + C) * 2u; }
    const size_t kstep = (size_t)(BK * 2);
    const size_t hstep = (size_t)HALF * K * 2;
    const size_t tstep = 2 * hstep;
    const unsigned ldsw = (unsigned)wid * 1024u;
    const int aoff = lds_byte(wr * 64 + fr, fq * 8), boff = lds_byte(wc * 32 + fr, fq * 8);
#define PG8_SA(b, h) (((b) * 2 + (h)) * HTB)
#define PG8_SB(b, h) ((4 + (b) * 2 + (h)) * HTB)
#define PG8_STAGE(bufoff, gbase, voff) do { _Pragma("unroll") for (int _i = 0; _i < 2; ++_i) \
        __builtin_amdgcn_global_load_lds((const unsigned*)((const char*)(gbase) + (voff)[_i]), (PG8_LAS unsigned*)(lds + (bufoff) + ldsw + _i * 8192), 16, 0, 0); } while (0)
#define PG8_LDA(dst, b, h) do { _Pragma("unroll") for (int m = 0; m < 4; ++m) _Pragma("unroll") for (int k = 0; k < 2; ++k) dst[m][k] = *(const PG8_LAS bf16x8*)(lds + PG8_SA(b, h) + aoff + m * 2048 + k * 1024); } while (0)
#define PG8_LDB(dst, b, h) do { _Pragma("unroll") for (int n = 0; n < 2; ++n) _Pragma("unroll") for (int k = 0; k < 2; ++k) dst[n][k] = *(const PG8_LAS bf16x8*)(lds + PG8_SB(b, h) + boff + n * 2048 + k * 1024); } while (0)
#define PG8_MMA(ai, bj, At, Bt) do { __builtin_amdgcn_s_setprio(1); _Pragma("unroll") for (int m = 0; m < 4; ++m) _Pragma("unroll") for (int n = 0; n < 2; ++n) _Pragma("unroll") for (int k = 0; k < 2; ++k) \
        acc[ai][bj][m][n] = __builtin_amdgcn_mfma_f32_16x16x32_bf16(Bt[n][k], At[m][k], acc[ai][bj][m][n], 0, 0, 0); __builtin_amdgcn_s_setprio(0); } while (0)
#define PG8_WAIT_V(n) asm volatile("s_waitcnt vmcnt(" #n ")" ::: "memory")
#define PG8_WAIT_L(n) asm volatile("s_waitcnt lgkmcnt(" #n ")" ::: "memory")
#define PG8_BAR __builtin_amdgcn_s_barrier()
#define PG8_SCHED __builtin_amdgcn_sched_barrier(0)
    Unit cur, nxt; int ui = 0;
    if (!S.next(0, cur)) return;
    f32x4 acc[2][2][4][2];
#pragma unroll
    for (int a = 0; a < 2; ++a)
#pragma unroll
        for (int b = 0; b < 2; ++b)
#pragma unroll
            for (int m = 0; m < 4; ++m)
#pragma unroll
                for (int n = 0; n < 2; ++n) acc[a][b][m][n] = (f32x4){0.f, 0.f, 0.f, 0.f};
    bf16x8 At[4][2], B0[2][2], B1[2][2];
    const char* cA = (const char*)g.A + (size_t)cur.pm * tstep; const char* cB = (const char*)g.Bt + (size_t)cur.pn * tstep;
    S.a_ready(cur);
    if constexpr (SP2) {
        PG8_STAGE(PG8_SB(0, 0), cB, voffB); PG8_STAGE(PG8_SB(0, 1), cB + hstep, voffB); PG8_STAGE(PG8_SA(0, 0), cA, voffA); PG8_STAGE(PG8_SA(0, 1), cA + hstep, voffA);
        if (wr == 1) PG8_BAR;
        PG8_WAIT_V(2); PG8_BAR;
        PG8_STAGE(PG8_SB(1, 0), cB + kstep, voffB); PG8_STAGE(PG8_SA(1, 0), cA + kstep, voffA); PG8_STAGE(PG8_SB(1, 1), cB + hstep + kstep, voffB);
        PG8_WAIT_V(6); PG8_BAR;
    } else {
        PG8_STAGE(PG8_SB(0, 0), cB, voffB); PG8_STAGE(PG8_SA(0, 0), cA, voffA); PG8_STAGE(PG8_SB(0, 1), cB + hstep, voffB); PG8_STAGE(PG8_SA(0, 1), cA + hstep, voffA);
        if (wr == 1) PG8_BAR;
        PG8_WAIT_V(4); PG8_BAR;
        PG8_STAGE(PG8_SB(1, 0), cB + kstep, voffB); PG8_STAGE(PG8_SA(1, 0), cA + kstep, voffA); PG8_STAGE(PG8_SB(1, 1), cB + hstep + kstep, voffB);
        PG8_WAIT_V(6); PG8_BAR;
    }
    for (;;) {
        const bool has_next = S.next(ui + 1, nxt);
        const char* nA = has_next ? (const char*)g.A + (size_t)nxt.pm * tstep : cA; const char* nB = has_next ? (const char*)g.Bt + (size_t)nxt.pn * tstep : cB;
        for (int t = 0; t < nt; t += 2) {
            const bool last = (t == nt - 2);
            const char* a1 = cA + (size_t)(t + 1) * kstep;
            const char* a2 = last ? nA : cA + (size_t)(t + 2) * kstep; const char* b2 = last ? nB : cB + (size_t)(t + 2) * kstep;
            const char* a3 = a2 + kstep; const char* b3 = b2 + kstep;
            if (last && has_next) S.a_ready(nxt);
            if constexpr (SP2) {
            PG8_LDB(B0, 0, 0); PG8_LDB(B1, 0, 1); PG8_SCHED; PG8_LDA(At, 0, 0); PG8_STAGE(PG8_SA(1, 1), a1 + hstep, voffA);
            PG8_WAIT_V(8); PG8_WAIT_L(0); PG8_BAR; PG8_MMA(0, 0, At, B0); PG8_MMA(0, 1, At, B1); PG8_BAR; PG8_SCHED;
            PG8_LDA(At, 0, 1); PG8_STAGE(PG8_SB(0, 0), b2, voffB); PG8_STAGE(PG8_SB(0, 1), b2 + hstep, voffB); PG8_STAGE(PG8_SA(0, 0), a2, voffA);
            PG8_WAIT_V(8); PG8_WAIT_L(0); PG8_BAR; PG8_MMA(1, 0, At, B0); PG8_MMA(1, 1, At, B1); PG8_BAR; PG8_SCHED;
            PG8_LDB(B0, 1, 0); PG8_LDB(B1, 1, 1); PG8_SCHED; PG8_LDA(At, 1, 0); PG8_STAGE(PG8_SA(0, 1), a2 + hstep, voffA);
            PG8_WAIT_V(8); PG8_WAIT_L(0); PG8_BAR; PG8_MMA(0, 0, At, B0); PG8_MMA(0, 1, At, B1); PG8_BAR; PG8_SCHED;
            PG8_LDA(At, 1, 1); PG8_STAGE(PG8_SB(1, 0), b3, voffB); PG8_STAGE(PG8_SB(1, 1), b3 + hstep, voffB); PG8_STAGE(PG8_SA(1, 0), a3, voffA);
            PG8_WAIT_V(8); PG8_WAIT_L(0); PG8_BAR; PG8_MMA(1, 0, At, B0); PG8_MMA(1, 1, At, B1); PG8_BAR; PG8_SCHED;
            } else {
            PG8_LDB(B0, 0, 0); PG8_SCHED; PG8_LDA(At, 0, 0); PG8_STAGE(PG8_SA(1, 1), a1 + hstep, voffA);
            PG8_WAIT_L(8); PG8_BAR; PG8_WAIT_L(0); PG8_MMA(0, 0, At, B0); PG8_BAR; PG8_SCHED;
            PG8_LDB(B1, 0, 1); PG8_STAGE(PG8_SB(0, 0), b2, voffB);
            PG8_BAR; PG8_WAIT_L(0); PG8_MMA(0, 1, At, B1); PG8_BAR;
            PG8_LDA(At, 0, 1); PG8_STAGE(PG8_SA(0, 0), a2, voffA);
            PG8_BAR; PG8_WAIT_L(0); PG8_MMA(1, 0, At, B0); PG8_BAR; PG8_SCHED;
            PG8_STAGE(PG8_SB(0, 1), b2 + hstep, voffB);
            PG8_WAIT_V(6); PG8_BAR; PG8_MMA(1, 1, At, B1); PG8_BAR;
            PG8_LDB(B0, 1, 0); PG8_SCHED; PG8_LDA(At, 1, 0); PG8_STAGE(PG8_SA(0, 1), a2 + hstep, voffA);
            PG8_WAIT_L(8); PG8_BAR; PG8_WAIT_L(0); PG8_MMA(0, 0, At, B0); PG8_BAR; PG8_SCHED;
            PG8_LDB(B1, 1, 1); PG8_STAGE(PG8_SB(1, 0), b3, voffB);
            PG8_BAR; PG8_WAIT_L(0); PG8_MMA(0, 1, At, B1); PG8_BAR;
            PG8_LDA(At, 1, 1); PG8_STAGE(PG8_SA(1, 0), a3, voffA);
            PG8_BAR; PG8_WAIT_L(0); PG8_MMA(1, 0, At, B0); PG8_BAR; PG8_SCHED;
            PG8_STAGE(PG8_SB(1, 1), b3 + hstep, voffB);
            PG8_WAIT_V(6); PG8_BAR; PG8_MMA(1, 1, At, B1); PG8_BAR;
            }
        }
        if constexpr (ALIGN_EPI) { if (wr == 0) PG8_BAR; }
        if constexpr (!Epi::AFTER_DRAIN) { E(acc, cur, wr, wc, fr, fq); S.done(cur); }
        if (!has_next) break;
#pragma unroll
        for (int a = 0; a < 2; ++a)
#pragma unroll
            for (int b = 0; b < 2; ++b)
#pragma unroll
                for (int m = 0; m < 4; ++m)
#pragma unroll
                    for (int n = 0; n < 2; ++n) acc[a][b][m][n] = (f32x4){0.f, 0.f, 0.f, 0.f};
        cur = nxt; cA = nA; cB = nB; ++ui;
        if constexpr (ALIGN_EPI) { if (wr == 1) PG8_BAR; }
    }
    PG8_WAIT_V(0);
    if constexpr (!ALIGN_EPI) { if (wr == 0) PG8_BAR; }
    PG8_BAR;
    if constexpr (Epi::AFTER_DRAIN) { E.fused(acc, cur, wr, wc, fr, fq, lds, wid, lane); S.done(cur); }
#undef PG8_SA
#undef PG8_SB
#undef PG8_STAGE
#undef PG8_LDA
#undef PG8_LDB
#undef PG8_MMA
#undef PG8_WAIT_V
#undef PG8_WAIT_L
#undef PG8_BAR
#undef PG8_SCHED
}
}

#ifndef MK_N_LAUNCHES
#define MK_N_LAUNCHES 1
#endif
constexpr int NWAVES = 8;
constexpr int BATCH = 2, SEQ = 8192, D = 1024, FF = 2816, M = BATCH * SEQ, DEPTH = 4;
constexpr int NIN_CONV = 2560, NQKV = 3072, NHEAD = 16;
constexpr size_t MiB = 1u << 20;
constexpr size_t WS_CTL = 0, CTL_ZERO_BYTES = 2 * MiB;
constexpr size_t WS_SS = 64 * 1024;
constexpr size_t WS_LSE = 2 * MiB;
constexpr size_t WS_W = 8 * MiB, W_STRIDE = 44 * MiB;
constexpr size_t WS_XB = 96 * MiB;
constexpr size_t WS_ACT = 128 * MiB;
constexpr size_t WS_OG = 224 * MiB;
constexpr size_t WS_MG = 320 * MiB;
constexpr size_t WS_END = 352 * MiB;
constexpr size_t OW_GU1 = 0, OW_D1 = OW_GU1 + (size_t)2 * FF * D, OW_MI = OW_D1 + (size_t)D * FF, OW_MO = OW_MI + (size_t)NQKV * D, OW_GU2 = OW_MO + (size_t)D * D, OW_D2 = OW_GU2 + (size_t)2 * FF * D, OW_END = OW_D2 + (size_t)D * FF;
static_assert(OW_END * 2 <= W_STRIDE, "weight buffer");
constexpr int LDS_BYTES = 147456;
constexpr int CW_BAR = 4096;
constexpr int MISC_OFF = 131072 + 320;

#define LAS __attribute__((address_space(3)))
typedef unsigned short bf16;
typedef unsigned v4u __attribute__((ext_vector_type(4)));
typedef unsigned v2u __attribute__((ext_vector_type(2)));
typedef float f32x4 __attribute__((ext_vector_type(4)));
typedef short bf16x8 __attribute__((ext_vector_type(8)));
typedef short s16x4 __attribute__((ext_vector_type(4)));
#define LDS_WAIT() asm volatile("s_waitcnt lgkmcnt(0)" ::: "memory")
__device__ __forceinline__ unsigned pk2(float lo, float hi) { return pg8::cvt_pk_bf16(lo, hi); }
__device__ __forceinline__ int opq(int x) { asm volatile("" : "+v"(x)); return x; }
__device__ __forceinline__ float bf_lo(unsigned u) { return __uint_as_float(u << 16); }
__device__ __forceinline__ float bf_hi(unsigned u) { return __uint_as_float(u & 0xffff0000u); }
__device__ __forceinline__ float wave_sum(float v) {
#pragma unroll
    for (int o = 1; o < 64; o <<= 1) v += __shfl_xor(v, o);
    return v;
}

__device__ __forceinline__ void cvt_item(const float* __restrict__ W, int K, int N, bf16* WT, int dst_row0, int k0, int n0, const float* __restrict__ g, float cs, LAS float* scr, int lane) {
    float wv[32];
#pragma unroll
    for (int i = 0; i < 32; ++i) { const int kk = 2 * i + (lane >> 5); wv[i] = W[(size_t)(k0 + kk) * N + n0 + (lane & 31)]; }
#pragma unroll
    for (int i = 0; i < 32; ++i) { const int kk = 2 * i + (lane >> 5); const float gk = g ? g[k0 + kk] * cs : cs; scr[kk * 33 + (lane & 31)] = wv[i] * gk; }
    LDS_WAIT(); asm volatile("" ::: "memory");
    const int c = lane & 7;
#pragma unroll
    for (int j = 0; j < 4; ++j) { const int n = (lane >> 3) + 8 * j; const LAS float* s = scr + (8 * c) * 33 + n;
        v4u o; o.x = pk2(s[0 * 33], s[1 * 33]); o.y = pk2(s[2 * 33], s[3 * 33]); o.z = pk2(s[4 * 33], s[5 * 33]); o.w = pk2(s[6 * 33], s[7 * 33]);
        *(v4u*)(WT + (size_t)(dst_row0 + n) * K + k0 + 8 * c) = o; }
    LDS_WAIT(); asm volatile("" ::: "memory");
}
struct LayerW { const float *gu1, *d1, *mi, *mo, *gu2, *d2, *g1, *gm, *g2; int even; };
__device__ __forceinline__ void convert_layer(const LayerW& w, bf16* WB, int part, LAS unsigned char* lds, int gw, int NGW, int wave, int lane) {
    LAS float* scr = (LAS float*)(lds + wave * 16384);
    const int nmi = w.even ? NIN_CONV : NQKV;
    const int I_GU = (D / 64) * (2 * FF / 32), I_D = (FF / 64) * (D / 32), I_MI = (D / 64) * (nmi / 32), I_MO = (D / 64) * (D / 32);
    const int NITEMS = part == 0 ? I_GU + I_D : I_GU + I_D + I_MI + I_MO;
    for (int it = gw; it < NITEMS; it += NGW) {
        int r = it;
        if (r < I_GU) { const int nblk = 2 * FF / 32, kb = r / nblk, nb = r % nblk, n0 = nb * 32;
            const int j0 = n0 < FF ? n0 : n0 - FF; const int dst = (j0 >> 7) * 256 + (n0 < FF ? 0 : 128) + (j0 & 127);
            cvt_item(part ? w.gu2 : w.gu1, D, 2 * FF, WB + (part ? OW_GU2 : OW_GU1), dst, kb * 64, n0, part ? w.g2 : w.g1, 1.0f, scr, lane); continue; }
        r -= I_GU;
        if (r < I_D) { const int nblk = D / 32, kb = r / nblk, nb = r % nblk;
            cvt_item(part ? w.d2 : w.d1, FF, D, WB + (part ? OW_D2 : OW_D1), nb * 32, kb * 64, nb * 32, nullptr, 1.0f, scr, lane); continue; }
        r -= I_D;
        if (r < I_MI) { const int nblk = nmi / 32, kb = r / nblk, nb = r % nblk, n0 = nb * 32;
            const float cs = (!w.even && n0 < D) ? 0.125f * 1.4426950408889634f : 1.0f;
            cvt_item(w.mi, D, nmi, WB + OW_MI, n0, kb * 64, n0, w.gm, cs, scr, lane); continue; }
        r -= I_MI;
        { const int nblk = D / 32, kb = r / nblk, nb = r % nblk; cvt_item(w.mo, D, D, WB + OW_MO, nb * 32, kb * 64, nb * 32, nullptr, 1.0f, scr, lane); }
    }
}

constexpr int KP = 144;
constexpr int ATT_K = 0, ATT_V = 272 * KP;
__device__ __forceinline__ void attn_phase(LAS unsigned char* lds, const bf16* __restrict__ QKV, bf16* OG, float* LSE, int G, int vcu) {
    const int tid = opq(threadIdx.x), lane = tid & 63, wid = __builtin_amdgcn_readfirstlane(tid >> 6), fr = lane & 15, fq = lane >> 4;
    const unsigned z1 = (unsigned)opq(0); const v4u zero4 = (v4u){z1, z1, z1, z1};
    for (int i = tid; i < 2 * 272 * KP / 16; i += 512) *(LAS v4u*)(lds + i * 16) = zero4;
    f32x4 relf[9];
#pragma unroll
    for (int j = 0; j < 9; ++j)
#pragma unroll
        for (int r = 0; r < 4; ++r) { const int rel = 128 + fr - 16 * j - 4 * fq - r; relf[j][r] = (rel >= 0 && rel <= 128) ? (float)rel : 1e30f; }
    const int total = 3 * BATCH * NHEAD * 64;
    const int per = (total + G - 1) / G, u_beg = vcu * per, u_end = (u_beg + per < total) ? u_beg + per : total;
    v4u kreg[2], vreg[2];
#define ATT_DECODE(u) const int g_ = (u) >> 11, rem_ = (u) & 2047, b_ = rem_ >> 10, h_ = (rem_ >> 6) & 15, rb_ = rem_ & 63, sh_ = 2 * g_, nl_ = 6 - sh_, r_ = rb_ >> nl_, n_ = rb_ & ((1 << nl_) - 1)
#define ATT_PREFETCH(u, nb) do { ATT_DECODE(u); _Pragma("unroll") for (int i = 0; i < 2; ++i) { const int idx = tid + 512 * i, k = idx >> 3, ch = idx & 7; const int j = 128 * (n_ + (nb)) + k; \
        const bf16* src = QKV + ((size_t)(b_ * SEQ + (j << sh_) + r_)) * NQKV + D + h_ * 64 + ch * 8; kreg[i] = *(const v4u*)src; vreg[i] = *(const v4u*)(src + D); } } while (0)
#define ATT_STORE(slot) do { _Pragma("unroll") for (int i = 0; i < 2; ++i) { const int idx = tid + 512 * i, k = idx >> 3, ch = idx & 7; \
        *(LAS v4u*)(lds + ATT_K + ((slot) * 128 + k) * KP + ch * 16) = kreg[i]; *(LAS v4u*)(lds + ATT_V + ((slot) * 128 + k) * KP + ch * 16) = vreg[i]; } } while (0)
    bf16x8 qn0 = (bf16x8){0, 0, 0, 0, 0, 0, 0, 0}, qn1 = qn0;
#define ATT_QLOAD(u) do { ATT_DECODE(u); const bf16* qp_ = QKV + ((size_t)(b_ * SEQ + ((128 * n_ + 16 * wid + fr) << sh_) + r_)) * NQKV + h_ * 64 + fq * 8; qn0 = *(const bf16x8*)qp_; qn1 = *(const bf16x8*)(qp_ + 32); } while (0)
    int p = 0;
    __syncthreads();
    if (u_beg < u_end) { { ATT_DECODE(u_beg); if (n_ > 0) { ATT_PREFETCH(u_beg, -1); ATT_STORE(0); } }
        ATT_PREFETCH(u_beg, 0); ATT_QLOAD(u_beg); }
    for (int u = u_beg; u < u_end; ++u) {
        __syncthreads();
        ATT_STORE(1 - p);
        __syncthreads();
        ATT_DECODE(u);
        const int dil = 1 << sh_;
        const size_t qrow = (size_t)(b_ * SEQ + ((128 * n_ + 16 * wid + fr) << sh_) + r_);
        const bf16x8 qf0 = qn0, qf1 = qn1;
        if (u + 1 < u_end) { ATT_PREFETCH(u + 1, 0); ATT_QLOAD(u + 1); }
        const float ncb = -__builtin_amdgcn_exp2f(-0.5f * (float)(h_ + 1)) * (float)dil * 1.4426950408889634f;
        f32x4 s[9];
#define ATT_ROWB(T) ((T) < 8 ? p * 128 + 16 * (T) : ((T) < 16 ? (1 - p) * 128 + 16 * ((T) - 8) : 256))
        const LAS unsigned char* kb = lds + ATT_K + fr * KP + fq * 16;
        float mx = -3.0e38f;
#pragma unroll
        for (int j = 0; j < 9; ++j) { const int rbk = ATT_ROWB(wid + j); const bf16x8 k0 = *(const LAS bf16x8*)(kb + rbk * KP), k1 = *(const LAS bf16x8*)(kb + rbk * KP + 64);
            f32x4 a = relf[j] * ncb;
            a = __builtin_amdgcn_mfma_f32_16x16x32_bf16(k0, qf0, a, 0, 0, 0); a = __builtin_amdgcn_mfma_f32_16x16x32_bf16(k1, qf1, a, 0, 0, 0);
            if (n_ == 0 && wid + j < 8) a = (f32x4){-1e30f, -1e30f, -1e30f, -1e30f};
            s[j] = a; mx = fmaxf(fmaxf(mx, fmaxf(a[0], a[1])), fmaxf(a[2], a[3])); }
        mx = fmaxf(mx, __shfl_xor(mx, 16)); mx = fmaxf(mx, __shfl_xor(mx, 32));
        float l = 0.f;
#pragma unroll
        for (int j = 0; j < 9; ++j)
#pragma unroll
            for (int r = 0; r < 4; ++r) { const float p = __builtin_amdgcn_exp2f(s[j][r] - mx); s[j][r] = p; l += p; }
        l += __shfl_xor(l, 16); l += __shfl_xor(l, 32);
        f32x4 o[4];
#pragma unroll
        for (int dt = 0; dt < 4; ++dt) o[dt] = (f32x4){0.f, 0.f, 0.f, 0.f};
        const LAS unsigned char* vb = lds + ATT_V + (4 * fq + (fr >> 2)) * KP + (fr & 3) * 8;
#pragma unroll
        for (int gk = 0; gk < 5; ++gk) {
            v4u pw; pw.x = pk2(s[2 * gk][0], s[2 * gk][1]); pw.y = pk2(s[2 * gk][2], s[2 * gk][3]);
            if (gk < 4) { pw.z = pk2(s[(2 * gk + 1) % 9][0], s[(2 * gk + 1) % 9][1]); pw.w = pk2(s[(2 * gk + 1) % 9][2], s[(2 * gk + 1) % 9][3]); } else { pw.z = 0u; pw.w = 0u; }
            const bf16x8 pb = __builtin_bit_cast(bf16x8, pw);
            const int rv0 = ATT_ROWB(wid + 2 * gk), rv1 = ATT_ROWB(wid + 2 * gk + 1);
#pragma unroll
            for (int dt = 0; dt < 4; ++dt) {
                const s16x4 lo = __builtin_bit_cast(s16x4, __builtin_amdgcn_ds_read_tr16_b64_v4i16((LAS s16x4*)(vb + rv0 * KP + dt * 32)));
                const s16x4 hi = __builtin_bit_cast(s16x4, __builtin_amdgcn_ds_read_tr16_b64_v4i16((LAS s16x4*)(vb + rv1 * KP + dt * 32)));
                const bf16x8 vf = (bf16x8){lo[0], lo[1], lo[2], lo[3], hi[0], hi[1], hi[2], hi[3]};
                o[dt] = __builtin_amdgcn_mfma_f32_16x16x32_bf16(vf, pb, o[dt], 0, 0, 0);
            }
        }
        const float il = __builtin_amdgcn_rcpf(l);
        bf16* op = OG + (size_t)g_ * M * D + qrow * D + h_ * 64 + 4 * fq;
#pragma unroll
        for (int dt = 0; dt < 4; ++dt) { v2u w; w.x = pk2(o[dt][0] * il, o[dt][1] * il); w.y = pk2(o[dt][2] * il, o[dt][3] * il); *(v2u*)(op + dt * 16) = w; }
        if (fq == 0) LSE[(size_t)g_ * M * NHEAD + qrow * NHEAD + h_] = mx + __builtin_amdgcn_logf(l);
        p ^= 1;
    }
#undef ATT_STORE
#undef ATT_ROWB
#undef ATT_QLOAD
#undef ATT_DECODE
#undef ATT_PREFETCH
}
__device__ __forceinline__ void merge_phase(const bf16* __restrict__ OG, const float* __restrict__ LSE, bf16* MG, int G, int bid) {
    const int tid = opq(threadIdx.x);
    const size_t nth = (size_t)G * 512, total = (size_t)M * 128;
    for (size_t base = (size_t)bid * 512 + tid; base < total; base += 4 * nth) {
        v4u a[4], b[4], c[4]; float l0[4], l1[4], l2[4];
#pragma unroll
        for (int e = 0; e < 4; ++e) { const size_t idx = base + e * nth; if (idx < total) { const size_t row = idx >> 7; const int cc = (int)(idx & 127), h = cc >> 3;
            l0[e] = LSE[row * NHEAD + h]; l1[e] = LSE[(size_t)M * NHEAD + row * NHEAD + h]; l2[e] = LSE[(size_t)2 * M * NHEAD + row * NHEAD + h];
            a[e] = *(const v4u*)(OG + row * D + cc * 8); b[e] = *(const v4u*)(OG + (size_t)M * D + row * D + cc * 8); c[e] = *(const v4u*)(OG + (size_t)2 * M * D + row * D + cc * 8); } }
#pragma unroll
        for (int e = 0; e < 4; ++e) { const size_t idx = base + e * nth; if (idx < total) { const size_t row = idx >> 7; const int cc = (int)(idx & 127);
            const float mx = fmaxf(l0[e], fmaxf(l1[e], l2[e]));
            float w0 = __builtin_amdgcn_exp2f(l0[e] - mx), w1 = __builtin_amdgcn_exp2f(l1[e] - mx), w2 = __builtin_amdgcn_exp2f(l2[e] - mx);
            const float inv = __builtin_amdgcn_rcpf(w0 + w1 + w2); w0 *= inv; w1 *= inv; w2 *= inv;
            v4u o;
#pragma unroll
            for (int i = 0; i < 4; ++i) o[i] = pk2(w0 * bf_lo(a[e][i]) + w1 * bf_lo(b[e][i]) + w2 * bf_lo(c[e][i]), w0 * bf_hi(a[e][i]) + w1 * bf_hi(b[e][i]) + w2 * bf_hi(c[e][i]));
            *(v4u*)(MG + row * D + cc * 8) = o; } }
    }
}

__device__ __forceinline__ float sigmoidf_(float x) { return __builtin_amdgcn_rcpf(1.0f + __builtin_amdgcn_exp2f(x * -1.4426950408889634f)); }
__device__ __forceinline__ void conv_phase(LAS unsigned char* lds, const bf16* __restrict__ Z, bf16* CAT, const float* __restrict__ wa, const float* __restrict__ wb, const float* __restrict__ bias,
                                           const float* __restrict__ lng, const float* __restrict__ lnb, int G, int vcu) {
    const int tid = opq(threadIdx.x), lane = tid & 63, wid = __builtin_amdgcn_readfirstlane(tid >> 6), cp = tid & 255, th = tid >> 8;
    LAS float* red = (LAS float*)(lds + 62 * 1024);
    const unsigned z1 = (unsigned)opq(0); const v4u zero4 = (v4u){z1, z1, z1, z1};
    float w0[31], w1[31];
#pragma unroll
    for (int k = 0; k < 31; ++k) { const v2u w = *(const v2u*)(wb + k * 512 + 2 * cp); w0[k] = __uint_as_float(w.x); w1[k] = __uint_as_float(w.y); }
    for (int unit = vcu; unit < M / 32; unit += G) {
        const int row0 = unit * 32, s0 = row0 & (SEQ - 1);
        __syncthreads();
#pragma unroll 1
        for (int hb = 0; hb < 2; ++hb) { v4u bv[4], bg[4];
#pragma unroll
          for (int i = 0; i < 4; ++i) { const int it = tid + 512 * (4 * hb + i), lr = it >> 6, ch = it & 63; bv[i] = zero4; bg[i] = zero4;
              if (it < 62 * 64 && s0 - 30 + lr >= 0) { const bf16* zp = Z + (size_t)(row0 - 30 + lr) * NIN_CONV + 1536 + ch * 8; bv[i] = *(const v4u*)zp; bg[i] = *(const v4u*)(zp + 512); } }
#pragma unroll
          for (int i = 0; i < 4; ++i) { const int it = tid + 512 * (4 * hb + i), lr = it >> 6, ch = it & 63; v4u o;
#pragma unroll
              for (int e = 0; e < 4; ++e) o[e] = pk2(bf_lo(bv[i][e]) * sigmoidf_(bf_lo(bg[i][e])), bf_hi(bv[i][e]) * sigmoidf_(bf_hi(bg[i][e])));
              if (it < 62 * 64) *(LAS v4u*)(lds + lr * 1024 + ch * 16) = o; } }
        __syncthreads();
        float acc[16][2];
        { const v2u b = *(const v2u*)(bias + 2 * cp); const float b0 = __uint_as_float(b.x), b1 = __uint_as_float(b.y);
#pragma unroll
          for (int t = 0; t < 16; ++t) { acc[t][0] = b0; acc[t][1] = b1; } }
        const LAS unsigned char* up = lds + (th * 16) * 1024 + cp * 4;
#pragma unroll
        for (int j = 0; j < 46; ++j) { const unsigned uu = *(const LAS unsigned*)(up + j * 1024); const float ul = bf_lo(uu), uh = bf_hi(uu);
#pragma unroll
            for (int t = 0; t < 16; ++t) { const int k = j - t; if (k >= 0 && k < 31) { acc[t][0] += w0[k] * ul; acc[t][1] += w1[k] * uh; } } }
#pragma unroll
        for (int t = 0; t < 16; ++t) { const float s1 = wave_sum(acc[t][0] + acc[t][1]), s2 = wave_sum(acc[t][0] * acc[t][0] + acc[t][1] * acc[t][1]);
            if (lane == 0) { red[(wid * 16 + t) * 2] = s1; red[(wid * 16 + t) * 2 + 1] = s2; } }
        __syncthreads();
        { const float g0 = lng[2 * cp], g1 = lng[2 * cp + 1], c0 = lnb[2 * cp], c1 = lnb[2 * cp + 1];
#pragma unroll
          for (int t = 0; t < 16; ++t) { float s1 = 0.f, s2 = 0.f;
#pragma unroll
              for (int w = 0; w < 4; ++w) { s1 += red[((th * 4 + w) * 16 + t) * 2]; s2 += red[((th * 4 + w) * 16 + t) * 2 + 1]; }
              const float mean = s1 * (1.0f / 512.0f), var = fmaxf(s2 * (1.0f / 512.0f) - mean * mean, 0.f), rstd = __builtin_amdgcn_rsqf(var + 1e-5f);
              const float y0 = (acc[t][0] - mean) * rstd * g0 + c0, y1 = (acc[t][1] - mean) * rstd * g1 + c1;
              *(unsigned*)(CAT + (size_t)(row0 + th * 16 + t) * D + 512 + 2 * cp) = pk2(y0 * sigmoidf_(y0), y1 * sigmoidf_(y1)); } }
        { const float a00 = wa[2 * cp], a01 = wa[2 * cp + 1], a10 = wa[512 + 2 * cp], a11 = wa[512 + 2 * cp + 1], a20 = wa[1024 + 2 * cp], a21 = wa[1024 + 2 * cp + 1];
          unsigned zc[18], zx[18], zb[16];
#pragma unroll
          for (int t = -2; t < 16; ++t) { const int s = s0 + th * 16 + t; const bf16* zp = Z + (size_t)(row0 + th * 16 + t) * NIN_CONV + 2 * cp; zc[t + 2] = 0u; zx[t + 2] = 0u;
              if (s >= 0) { zc[t + 2] = *(const unsigned*)(zp + 512); zx[t + 2] = *(const unsigned*)(zp + 1024); }
              if (t >= 0) zb[t] = *(const unsigned*)zp; }
          float p2x = 0.f, p2y = 0.f, p1x = 0.f, p1y = 0.f;
#pragma unroll
          for (int t = -2; t < 16; ++t) { const float px = bf_lo(zc[t + 2]) * bf_lo(zx[t + 2]), py = bf_hi(zc[t + 2]) * bf_hi(zx[t + 2]);
              if (t >= 0) { const float y0 = bf_lo(zb[t]) * (a00 * p2x + a10 * p1x + a20 * px), y1 = bf_hi(zb[t]) * (a01 * p2y + a11 * p1y + a21 * py);
                  *(unsigned*)(CAT + (size_t)(row0 + th * 16 + t) * D + 2 * cp) = pk2(y0, y1); }
              p2x = p1x; p2y = p1y; p1x = px; p1y = py; } }
    }
}

typedef __attribute__((address_space(1))) unsigned gu32;
#define XB_TMO      128
#define XB_XCNT(j)  (256  + 64 * (j))
#define XB_XSUB(j)  (1280 + 64 * (j))
#define XB_XGEN(j)  (2304 + 64 * (j))
#define XB_TOP      3328
#define XB_TOPGEN   3392
#define XCD_BAR_WORDS 3456
#define XB_SPIN_CAP (1u << 18)

__device__ __forceinline__ unsigned xb_ld(unsigned* p)              { return __hip_atomic_load(p, __ATOMIC_RELAXED, __HIP_MEMORY_SCOPE_AGENT); }
__device__ __forceinline__ unsigned xb_add(unsigned* p, unsigned v) { return __hip_atomic_fetch_add(p, v, __ATOMIC_RELAXED, __HIP_MEMORY_SCOPE_AGENT); }
__device__ __forceinline__ unsigned xb_xcc_id() { return (unsigned)__builtin_amdgcn_s_getreg((3 << 11) | 20) & 0xFu; }
#define XB_SPIN(cond, bar) do { unsigned _sp = 0; while (cond) { __builtin_amdgcn_s_sleep(1); \
    if ((++_sp & 255u) == 0u) { if (xb_ld(&(bar)[XB_TMO])) break; if (_sp > XB_SPIN_CAP) { atomicAdd(&(bar)[XB_TMO], 1u); break; } } } } while (0)

struct XcdBarrier {
    unsigned* bar; unsigned x;
    volatile LAS unsigned* st;
};

__device__ __forceinline__ XcdBarrier xcd_barrier_post(unsigned* bar, volatile LAS unsigned* st) {
    XcdBarrier b; b.bar = bar; b.x = xb_xcc_id(); b.st = st;
    if (threadIdx.x == 0) (void)xb_add(&bar[XB_XCNT(b.x)], 1u);
    return b;
}
__device__ __forceinline__ void xcd_barrier_complete(unsigned* bar, unsigned x, unsigned& nloc, unsigned& nx) {
    const unsigned G = gridDim.x * gridDim.y * gridDim.z;
    unsigned sum, cnt, mine, sp = 0u;
    for (;;) {
        sum = 0u; cnt = 0u; mine = 0u;
#pragma unroll
        for (unsigned j = 0; j < 16; ++j) { const unsigned c = xb_ld(&bar[XB_XCNT(j)]); sum += c; cnt += (c > 0u) ? 1u : 0u; mine = (j == x) ? c : mine; }
        if (sum == G) break;
        __builtin_amdgcn_s_sleep(1);
        if ((++sp & 255u) == 0u) { if (xb_ld(&bar[XB_TMO])) break; if (sp > XB_SPIN_CAP) { atomicAdd(&bar[XB_TMO], 1u); break; } }
    }
    nloc = mine > 0u ? mine : 1u; nx = cnt > 0u ? cnt : 1u;
}

__device__ __forceinline__ void xcd_barrier(const XcdBarrier& b) {
    asm volatile("s_waitcnt vmcnt(0)" ::: "memory");
    __syncthreads();
    if (threadIdx.x == 0) {
        unsigned* bar = b.bar;
        __builtin_amdgcn_s_waitcnt(0);
        unsigned nloc = b.st[0], nx = b.st[1];
        if (nloc == 0u) { xcd_barrier_complete(bar, b.x, nloc, nx); b.st[0] = nloc; b.st[1] = nx; }
        const unsigned old = xb_add(&bar[XB_XSUB(b.x)], 1u);
        const unsigned gen = old / nloc;
        if (old + 1u == (gen + 1u) * nloc) {
            __builtin_amdgcn_fence(__ATOMIC_RELEASE, "agent");
            asm volatile("s_waitcnt vmcnt(0)" ::: "memory");
            const unsigned og = xb_add(&bar[XB_TOP], 1u);
            const unsigned tg = og / nx;
            if (og + 1u == (tg + 1u) * nx) xb_add(&bar[XB_TOPGEN], 1u);
            else XB_SPIN(xb_ld(&bar[XB_TOPGEN]) == tg, bar);
            __builtin_amdgcn_fence(__ATOMIC_ACQUIRE, "agent");
            xb_add(&bar[XB_XGEN(b.x)], 1u);
            asm volatile("s_waitcnt vmcnt(0)" ::: "memory");
        } else {
            XB_SPIN(xb_ld(&bar[XB_XGEN(b.x)]) == gen, bar);
            __builtin_amdgcn_fence(__ATOMIC_ACQUIRE, "agent");
            asm volatile("s_waitcnt vmcnt(0)" ::: "memory");
        }
    }
    __syncthreads();
}

struct Args { const float* in[18]; float* out; unsigned char* ws; int ph_lo, ph_hi; };
__global__ void __launch_bounds__(NWAVES * 64, 2) mk_fwd(Args args) {
    extern __shared__ __attribute__((aligned(16))) unsigned char lds_raw[];
    LAS unsigned char* lds = (LAS unsigned char*)lds_raw;
    cg::grid_group grid = cg::this_grid();
    for (int u = threadIdx.x; u < (LDS_BYTES - 131072) / 4; u += NWAVES * 64) ((LAS unsigned*)(lds + 131072))[u] = 0u;
    __syncthreads();
#if MK_N_LAUNCHES == 1
    grid.sync();
#endif
    const XcdBarrier xbar = xcd_barrier_post((unsigned*)(args.ws + WS_CTL) + CW_BAR, (volatile LAS unsigned*)(lds + MISC_OFF) + 8);
    const int G = gridDim.x, bx = blockIdx.x, vcu = (G % 8 == 0) ? (bx % 8) * (G / 8) + bx / 8 : bx;
    const int NGW = G * NWAVES;
#define TID_VARS const int tid = opq(threadIdx.x), lane = tid & 63, wave = __builtin_amdgcn_readfirstlane(tid >> 6), gw = vcu * NWAVES + wave; (void)gw; (void)lane
    unsigned char* ws = args.ws;
    float* X = args.out;
    pg8::ss_t* SS = (pg8::ss_t*)(ws + WS_SS); float* LSE = (float*)(ws + WS_LSE);
    bf16* XB = (bf16*)(ws + WS_XB); bf16* ACT = (bf16*)(ws + WS_ACT); bf16* OG = (bf16*)(ws + WS_OG); bf16* MG = (bf16*)(ws + WS_MG);
    const int lo = args.ph_lo, hi = args.ph_hi;
    int ph = 0;
#define PH_ON (ph >= lo && ph < hi)
#define GRID_BAR() do { asm volatile("s_waitcnt vmcnt(0)" ::: "memory"); grid.sync(); __builtin_amdgcn_fence(__ATOMIC_ACQUIRE, "agent"); asm volatile("s_waitcnt vmcnt(0)" ::: "memory"); } while (0)
#ifdef DUP_BAR
#define PH_END do { if (PH_ON && ph + 1 < hi) { if (ph == 0) GRID_BAR(); else { xcd_barrier(xbar); xcd_barrier(xbar); } } ++ph; } while (0)
#else
#define PH_END do { if (PH_ON && ph + 1 < hi) xcd_barrier(xbar); ++ph; } while (0)
#endif
#define MAKE_LW(lw, L) LayerW lw; { const int L_ = (L), i_ = L_ >> 1; lw.even = !(L_ & 1); \
        lw.gu1 = args.in[2] + (size_t)L_ * D * 2 * FF; lw.d1 = args.in[3] + (size_t)L_ * FF * D; lw.gu2 = args.in[6] + (size_t)L_ * D * 2 * FF; lw.d2 = args.in[7] + (size_t)L_ * FF * D; \
        lw.g1 = args.in[1] + L_ * D; lw.gm = args.in[4] + L_ * D; lw.g2 = args.in[5] + L_ * D; \
        lw.mi = lw.even ? args.in[8] + (size_t)i_ * D * NIN_CONV : args.in[15] + (size_t)i_ * D * NQKV; lw.mo = lw.even ? args.in[14] + (size_t)i_ * D * D : args.in[16] + (size_t)i_ * D * D; }

    if (PH_ON) {
        TID_VARS;
        const float* x = args.in[0];
        for (int m0 = gw; m0 < M; m0 += 2 * NGW) { f32x4 v[2][4]; float s[2] = {0.f, 0.f};
#pragma unroll
            for (int e = 0; e < 2; ++e) { const int m = m0 + e * NGW; if (m < M) { const f32x4* xr = (const f32x4*)(x + (size_t)m * D) + lane;
#pragma unroll
                for (int j = 0; j < 4; ++j) v[e][j] = xr[64 * j]; } }
#pragma unroll
            for (int e = 0; e < 2; ++e) { const int m = m0 + e * NGW; if (m < M) {
#pragma unroll
                for (int j = 0; j < 4; ++j) s[e] += (v[e][j].x * v[e][j].x + v[e][j].y * v[e][j].y) + (v[e][j].z * v[e][j].z + v[e][j].w * v[e][j].w);
                s[e] = wave_sum(s[e]);
                v2u* bo = (v2u*)(XB + (size_t)m * D) + lane;
#pragma unroll
                for (int j = 0; j < 4; ++j) { v2u w; w.x = pk2(v[e][j].x, v[e][j].y); w.y = pk2(v[e][j].z, v[e][j].w); bo[64 * j] = w; }
                if (lane == 0) SS[m] = (pg8::ss_t)(s[e] * pg8::SS_SCALE); } } }
        MAKE_LW(lw, 0); convert_layer(lw, (bf16*)(ws + WS_W), 0, lds, gw, NGW, wave, lane);
    }
    PH_END;

    for (int sb = 0; sb < 3 * DEPTH; ++sb) {
        const int L = sb / 3, kind = sb % 3, even = !(L & 1);
        bf16* WB = (bf16*)(ws + WS_W + (size_t)(L & 1) * W_STRIDE);
        pg8::ss_t* ss_in = SS + (size_t)sb * M; pg8::ss_t* ss_out = SS + (size_t)(sb + 1) * M;
        if (kind != 1) {
            if (PH_ON) { pg8::Gemm g{XB, WB + (kind ? OW_GU2 : OW_GU1), M, 2 * FF, D}; pg8::StaticOrder S; S.init(M, 2 * FF, G, bx);
                pg8::EpiSwiglu E{ACT, FF, ss_in};

#ifndef NO_G1
                pg8::gemm_phase<pg8::EpiSwiglu, pg8::StaticOrder, true, true>(lds, g, S, E);
#endif
#ifdef DUP_G1
                xcd_barrier(xbar); pg8::gemm_phase<pg8::EpiSwiglu, pg8::StaticOrder, true, true>(lds, g, S, E);
#endif
                { const int nwg = (M / 256) * (2 * FF / 256), ntail = nwg % G, cl = (kind == 0) ? L : L + 1;
                  if (ntail > 0 && bx >= ntail && cl < DEPTH) { TID_VARS; MAKE_LW(lw, cl);
                      convert_layer(lw, (bf16*)(ws + WS_W + (size_t)(cl & 1) * W_STRIDE), kind == 0 ? 1 : 0, lds, (bx - ntail) * NWAVES + wave, (G - ntail) * NWAVES, wave, lane); }
                  else if (ntail == 0 && cl < DEPTH) { TID_VARS; MAKE_LW(lw, cl); convert_layer(lw, (bf16*)(ws + WS_W + (size_t)(cl & 1) * W_STRIDE), kind == 0 ? 1 : 0, lds, gw, NGW, wave, lane); } }
            }
            PH_END;
            if (PH_ON) { pg8::Gemm g{ACT, WB + (kind ? OW_D2 : OW_D1), M, D, FF}; pg8::StaticOrder S; S.init(M, D, G, bx);
                pg8::EpiResid E{XB, ss_out, 0.5f};
#ifndef NO_G2
                pg8::gemm_phase<pg8::EpiResid, pg8::StaticOrder, true, true>(lds, g, S, E);
#endif
#ifdef DUP_G2
                xcd_barrier(xbar); { pg8::EpiResid E2{XB, SS + (size_t)13 * M, 0.0f}; pg8::gemm_phase<pg8::EpiResid, pg8::StaticOrder, true, true>(lds, g, S, E2); }
#endif
            }
            PH_END;
        } else {
            const int nmi = even ? NIN_CONV : NQKV;
            if (PH_ON) { pg8::Gemm g{XB, WB + OW_MI, M, nmi, D}; pg8::StaticOrder S; S.init(M, nmi, G, bx);
                pg8::EpiScale E{ACT, nmi, ss_in};

#ifndef NO_G3
                pg8::gemm_phase<pg8::EpiScale, pg8::StaticOrder, true, true>(lds, g, S, E);
#endif
#ifdef DUP_G3
                xcd_barrier(xbar); pg8::gemm_phase<pg8::EpiScale, pg8::StaticOrder, true, true>(lds, g, S, E);
#endif
            }
            PH_END;
            if (PH_ON) {
                const int i = L >> 1;
                if (even) {
#ifndef NO_CONV
                    conv_phase(lds, ACT, OG, args.in[9] + i * 3 * 512, args.in[10] + i * 31 * 512, args.in[11] + i * 512, args.in[12] + i * 512, args.in[13] + i * 512, G, vcu);
#endif
#ifdef DUP_CONV
                    __syncthreads(); conv_phase(lds, ACT, OG, args.in[9] + i * 3 * 512, args.in[10] + i * 31 * 512, args.in[11] + i * 512, args.in[12] + i * 512, args.in[13] + i * 512, G, vcu);
#endif
                } else {
#ifndef NO_ATT
                    attn_phase(lds, ACT, OG, LSE, G, vcu);
#endif
#ifdef DUP_ATT
                    __syncthreads(); attn_phase(lds, ACT, OG, LSE, G, vcu);
#endif
                }
            }
            PH_END;
            if (!even) { if (PH_ON) { merge_phase(OG, LSE, MG, G, vcu);
#ifdef DUP_MERGE
                xcd_barrier(xbar); merge_phase(OG, LSE, MG, G, vcu);
#endif
            } PH_END; }
            if (PH_ON) { pg8::Gemm g{even ? OG : MG, WB + OW_MO, M, D, D}; pg8::StaticOrder S; S.init(M, D, G, bx);
                pg8::EpiResid E{XB, ss_out, 1.0f};
#ifndef NO_G4
                pg8::gemm_phase<pg8::EpiResid, pg8::StaticOrder, true, true>(lds, g, S, E);
#endif
#ifdef DUP_G4
                xcd_barrier(xbar); { pg8::EpiResid E2{XB, SS + (size_t)13 * M, 0.0f}; pg8::gemm_phase<pg8::EpiResid, pg8::StaticOrder, true, true>(lds, g, S, E2); }
#endif
            }
            PH_END;
        }
    }
    if (PH_ON) {
        TID_VARS;
        const float* gf = args.in[17]; const pg8::ss_t* ssf = SS + (size_t)12 * M;
        f32x4 gv[4];
#pragma unroll
        for (int j = 0; j < 4; ++j) gv[j] = ((const f32x4*)gf)[64 * j + lane];
        for (int m0 = gw; m0 < M; m0 += 2 * NGW) { v2u w[2][4]; float rs[2] = {0.f, 0.f};
#pragma unroll
            for (int e = 0; e < 2; ++e) { const int m = m0 + e * NGW; if (m < M) { const v2u* xb = (const v2u*)(XB + (size_t)m * D) + lane; rs[e] = pg8::rstd_of(ssf, m);
#pragma unroll
                for (int j = 0; j < 4; ++j) w[e][j] = xb[64 * j]; } }
#pragma unroll
            for (int e = 0; e < 2; ++e) { const int m = m0 + e * NGW; if (m < M) { f32x4* xo = (f32x4*)(X + (size_t)m * D) + lane;
#pragma unroll
                for (int j = 0; j < 4; ++j) { const f32x4 v = (f32x4){bf_lo(w[e][j].x), bf_hi(w[e][j].x), bf_lo(w[e][j].y), bf_hi(w[e][j].y)}; xo[64 * j] = v * rs[e] * gv[j]; } } } }
    }
    ++ph;
}
constexpr int N_PHASES = 1 + 2 * (2 + 3 + 2) + 2 * (2 + 4 + 2) + 1;

extern "C" void kernel_launch(void* const* d_in, const int* in_sizes, int n_in, void* d_out, int out_size, void* d_ws, size_t ws_size, hipStream_t stream) {
    static int grid = 0;
    if (grid == 0) {
        if (n_in != 18 || in_sizes[0] != M * D || out_size != M * D || ws_size < WS_END) { fprintf(stderr, "kernel_launch: unexpected shapes (n_in %d, in0 %d, out %d, ws %zu)\n", n_in, n_in > 0 ? in_sizes[0] : -1, out_size, ws_size); grid = -1; return; }
        int dev = 0, cus = 0, per_cu = 0;
        hipGetDevice(&dev); hipDeviceGetAttribute(&cus, hipDeviceAttributeMultiprocessorCount, dev);
        if (hipFuncSetAttribute((const void*)mk_fwd, hipFuncAttributeMaxDynamicSharedMemorySize, LDS_BYTES) != hipSuccess) { fprintf(stderr, "kernel_launch: hipFuncSetAttribute failed\n"); grid = -1; return; }
        if (hipOccupancyMaxActiveBlocksPerMultiprocessor(&per_cu, (const void*)mk_fwd, NWAVES * 64, LDS_BYTES) != hipSuccess || per_cu < 1) { fprintf(stderr, "kernel_launch: occupancy query says %d\n", per_cu); per_cu = 1; }
        (void)hipGetLastError();
        grid = cus * (per_cu > 1 ? 1 : per_cu);
    }
    if (grid < 0) return;
    hipMemsetAsync((char*)d_ws + WS_CTL, 0, CTL_ZERO_BYTES, stream);
    Args a{};
    for (int i = 0; i < 18; ++i) a.in[i] = (const float*)d_in[i];
    a.out = (float*)d_out; a.ws = (unsigned char*)d_ws;
#if MK_N_LAUNCHES == 1
    a.ph_lo = 0; a.ph_hi = N_PHASES;
    void* kargs[] = {&a};
    hipError_t e = hipLaunchCooperativeKernel((const void*)mk_fwd, dim3(grid), dim3(NWAVES * 64), kargs, LDS_BYTES, stream);
    if (e != hipSuccess) fprintf(stderr, "kernel_launch: cooperative launch failed: %s (grid %d)\n", hipGetErrorString(e), grid);
#else
    for (int p = 0; p < N_PHASES; ++p) { a.ph_lo = p; a.ph_hi = p + 1; hipLaunchKernelGGL(mk_fwd, dim3(grid), dim3(NWAVES * 64), LDS_BYTES, stream, a); }
#endif
}
```

```cpp
#include <hip/hip_runtime.h>
#include <hip/hip_cooperative_groups.h>
#include <cstdio>
#include <cstdint>
namespace cg = cooperative_groups;
namespace pg8 {
#define PG8_LAS __attribute__((address_space(3)))
typedef unsigned short bf16_t;
typedef short bf16x8 __attribute__((ext_vector_type(8)));
typedef float f32x4 __attribute__((ext_vector_type(4)));
typedef unsigned u32x4 __attribute__((ext_vector_type(4)));
constexpr int BM = 256, BK = 64, HALF = 128, HTB = HALF * BK * 2  , STAGE_BYTES = 8 * HTB, NXCD = 8, WGM = 8;

__host__ __device__ __forceinline__ int lds_byte(int r, int c) { const int st = (r >> 4) * 2 + (c >> 5), rr = r & 15, cc = c & 31, ob = rr * 64 + cc * 2; return st * 1024 + (ob ^ (((ob >> 9) & 1) << 5)); }
__host__ __device__ __forceinline__ void stage_rc(int b, int& R, int& C) { const int st = b / 1024, sb = b % 1024, swz = sb ^ (((sb >> 9) & 1) << 5); R = (st >> 1) * 16 + swz / 64; C = (st & 1) * 32 + (swz % 64) / 2; }
__host__ __device__ __forceinline__ int perm32(int rho) { const int n = rho >> 4, i = rho & 15; return 8 * (i >> 2) + 4 * n + (i & 3); }

struct Unit { int pm, pn; };
struct Gemm { const bf16_t* A; const bf16_t* Bt; int M, N, K; int lda; };

struct StaticOrder {
    int nM, nN, nwg, G, c;
    __host__ __device__ void init(int M, int N, int G_, int c_) { nM = M / BM; nN = N / BM; nwg = nM * nN; G = G_; c = c_; }
    __host__ __device__ bool next(int i, Unit& u) const {
        const long L = (long)i * G + c; if (L >= nwg) return false;
        int wgid = (int)L; { const int q = nwg / NXCD, r = nwg % NXCD, xcd = wgid % NXCD, off = wgid / NXCD; wgid = (xcd < r ? xcd * (q + 1) : r * (q + 1) + (xcd - r) * q) + off; }
        const int nig = WGM * nN, gid = wgid / nig, fm = gid * WGM, gsz = (nM - fm) < WGM ? (nM - fm) : WGM;
        u.pm = fm + ((wgid % nig) % gsz); u.pn = (wgid % nig) / gsz; return true;
    }
    __device__ __forceinline__ void a_ready(const Unit&) const {}
    __device__ __forceinline__ void done(const Unit&) const {}
};

__device__ __forceinline__ unsigned cvt_pk_bf16(float lo, float hi) { unsigned r; asm volatile("v_cvt_pk_bf16_f32 %0, %1, %2" : "=v"(r) : "v"(lo), "v"(hi)); return r; }
typedef float f32x2 __attribute__((ext_vector_type(2)));
typedef unsigned long long ss_t;
constexpr float SS_SCALE = 1048576.0f;
__device__ __forceinline__ float rstd_of(const ss_t* ss, int row) { return __builtin_amdgcn_rsqf((float)ss[row] * (1.0f / (1024.0f * SS_SCALE)) + 1e-6f); }
__device__ __forceinline__ void st16_wt(void* p, u32x4 v) { asm volatile("global_store_dwordx4 %0, %1, off sc1\n\ts_nop 1" : : "v"(p), "v"(v) : "memory"); }
template <bool LDSTAB> struct RsTable {
    PG8_LAS float* tab; const ss_t* ss;
    __device__ __forceinline__ void fill(int pm, int wr, int lane) const {
        const float a = rstd_of(ss, pm * BM + wr * 64 + lane), b = rstd_of(ss, pm * BM + HALF + wr * 64 + lane);
        tab[lane] = a; tab[64 + lane] = b;
        asm volatile("s_waitcnt lgkmcnt(0)" ::: "memory");
    }
    __device__ __forceinline__ void get(float (&rsv)[2][4], int pm, int wr, int fr, int fq) const {
#pragma unroll
        for (int ai = 0; ai < 2; ++ai)
#pragma unroll
            for (int m = 0; m < 4; ++m) rsv[ai][m] = LDSTAB ? tab[ai * 64 + m * 16 + fr] : rstd_of(ss, pm * BM + ai * HALF + wr * 64 + m * 16 + fr);
    }
};
template <bool LDSTAB> struct EpiScale {
    static constexpr bool PERM = true, AFTER_DRAIN = false;
    bf16_t* O; int ldc; RsTable<LDSTAB> rt;
    __device__ __forceinline__ void operator()(const f32x4 (&acc)[2][2][4][2], const Unit& u, int wr, int wc, int fr, int fq) const {
        const int row0 = u.pm * BM + wr * 64 + fr, col0 = u.pn * BM + wc * 32 + 8 * fq;
        float rsv[2][4]; rt.get(rsv, u.pm, wr, fr, fq);
#pragma unroll
        for (int ai = 0; ai < 2; ++ai)
#pragma unroll
            for (int m = 0; m < 4; ++m) { const int row = row0 + ai * HALF + m * 16; const float rs = rsv[ai][m]; bf16_t* rowp = O + (size_t)row * ldc + col0;
#pragma unroll
                for (int bj = 0; bj < 2; ++bj) { const f32x4 v0 = acc[ai][bj][m][0] * rs, v1 = acc[ai][bj][m][1] * rs;
                    u32x4 w; w.x = cvt_pk_bf16(v0[0], v0[1]); w.y = cvt_pk_bf16(v0[2], v0[3]); w.z = cvt_pk_bf16(v1[0], v1[1]); w.w = cvt_pk_bf16(v1[2], v1[3]);
                    st16_wt(rowp + bj * HALF, w); }
                asm volatile("" ::: "memory"); }
    }
};
__device__ __forceinline__ float silu_mul(float g, float u) { const float e = __builtin_amdgcn_exp2f(g * -1.4426950408889634f); return g * u * __builtin_amdgcn_rcpf(1.0f + e); }
template <bool LDSTAB> struct EpiSwiglu {
    static constexpr bool PERM = true, AFTER_DRAIN = false;
    bf16_t* H; int ldh; RsTable<LDSTAB> rt;
    __device__ __forceinline__ void operator()(const f32x4 (&acc)[2][2][4][2], const Unit& u, int wr, int wc, int fr, int fq) const {
        const int row0 = u.pm * BM + wr * 64 + fr, col0 = u.pn * HALF + wc * 32 + 8 * fq;
        float rsv[2][4]; rt.get(rsv, u.pm, wr, fr, fq);
#pragma unroll
        for (int ai = 0; ai < 2; ++ai)
#pragma unroll
            for (int m = 0; m < 4; ++m) { const int row = row0 + ai * HALF + m * 16; const float rs = rsv[ai][m];
                const f32x4 g0 = acc[ai][0][m][0] * rs, g1 = acc[ai][0][m][1] * rs, u0 = acc[ai][1][m][0] * rs, u1 = acc[ai][1][m][1] * rs;
                u32x4 w; w.x = cvt_pk_bf16(silu_mul(g0[0], u0[0]), silu_mul(g0[1], u0[1])); w.y = cvt_pk_bf16(silu_mul(g0[2], u0[2]), silu_mul(g0[3], u0[3]));
                w.z = cvt_pk_bf16(silu_mul(g1[0], u1[0]), silu_mul(g1[1], u1[1])); w.w = cvt_pk_bf16(silu_mul(g1[2], u1[2]), silu_mul(g1[3], u1[3]));
                st16_wt(H + (size_t)row * ldh + col0, w); asm volatile("" ::: "memory"); }
    }
};
__device__ __forceinline__ float bfl(unsigned u) { return __builtin_bit_cast(float, u << 16); }
__device__ __forceinline__ float bfh(unsigned u) { return __builtin_bit_cast(float, u & 0xffff0000u); }
struct EpiResid {
    static constexpr bool PERM = true, AFTER_DRAIN = false;
    bf16_t* XB; ss_t* ssn; float alpha;
    PG8_LAS ss_t* qtab;
    __device__ __forceinline__ void operator()(const f32x4 (&acc)[2][2][4][2], const Unit& u, int wr, int wc, int fr, int fq) const {
        const int row0 = u.pm * BM + wr * 64 + fr, col0 = u.pn * BM + wc * 32 + 8 * fq;
#pragma unroll
        for (int ai = 0; ai < 2; ++ai) {
            u32x4 xv[4][2];
#pragma unroll
            for (int m = 0; m < 4; ++m) { const bf16_t* bp = XB + (size_t)(row0 + ai * HALF + m * 16) * 1024 + col0; xv[m][0] = *(const u32x4*)bp; xv[m][1] = *(const u32x4*)(bp + HALF); }
#pragma unroll
            for (int m = 0; m < 4; ++m) { const int row = row0 + ai * HALF + m * 16; bf16_t* bp = XB + (size_t)row * 1024 + col0; float q = 0.f;
#pragma unroll
                for (int bj = 0; bj < 2; ++bj) { const u32x4 x = xv[m][bj]; const f32x4 a0 = acc[ai][bj][m][0] * alpha, a1 = acc[ai][bj][m][1] * alpha;
                    const float y0 = bfl(x.x) + a0[0], y1 = bfh(x.x) + a0[1], y2 = bfl(x.y) + a0[2], y3 = bfh(x.y) + a0[3], y4 = bfl(x.z) + a1[0], y5 = bfh(x.z) + a1[1], y6 = bfl(x.w) + a1[2], y7 = bfh(x.w) + a1[3];
                    u32x4 w; w.x = cvt_pk_bf16(y0, y1); w.y = cvt_pk_bf16(y2, y3); w.z = cvt_pk_bf16(y4, y5); w.w = cvt_pk_bf16(y6, y7);
                    st16_wt(bp + bj * HALF, w);
                    q += (y0 * y0 + y1 * y1) + (y2 * y2 + y3 * y3) + (y4 * y4 + y5 * y5) + (y6 * y6 + y7 * y7); }
                q += __shfl_xor(q, 16); q += __shfl_xor(q, 32);
                if (fq == 0) { const ss_t qv = (ss_t)(q * SS_SCALE);
                    if (qtab) qtab[(ai * HALF + wr * 64 + m * 16 + fr) * 4 + wc] = qv; else __hip_atomic_fetch_add(ssn + row, qv, __ATOMIC_RELAXED, __HIP_MEMORY_SCOPE_AGENT); } }
            asm volatile("" ::: "memory");
        }
    }
};
template <class Epi, class Sched, bool ALIGN_EPI = false, bool SP2 = false>
__device__ __forceinline__ void gemm_phase(PG8_LAS unsigned char* lds, const Gemm g, const Sched& S, const Epi& E, int wave_s) {
    asm volatile("" : "+s"(wave_s)); int ln_ = (int)__builtin_amdgcn_mbcnt_hi(~0u, __builtin_amdgcn_mbcnt_lo(~0u, 0u)); asm volatile("" : "+v"(ln_)); const int tid = wave_s * 64 + ln_; const int wid = wave_s, lane = tid & 63, wr = wid >> 2, wc = wid & 3, fr = lane & 15, fq = lane >> 4;
    const int K = g.K, nt = K / BK, LDA = g.lda ? g.lda : K;
    unsigned voffA[2], voffB[2];
#pragma unroll
    for (int i = 0; i < 2; ++i) { int R, C; stage_rc(tid * 16 + i * 8192, R, C); const int Rb = Epi::PERM ? ((R & ~31) + perm32(R & 31)) : R;
        voffA[i] = (unsigned)(R * LDA + C) * 2u; voffB[i] = (unsigned)(Rb * K + C) * 2u; }
    const size_t kstep = (size_t)(BK * 2);
    const size_t hstep = (size_t)HALF * K * 2;
    const size_t tstep = 2 * hstep;
    const size_t hstepA = (size_t)HALF * LDA * 2, tstepA = 2 * hstepA;
    const unsigned ldsw = (unsigned)wid * 1024u;
    const int aoff = lds_byte(wr * 64 + fr, fq * 8), boff = lds_byte(wc * 32 + fr, fq * 8);
#define PG8_SA(b, h) (((b) * 2 + (h)) * HTB)
#define PG8_SB(b, h) ((4 + (b) * 2 + (h)) * HTB)
#define PG8_STAGE(bufoff, gbase, voff) do { _Pragma("unroll") for (int _i = 0; _i < 2; ++_i) \
        __builtin_amdgcn_global_load_lds((const unsigned*)((const char*)(gbase) + (voff)[_i]), (PG8_LAS unsigned*)(lds + (bufoff) + ldsw + _i * 8192), 16, 0, 0); } while (0)
#define PG8_LDA(dst, b, h) do { _Pragma("unroll") for (int m = 0; m < 4; ++m) _Pragma("unroll") for (int k = 0; k < 2; ++k) dst[m][k] = *(const PG8_LAS bf16x8*)(lds + PG8_SA(b, h) + aoff + m * 2048 + k * 1024); } while (0)
#define PG8_LDB(dst, b, h) do { _Pragma("unroll") for (int n = 0; n < 2; ++n) _Pragma("unroll") for (int k = 0; k < 2; ++k) dst[n][k] = *(const PG8_LAS bf16x8*)(lds + PG8_SB(b, h) + boff + n * 2048 + k * 1024); } while (0)
#define PG8_MMA(ai, bj, At, Bt) do { __builtin_amdgcn_s_setprio(1); _Pragma("unroll") for (int m = 0; m < 4; ++m) _Pragma("unroll") for (int n = 0; n < 2; ++n) _Pragma("unroll") for (int k = 0; k < 2; ++k) \
        acc[ai][bj][m][n] = __builtin_amdgcn_mfma_f32_16x16x32_bf16(Bt[n][k], At[m][k], acc[ai][bj][m][n], 0, 0, 0); __builtin_amdgcn_s_setprio(0); } while (0)
#define PG8_WAIT_V(n) asm volatile("s_waitcnt vmcnt(" #n ")" ::: "memory")
#define PG8_WAIT_L(n) asm volatile("s_waitcnt lgkmcnt(" #n ")" ::: "memory")
#define PG8_BAR __builtin_amdgcn_s_barrier()
#define PG8_SCHED __builtin_amdgcn_sched_barrier(0)
    Unit cur, nxt; int ui = 0;
    if (!S.next(0, cur)) return;
    f32x4 acc[2][2][4][2];
#pragma unroll
    for (int a = 0; a < 2; ++a)
#pragma unroll
        for (int b = 0; b < 2; ++b)
#pragma unroll
            for (int m = 0; m < 4; ++m)
#pragma unroll
                for (int n = 0; n < 2; ++n) acc[a][b][m][n] = (f32x4){0.f, 0.f, 0.f, 0.f};
    bf16x8 At[4][2], B0[2][2], B1[2][2];
    const char* cA = (const char*)g.A + (size_t)cur.pm * tstepA; const char* cB = (const char*)g.Bt + (size_t)cur.pn * tstep;
    S.a_ready(cur);
    if constexpr (SP2) {
        PG8_STAGE(PG8_SB(0, 0), cB, voffB); PG8_STAGE(PG8_SB(0, 1), cB + hstep, voffB); PG8_STAGE(PG8_SA(0, 0), cA, voffA); PG8_STAGE(PG8_SA(0, 1), cA + hstepA, voffA);
        if (wr == 1) PG8_BAR;
        PG8_WAIT_V(2); PG8_BAR;
        PG8_STAGE(PG8_SB(1, 0), cB + kstep, voffB); PG8_STAGE(PG8_SA(1, 0), cA + kstep, voffA); PG8_STAGE(PG8_SB(1, 1), cB + hstep + kstep, voffB);
        PG8_WAIT_V(6); PG8_BAR;
    } else {
        PG8_STAGE(PG8_SB(0, 0), cB, voffB); PG8_STAGE(PG8_SA(0, 0), cA, voffA); PG8_STAGE(PG8_SB(0, 1), cB + hstep, voffB); PG8_STAGE(PG8_SA(0, 1), cA + hstepA, voffA);
        if (wr == 1) PG8_BAR;
        PG8_WAIT_V(4); PG8_BAR;
        PG8_STAGE(PG8_SB(1, 0), cB + kstep, voffB); PG8_STAGE(PG8_SA(1, 0), cA + kstep, voffA); PG8_STAGE(PG8_SB(1, 1), cB + hstep + kstep, voffB);
        PG8_WAIT_V(6); PG8_BAR;
    }
    for (;;) {
        const bool has_next = S.next(ui + 1, nxt);
        const char* nA = has_next ? (const char*)g.A + (size_t)nxt.pm * tstepA : cA; const char* nB = has_next ? (const char*)g.Bt + (size_t)nxt.pn * tstep : cB;
        for (int t = 0; t < nt; t += 2) {
            const bool last = (t == nt - 2);
            const char* a1 = cA + (size_t)(t + 1) * kstep;
            const char* a2 = last ? nA : cA + (size_t)(t + 2) * kstep; const char* b2 = last ? nB : cB + (size_t)(t + 2) * kstep;
            const char* a3 = a2 + kstep; const char* b3 = b2 + kstep;
            if (last && has_next) S.a_ready(nxt);
            if constexpr (SP2) {
            PG8_LDB(B0, 0, 0); PG8_LDB(B1, 0, 1); PG8_SCHED; PG8_LDA(At, 0, 0); PG8_STAGE(PG8_SA(1, 1), a1 + hstepA, voffA);
            PG8_WAIT_V(8); PG8_WAIT_L(0); PG8_BAR; PG8_MMA(0, 0, At, B0); PG8_MMA(0, 1, At, B1); PG8_BAR; PG8_SCHED;
            PG8_LDA(At, 0, 1); PG8_STAGE(PG8_SB(0, 0), b2, voffB); PG8_STAGE(PG8_SB(0, 1), b2 + hstep, voffB); PG8_STAGE(PG8_SA(0, 0), a2, voffA);
            PG8_WAIT_V(8); PG8_WAIT_L(0); PG8_BAR; PG8_MMA(1, 0, At, B0); PG8_MMA(1, 1, At, B1); PG8_BAR; PG8_SCHED;
            PG8_LDB(B0, 1, 0); PG8_LDB(B1, 1, 1); PG8_SCHED; PG8_LDA(At, 1, 0); PG8_STAGE(PG8_SA(0, 1), a2 + hstepA, voffA);
            PG8_WAIT_V(8); PG8_WAIT_L(0); PG8_BAR; PG8_MMA(0, 0, At, B0); PG8_MMA(0, 1, At, B1); PG8_BAR; PG8_SCHED;
            PG8_LDA(At, 1, 1); PG8_STAGE(PG8_SB(1, 0), b3, voffB); PG8_STAGE(PG8_SB(1, 1), b3 + hstep, voffB); PG8_STAGE(PG8_SA(1, 0), a3, voffA);
            PG8_WAIT_V(8); PG8_WAIT_L(0); PG8_BAR; PG8_MMA(1, 0, At, B0); PG8_MMA(1, 1, At, B1); PG8_BAR; PG8_SCHED;
            } else {
            PG8_LDB(B0, 0, 0); PG8_SCHED; PG8_LDA(At, 0, 0); PG8_STAGE(PG8_SA(1, 1), a1 + hstepA, voffA);
            PG8_WAIT_L(8); PG8_BAR; PG8_WAIT_L(0); PG8_MMA(0, 0, At, B0); PG8_BAR; PG8_SCHED;
            PG8_LDB(B1, 0, 1); PG8_STAGE(PG8_SB(0, 0), b2, voffB);
            PG8_BAR; PG8_WAIT_L(0); PG8_MMA(0, 1, At, B1); PG8_BAR;
            PG8_LDA(At, 0, 1); PG8_STAGE(PG8_SA(0, 0), a2, voffA);
            PG8_BAR; PG8_WAIT_L(0); PG8_MMA(1, 0, At, B0); PG8_BAR; PG8_SCHED;
            PG8_STAGE(PG8_SB(0, 1), b2 + hstep, voffB);
            PG8_WAIT_V(6); PG8_BAR; PG8_MMA(1, 1, At, B1); PG8_BAR;
            PG8_LDB(B0, 1, 0); PG8_SCHED; PG8_LDA(At, 1, 0); PG8_STAGE(PG8_SA(0, 1), a2 + hstepA, voffA);
            PG8_WAIT_L(8); PG8_BAR; PG8_WAIT_L(0); PG8_MMA(0, 0, At, B0); PG8_BAR; PG8_SCHED;
            PG8_LDB(B1, 1, 1); PG8_STAGE(PG8_SB(1, 0), b3, voffB);
            PG8_BAR; PG8_WAIT_L(0); PG8_MMA(0, 1, At, B1); PG8_BAR;
            PG8_LDA(At, 1, 1); PG8_STAGE(PG8_SA(1, 0), a3, voffA);
            PG8_BAR; PG8_WAIT_L(0); PG8_MMA(1, 0, At, B0); PG8_BAR; PG8_SCHED;
            PG8_STAGE(PG8_SB(1, 1), b3 + hstep, voffB);
            PG8_WAIT_V(6); PG8_BAR; PG8_MMA(1, 1, At, B1); PG8_BAR;
            }
        }
        if constexpr (ALIGN_EPI) { if (wr == 0) PG8_BAR; }
        if constexpr (!Epi::AFTER_DRAIN) { E(acc, cur, wr, wc, fr, fq); S.done(cur); }
        if (!has_next) break;
#pragma unroll
        for (int a = 0; a < 2; ++a)
#pragma unroll
            for (int b = 0; b < 2; ++b)
#pragma unroll
                for (int m = 0; m < 4; ++m)
#pragma unroll
                    for (int n = 0; n < 2; ++n) acc[a][b][m][n] = (f32x4){0.f, 0.f, 0.f, 0.f};
        cur = nxt; cA = nA; cB = nB; ++ui;
        if constexpr (ALIGN_EPI) { if (wr == 1) PG8_BAR; }
    }
    PG8_WAIT_V(0);
    if constexpr (!ALIGN_EPI) { if (wr == 0) PG8_BAR; }
    PG8_BAR;
    if constexpr (Epi::AFTER_DRAIN) { E.fused(acc, cur, wr, wc, fr, fq, lds, wid, lane); S.done(cur); }
#undef PG8_SA
#undef PG8_SB
#undef PG8_STAGE
#undef PG8_LDA
#undef PG8_LDB
#undef PG8_MMA
#undef PG8_WAIT_V
#undef PG8_WAIT_L
#undef PG8_BAR
#undef PG8_SCHED
}
}

#ifndef MK_N_LAUNCHES
#define MK_N_LAUNCHES 1
#endif
constexpr int NWAVES = 8;
constexpr int BATCH = 2, SEQ = 8192, D = 1024, FF = 2816, M = BATCH * SEQ, DEPTH = 4;
constexpr int NIN_CONV = 2560, NQKV = 3072, NHEAD = 16;
constexpr int ZPITCH = 3072;
constexpr size_t MiB = 1u << 20;
constexpr size_t WS_CTL = 0, CTL_ZERO_BYTES = 2 * MiB;
constexpr size_t WS_SS = 64 * 1024;
constexpr size_t WS_LSE = 2 * MiB;
constexpr size_t WS_W = 8 * MiB, W_STRIDE = 44 * MiB;
constexpr size_t WS_XB = 96 * MiB;
constexpr size_t WS_ACT = 128 * MiB;
constexpr size_t WS_OG = 224 * MiB;
constexpr size_t WS_MG = 320 * MiB;
constexpr size_t WS_END = 352 * MiB;
constexpr size_t OW_GU1 = 0, OW_D1 = OW_GU1 + (size_t)2 * FF * D, OW_MI = OW_D1 + (size_t)D * FF, OW_MO = OW_MI + (size_t)NQKV * D, OW_GU2 = OW_MO + (size_t)D * D, OW_D2 = OW_GU2 + (size_t)2 * FF * D, OW_END = OW_D2 + (size_t)D * FF;
static_assert(OW_END * 2 <= W_STRIDE, "weight buffer");
constexpr int LDS_BYTES = 147456;
constexpr int CW_BAR = 4096;
constexpr int MISC_OFF = 131072 + 320;
constexpr int QTAB_OFF = 131072 + 8192;
constexpr int RST_OFF = 131072 + 4096;

#define LAS __attribute__((address_space(3)))
typedef unsigned short bf16;
typedef unsigned v4u __attribute__((ext_vector_type(4)));
typedef unsigned v2u __attribute__((ext_vector_type(2)));
typedef float f32x4 __attribute__((ext_vector_type(4)));
typedef short bf16x8 __attribute__((ext_vector_type(8)));
typedef short s16x4 __attribute__((ext_vector_type(4)));
#define LDS_WAIT() asm volatile("s_waitcnt lgkmcnt(0)" ::: "memory")
__device__ __forceinline__ unsigned pk2(float lo, float hi) { return pg8::cvt_pk_bf16(lo, hi); }
__device__ __forceinline__ int opq(int x) { asm volatile("" : "+v"(x)); return x; }
__device__ __forceinline__ int opqs(int x) { asm volatile("" : "+s"(x)); return x; }
__device__ __forceinline__ int tid_of(int wave_s) { asm volatile("" : "+s"(wave_s)); int l = (int)__builtin_amdgcn_mbcnt_hi(~0u, __builtin_amdgcn_mbcnt_lo(~0u, 0u)); asm volatile("" : "+v"(l)); return wave_s * 64 + l; }
__device__ __forceinline__ float bf_lo(unsigned u) { return __uint_as_float(u << 16); }
__device__ __forceinline__ float bf_hi(unsigned u) { return __uint_as_float(u & 0xffff0000u); }
__device__ __forceinline__ float wave_sum(float v) {
#pragma unroll
    for (int o = 1; o < 64; o <<= 1) v += __shfl_xor(v, o);
    return v;
}
__device__ __forceinline__ float dpp_f(float x, float old) { return x; }
#define DPP_ADD(x, ctrl, rmask) x += __builtin_bit_cast(float, __builtin_amdgcn_update_dpp(0, __builtin_bit_cast(int, x), ctrl, rmask, 0xF, false))
__device__ __forceinline__ float wave_sum_hi(float x) {
    DPP_ADD(x, 0xB1, 0xF);
    DPP_ADD(x, 0x4E, 0xF);
    DPP_ADD(x, 0x141, 0xF);
    DPP_ADD(x, 0x140, 0xF);
    DPP_ADD(x, 0x142, 0xA);
    DPP_ADD(x, 0x143, 0xC);
    return x;
}

__device__ __forceinline__ void cvt_item(const float* __restrict__ W, int K, int N, bf16* WT, int dst_row0, int k0, int n0, const float* __restrict__ g, float cs, LAS float* scr, int lane) {
    float wv[32];
#pragma unroll
    for (int i = 0; i < 32; ++i) { const int kk = 2 * i + (lane >> 5); wv[i] = W[(size_t)(k0 + kk) * N + n0 + (lane & 31)]; }
#pragma unroll
    for (int i = 0; i < 32; ++i) { const int kk = 2 * i + (lane >> 5); const float gk = g ? g[k0 + kk] * cs : cs; scr[kk * 33 + (lane & 31)] = wv[i] * gk; }
    LDS_WAIT(); asm volatile("" ::: "memory");
    const int c = lane & 7;
#pragma unroll
    for (int j = 0; j < 4; ++j) { const int n = (lane >> 3) + 8 * j; const LAS float* s = scr + (8 * c) * 33 + n;
        v4u o; o.x = pk2(s[0 * 33], s[1 * 33]); o.y = pk2(s[2 * 33], s[3 * 33]); o.z = pk2(s[4 * 33], s[5 * 33]); o.w = pk2(s[6 * 33], s[7 * 33]);
        asm volatile("global_store_dwordx4 %0, %1, off sc1\n\ts_nop 1" : : "v"(WT + (size_t)(dst_row0 + n) * K + k0 + 8 * c), "v"(o) : "memory"); }
    LDS_WAIT(); asm volatile("" ::: "memory");
}
struct LayerW { const float *gu1, *d1, *mi, *mo, *gu2, *d2, *g1, *gm, *g2; int even; };
__device__ __forceinline__ void convert_layer(const LayerW& w, bf16* WB, int part, LAS unsigned char* lds, int gw, int NGW, int wave, int lane) {
    LAS float* scr = (LAS float*)(lds + wave * 16384);
    const int nmi = w.even ? NIN_CONV : NQKV;
    const int I_GU = (D / 64) * (2 * FF / 32), I_D = (FF / 64) * (D / 32), I_MI = (D / 64) * (nmi / 32), I_MO = (D / 64) * (D / 32);
    const int NITEMS = part == 0 ? I_GU + I_D : I_GU + I_D + I_MI + I_MO;
    for (int it = gw; it < NITEMS; it += NGW) {
        int r = it;
        if (r < I_GU) { const int nblk = 2 * FF / 32, kb = r / nblk, nb = r % nblk, n0 = nb * 32;
            const int j0 = n0 < FF ? n0 : n0 - FF; const int dst = (j0 >> 7) * 256 + (n0 < FF ? 0 : 128) + (j0 & 127);
            cvt_item(part ? w.gu2 : w.gu1, D, 2 * FF, WB + (part ? OW_GU2 : OW_GU1), dst, kb * 64, n0, part ? w.g2 : w.g1, 1.0f, scr, lane); continue; }
        r -= I_GU;
        if (r < I_D) { const int nblk = D / 32, kb = r / nblk, nb = r % nblk;
            cvt_item(part ? w.d2 : w.d1, FF, D, WB + (part ? OW_D2 : OW_D1), nb * 32, kb * 64, nb * 32, nullptr, 1.0f, scr, lane); continue; }
        r -= I_D;
        if (r < I_MI) { const int nblk = nmi / 32, kb = r / nblk, nb = r % nblk, n0 = nb * 32;
            const float cs = (!w.even && n0 < D) ? 0.125f * 1.4426950408889634f : 1.0f;
            cvt_item(w.mi, D, nmi, WB + OW_MI, n0, kb * 64, n0, w.gm, cs, scr, lane); continue; }
        r -= I_MI;
        { const int nblk = D / 32, kb = r / nblk, nb = r % nblk; cvt_item(w.mo, D, D, WB + OW_MO, nb * 32, kb * 64, nb * 32, nullptr, 1.0f, scr, lane); }
    }
}

constexpr int KP = 144;
constexpr int ATT_K = 0, ATT_V = 272 * KP;
__device__ __forceinline__ void attn_phase(LAS unsigned char* lds, const bf16* __restrict__ QKV, bf16* OG, float* LSE, int G, int vcu, int wave_s) {
    G = opqs(G); vcu = opqs(vcu);
    const int tid = tid_of(wave_s), lane = tid & 63, wid = __builtin_amdgcn_readfirstlane(tid >> 6), fr = lane & 15, fq = lane >> 4;
    const unsigned z1 = (unsigned)opq(0); const v4u zero4 = (v4u){z1, z1, z1, z1};
    for (int i = tid; i < 2 * 272 * KP / 16; i += 512) *(LAS v4u*)(lds + i * 16) = zero4;
    f32x4 relf[9];
#pragma unroll
    for (int j = 0; j < 9; ++j)
#pragma unroll
        for (int r = 0; r < 4; ++r) { const int rel = 128 + fr - 16 * j - 4 * fq - r; relf[j][r] = (rel >= 0 && rel <= 128) ? (float)rel : 1e30f; }
    const int total = 3 * BATCH * NHEAD * 64;
    const int per = (total + G - 1) / G, u_beg = vcu * per, u_end = (u_beg + per < total) ? u_beg + per : total;
    v4u kreg[2], vreg[2];
#define ATT_DECODE(u) const int g_ = (u) >> 11, rem_ = (u) & 2047, b_ = rem_ >> 10, h_ = (rem_ >> 6) & 15, rb_ = rem_ & 63, sh_ = 2 * g_, nl_ = 6 - sh_, r_ = rb_ >> nl_, n_ = rb_ & ((1 << nl_) - 1)
#define ATT_PREFETCH(u, nb) do { ATT_DECODE(u); _Pragma("unroll") for (int i = 0; i < 2; ++i) { const int idx = tid + 512 * i, k = idx >> 3, ch = idx & 7; const int j = 128 * (n_ + (nb)) + k; \
        const bf16* src = QKV + ((size_t)(b_ * SEQ + (j << sh_) + r_)) * NQKV + D + h_ * 64 + ch * 8; kreg[i] = *(const v4u*)src; vreg[i] = *(const v4u*)(src + D); } } while (0)
#define ATT_STORE(slot) do { _Pragma("unroll") for (int i = 0; i < 2; ++i) { const int idx = tid + 512 * i, k = idx >> 3, ch = idx & 7; \
        *(LAS v4u*)(lds + ATT_K + ((slot) * 128 + k) * KP + ch * 16) = kreg[i]; *(LAS v4u*)(lds + ATT_V + ((slot) * 128 + k) * KP + ch * 16) = vreg[i]; } } while (0)
    bf16x8 qn0 = (bf16x8){0, 0, 0, 0, 0, 0, 0, 0}, qn1 = qn0;
#define ATT_QLOAD(u) do { ATT_DECODE(u); const bf16* qp_ = QKV + ((size_t)(b_ * SEQ + ((128 * n_ + 16 * wid + fr) << sh_) + r_)) * NQKV + h_ * 64 + fq * 8; qn0 = *(const bf16x8*)qp_; qn1 = *(const bf16x8*)(qp_ + 32); } while (0)
    int p = 0;
    __syncthreads();
    if (u_beg < u_end) { { ATT_DECODE(u_beg); if (n_ > 0) { ATT_PREFETCH(u_beg, -1); ATT_STORE(0); } }
        ATT_PREFETCH(u_beg, 0); ATT_QLOAD(u_beg); }
    for (int u = u_beg; u < u_end; ++u) {
        __syncthreads();
        ATT_STORE(1 - p);
        __syncthreads();
        ATT_DECODE(u);
        const int dil = 1 << sh_;
        const size_t qrow = (size_t)(b_ * SEQ + ((128 * n_ + 16 * wid + fr) << sh_) + r_);
        const bf16x8 qf0 = qn0, qf1 = qn1;
        if (u + 1 < u_end) { ATT_PREFETCH(u + 1, 0); ATT_QLOAD(u + 1); }
        const float ncb = -__builtin_amdgcn_exp2f(-0.5f * (float)(h_ + 1)) * (float)dil * 1.4426950408889634f;
        f32x4 s[9];
#define ATT_ROWB(T) ((T) < 8 ? p * 128 + 16 * (T) : ((T) < 16 ? (1 - p) * 128 + 16 * ((T) - 8) : 256))
        const LAS unsigned char* kb = lds + ATT_K + fr * KP + fq * 16;
        float mx = -3.0e38f;
#pragma unroll
        for (int j = 0; j < 9; ++j) { const int rbk = ATT_ROWB(wid + j); const bf16x8 k0 = *(const LAS bf16x8*)(kb + rbk * KP), k1 = *(const LAS bf16x8*)(kb + rbk * KP + 64);
            f32x4 a = relf[j] * ncb;
            a = __builtin_amdgcn_mfma_f32_16x16x32_bf16(k0, qf0, a, 0, 0, 0); a = __builtin_amdgcn_mfma_f32_16x16x32_bf16(k1, qf1, a, 0, 0, 0);
            if (n_ == 0 && wid + j < 8) a = (f32x4){-1e30f, -1e30f, -1e30f, -1e30f};
            s[j] = a; mx = fmaxf(fmaxf(mx, fmaxf(a[0], a[1])), fmaxf(a[2], a[3])); }
        mx = fmaxf(mx, __shfl_xor(mx, 16)); mx = fmaxf(mx, __shfl_xor(mx, 32));
        float l = 0.f;
#pragma unroll
        for (int j = 0; j < 9; ++j)
#pragma unroll
            for (int r = 0; r < 4; ++r) { const float p = __builtin_amdgcn_exp2f(s[j][r] - mx); s[j][r] = p; l += p; }
        l += __shfl_xor(l, 16); l += __shfl_xor(l, 32);
        f32x4 o[4];
#pragma unroll
        for (int dt = 0; dt < 4; ++dt) o[dt] = (f32x4){0.f, 0.f, 0.f, 0.f};
        const LAS unsigned char* vb = lds + ATT_V + (4 * fq + (fr >> 2)) * KP + (fr & 3) * 8;
#pragma unroll
        for (int gk = 0; gk < 5; ++gk) {
            v4u pw; pw.x = pk2(s[2 * gk][0], s[2 * gk][1]); pw.y = pk2(s[2 * gk][2], s[2 * gk][3]);
            if (gk < 4) { pw.z = pk2(s[(2 * gk + 1) % 9][0], s[(2 * gk + 1) % 9][1]); pw.w = pk2(s[(2 * gk + 1) % 9][2], s[(2 * gk + 1) % 9][3]); } else { pw.z = 0u; pw.w = 0u; }
            const bf16x8 pb = __builtin_bit_cast(bf16x8, pw);
            const int rv0 = ATT_ROWB(wid + 2 * gk), rv1 = ATT_ROWB(wid + 2 * gk + 1);
#pragma unroll
            for (int dt = 0; dt < 4; ++dt) {
                const s16x4 lo = __builtin_bit_cast(s16x4, __builtin_amdgcn_ds_read_tr16_b64_v4i16((LAS s16x4*)(vb + rv0 * KP + dt * 32)));
                const s16x4 hi = __builtin_bit_cast(s16x4, __builtin_amdgcn_ds_read_tr16_b64_v4i16((LAS s16x4*)(vb + rv1 * KP + dt * 32)));
                const bf16x8 vf = (bf16x8){lo[0], lo[1], lo[2], lo[3], hi[0], hi[1], hi[2], hi[3]};
                o[dt] = __builtin_amdgcn_mfma_f32_16x16x32_bf16(vf, pb, o[dt], 0, 0, 0);
            }
        }
        const float il = __builtin_amdgcn_rcpf(l);
        bf16* op = OG + (size_t)g_ * M * D + qrow * D + h_ * 64 + 4 * fq;
#pragma unroll
        for (int dt = 0; dt < 4; ++dt) { v2u w; w.x = pk2(o[dt][0] * il, o[dt][1] * il); w.y = pk2(o[dt][2] * il, o[dt][3] * il); *(v2u*)(op + dt * 16) = w; }
        if (fq == 0) LSE[(size_t)g_ * M * NHEAD + qrow * NHEAD + h_] = mx + __builtin_amdgcn_logf(l);
        p ^= 1;
    }
#undef ATT_STORE
#undef ATT_ROWB
#undef ATT_QLOAD
#undef ATT_DECODE
#undef ATT_PREFETCH
}
__device__ __forceinline__ void merge_phase(const bf16* __restrict__ OG, const float* __restrict__ LSE, bf16* MG, int item0_, int total_, int nth_, int wave_s) {
    item0_ = opqs(item0_); total_ = opqs(total_); nth_ = opqs(nth_);
    const int tid = tid_of(wave_s);
    const size_t nth = (size_t)nth_, total = (size_t)total_;
    for (size_t base = (size_t)item0_ + tid; base < total; base += 4 * nth) {
        v4u a[4], b[4], c[4]; float l0[4], l1[4], l2[4];
#pragma unroll
        for (int e = 0; e < 4; ++e) { const size_t idx = base + e * nth; if (idx < total) { const size_t row = idx >> 7; const int cc = (int)(idx & 127), h = cc >> 3;
            l0[e] = LSE[row * NHEAD + h]; l1[e] = LSE[(size_t)M * NHEAD + row * NHEAD + h]; l2[e] = LSE[(size_t)2 * M * NHEAD + row * NHEAD + h];
            a[e] = *(const v4u*)(OG + row * D + cc * 8); b[e] = *(const v4u*)(OG + (size_t)M * D + row * D + cc * 8); c[e] = *(const v4u*)(OG + (size_t)2 * M * D + row * D + cc * 8); } }
#pragma unroll
        for (int e = 0; e < 4; ++e) { const size_t idx = base + e * nth; if (idx < total) { const size_t row = idx >> 7; const int cc = (int)(idx & 127);
            const float mx = fmaxf(l0[e], fmaxf(l1[e], l2[e]));
            float w0 = __builtin_amdgcn_exp2f(l0[e] - mx), w1 = __builtin_amdgcn_exp2f(l1[e] - mx), w2 = __builtin_amdgcn_exp2f(l2[e] - mx);
            const float inv = __builtin_amdgcn_rcpf(w0 + w1 + w2); w0 *= inv; w1 *= inv; w2 *= inv;
            v4u o;
#pragma unroll
            for (int i = 0; i < 4; ++i) o[i] = pk2(w0 * bf_lo(a[e][i]) + w1 * bf_lo(b[e][i]) + w2 * bf_lo(c[e][i]), w0 * bf_hi(a[e][i]) + w1 * bf_hi(b[e][i]) + w2 * bf_hi(c[e][i]));
            asm volatile("global_store_dwordx4 %0, %1, off sc1\n\ts_nop 1" : : "v"(MG + row * D + cc * 8), "v"(o) : "memory"); } }
    }
}

__device__ __forceinline__ float sigmoidf_(float x) { return __builtin_amdgcn_rcpf(1.0f + __builtin_amdgcn_exp2f(x * -1.4426950408889634f)); }
__device__ __forceinline__ void conv_phase(LAS unsigned char* lds, const bf16* __restrict__ Z, bf16* CAT, const float* __restrict__ wa, const float* __restrict__ wb, const float* __restrict__ bias,
                                           const float* __restrict__ lng, const float* __restrict__ lnb, int u0, int ustep, int uend, int wave_s) {
    u0 = opqs(u0); ustep = opqs(ustep); uend = opqs(uend);
    const int tid = tid_of(wave_s), lane = tid & 63, wid = __builtin_amdgcn_readfirstlane(tid >> 6), cp = tid & 255, th = tid >> 8;
    LAS float* red = (LAS float*)(lds + 94 * 1024);
    const unsigned z1 = (unsigned)opq(0); const v4u zero4 = (v4u){z1, z1, z1, z1};
    const bool shared = (ustep == 1 && uend - u0 == 2);
    const int nrows = shared ? 94 : 62, nbatch = shared ? 3 : 2;
    float w0[31], w1[31];
#pragma unroll
    for (int k = 0; k < 31; ++k) { const v2u w = *(const v2u*)(wb + k * 512 + 2 * cp); w0[k] = __uint_as_float(w.x); w1[k] = __uint_as_float(w.y); }
    for (int unit = u0; unit < uend; unit += ustep) {
        const int row0 = unit * 32, s0 = row0 & (SEQ - 1);
        const int lro = shared ? (unit - u0) * 32 : 0;
        __syncthreads();
        if (!shared || unit == u0) {
#pragma unroll 1
        for (int hb = 0; hb < nbatch; ++hb) { v4u bv[4], bg[4];
#pragma unroll
          for (int i = 0; i < 4; ++i) { const int it = tid + 512 * (4 * hb + i), lr = it >> 6, ch = it & 63; bv[i] = zero4; bg[i] = zero4;
              if (it < nrows * 64 && s0 - 30 + lr >= 0) { const bf16* zp = Z + (size_t)(row0 - 30 + lr) * ZPITCH + 1536 + ch * 8; bv[i] = *(const v4u*)zp; bg[i] = *(const v4u*)(zp + 512); } }
#pragma unroll
          for (int i = 0; i < 4; ++i) { const int it = tid + 512 * (4 * hb + i), lr = it >> 6, ch = it & 63; v4u o;
#pragma unroll
              for (int e = 0; e < 4; ++e) o[e] = pk2(bf_lo(bv[i][e]) * sigmoidf_(bf_lo(bg[i][e])), bf_hi(bv[i][e]) * sigmoidf_(bf_hi(bg[i][e])));
              if (it < nrows * 64) *(LAS v4u*)(lds + lr * 1024 + ch * 16) = o; } }
        __syncthreads();
        }
        float acc[16][2];
        { const v2u b = *(const v2u*)(bias + 2 * cp); const float b0 = __uint_as_float(b.x), b1 = __uint_as_float(b.y);
#pragma unroll
          for (int t = 0; t < 16; ++t) { acc[t][0] = b0; acc[t][1] = b1; } }
        const LAS unsigned char* up = lds + (lro + th * 16) * 1024 + cp * 4;
#pragma unroll
        for (int j = 0; j < 46; ++j) { const unsigned uu = *(const LAS unsigned*)(up + j * 1024); const float ul = bf_lo(uu), uh = bf_hi(uu);
#pragma unroll
            for (int t = 0; t < 16; ++t) { const int k = j - t; if (k >= 0 && k < 31) { acc[t][0] += w0[k] * ul; acc[t][1] += w1[k] * uh; } }
            if ((j & 7) == 7) asm volatile("" ::: "memory"); }
#pragma unroll
        for (int t = 0; t < 16; ++t) { const float s1 = wave_sum_hi(acc[t][0] + acc[t][1]), s2 = wave_sum_hi(acc[t][0] * acc[t][0] + acc[t][1] * acc[t][1]);
            if (lane == 63) { red[(wid * 16 + t) * 2] = s1; red[(wid * 16 + t) * 2 + 1] = s2; } }
        __syncthreads();
        { const float g0 = lng[2 * cp], g1 = lng[2 * cp + 1], c0 = lnb[2 * cp], c1 = lnb[2 * cp + 1];
#pragma unroll
          for (int t = 0; t < 16; ++t) { float s1 = 0.f, s2 = 0.f;
#pragma unroll
              for (int w = 0; w < 4; ++w) { s1 += red[((th * 4 + w) * 16 + t) * 2]; s2 += red[((th * 4 + w) * 16 + t) * 2 + 1]; }
              const float mean = s1 * (1.0f / 512.0f), var = fmaxf(s2 * (1.0f / 512.0f) - mean * mean, 0.f), rstd = __builtin_amdgcn_rsqf(var + 1e-5f);
              const float y0 = (acc[t][0] - mean) * rstd * g0 + c0, y1 = (acc[t][1] - mean) * rstd * g1 + c1;
              *(unsigned*)(CAT + (size_t)(row0 + th * 16 + t) * D + 512 + 2 * cp) = pk2(y0 * sigmoidf_(y0), y1 * sigmoidf_(y1)); } }
        { const float a00 = wa[2 * cp], a01 = wa[2 * cp + 1], a10 = wa[512 + 2 * cp], a11 = wa[512 + 2 * cp + 1], a20 = wa[1024 + 2 * cp], a21 = wa[1024 + 2 * cp + 1];
          unsigned zc[18], zx[18], zb[16];
#pragma unroll
          for (int t = -2; t < 16; ++t) { const int s = s0 + th * 16 + t; const bf16* zp = Z + (size_t)(row0 + th * 16 + t) * ZPITCH + 2 * cp; zc[t + 2] = 0u; zx[t + 2] = 0u;
              if (s >= 0) { zc[t + 2] = *(const unsigned*)(zp + 512); zx[t + 2] = *(const unsigned*)(zp + 1024); }
              if (t >= 0) zb[t] = *(const unsigned*)zp; }
          float p2x = 0.f, p2y = 0.f, p1x = 0.f, p1y = 0.f;
#pragma unroll
          for (int t = -2; t < 16; ++t) { const float px = bf_lo(zc[t + 2]) * bf_lo(zx[t + 2]), py = bf_hi(zc[t + 2]) * bf_hi(zx[t + 2]);
              if (t >= 0) { const float y0 = bf_lo(zb[t]) * (a00 * p2x + a10 * p1x + a20 * px), y1 = bf_hi(zb[t]) * (a01 * p2y + a11 * p1y + a21 * py);
                  *(unsigned*)(CAT + (size_t)(row0 + th * 16 + t) * D + 2 * cp) = pk2(y0, y1); }
              p2x = p1x; p2y = p1y; p1x = px; p1y = py; } }
    }
}

typedef __attribute__((address_space(1))) unsigned gu32;
#define XB_TMO      128
#define XB_XCNT(j)  (256  + 64 * (j))
#define XB_XSUB(j)  (1280 + 64 * (j))
#define XB_XGEN(j)  (2304 + 64 * (j))
#define XB_TOP      3328
#define XB_TOPGEN   3392
#define XCD_BAR_WORDS 3456
#define XB_SPIN_CAP (1u << 18)

__device__ __forceinline__ unsigned xb_ld(unsigned* p)              { return __hip_atomic_load(p, __ATOMIC_RELAXED, __HIP_MEMORY_SCOPE_AGENT); }
__device__ __forceinline__ unsigned xb_add(unsigned* p, unsigned v) { return __hip_atomic_fetch_add(p, v, __ATOMIC_RELAXED, __HIP_MEMORY_SCOPE_AGENT); }
__device__ __forceinline__ unsigned xb_xcc_id() { return (unsigned)__builtin_amdgcn_s_getreg((3 << 11) | 20) & 0xFu; }
#define XB_SPIN(cond, bar) do { unsigned _sp = 0; while (cond) { __builtin_amdgcn_s_sleep(1); \
    if ((++_sp & 255u) == 0u) { if (xb_ld(&(bar)[XB_TMO])) break; if (_sp > XB_SPIN_CAP) { atomicAdd(&(bar)[XB_TMO], 1u); break; } } } } while (0)

struct XcdBarrier {
    unsigned* bar; unsigned x; int wv;
    volatile LAS unsigned* st;
};

__device__ __forceinline__ XcdBarrier xcd_barrier_post(unsigned* bar, volatile LAS unsigned* st) {
    XcdBarrier b; b.bar = bar; b.x = xb_xcc_id(); b.st = st; b.wv = 0;
    if (threadIdx.x == 0) (void)xb_add(&bar[XB_XCNT(b.x)], 1u);
    return b;
}
__device__ __forceinline__ void xcd_barrier_complete(unsigned* bar, unsigned x, unsigned& nloc, unsigned& nx) {
    const unsigned G = gridDim.x * gridDim.y * gridDim.z;
    asm volatile("" : "+s"(x));
    unsigned sum, cnt, mine, sp = 0u;
    for (;;) {
        sum = 0u; cnt = 0u; mine = 0u;
#pragma unroll
        for (unsigned j = 0; j < 16; ++j) { const unsigned c = xb_ld(&bar[XB_XCNT(j)]); sum += c; cnt += (c > 0u) ? 1u : 0u; mine = (j == x) ? c : mine; }
        if (sum == G) break;
        __builtin_amdgcn_s_sleep(1);
        if ((++sp & 255u) == 0u) { if (xb_ld(&bar[XB_TMO])) break; if (sp > XB_SPIN_CAP) { atomicAdd(&bar[XB_TMO], 1u); break; } }
    }
    nloc = mine > 0u ? mine : 1u; nx = cnt > 0u ? cnt : 1u;
}

__device__ __forceinline__ void xcd_barrier(const XcdBarrier& b) {
    asm volatile("s_waitcnt vmcnt(0)" ::: "memory");
    __syncthreads();
    if (tid_of(b.wv) == 0) {
        unsigned* bar = b.bar;
        __builtin_amdgcn_s_waitcnt(0);
        unsigned nloc = b.st[0], nx = b.st[1];
        if (nloc == 0u) { xcd_barrier_complete(bar, b.x, nloc, nx); b.st[0] = nloc; b.st[1] = nx; }
        const unsigned old = xb_add(&bar[XB_XSUB(b.x)], 1u);
        const unsigned gen = old / nloc;
        if (old + 1u == (gen + 1u) * nloc) {
            __builtin_amdgcn_fence(__ATOMIC_RELEASE, "agent");
            asm volatile("s_waitcnt vmcnt(0)" ::: "memory");
            const unsigned og = xb_add(&bar[XB_TOP], 1u);
            const unsigned tg = og / nx;
            if (og + 1u == (tg + 1u) * nx) xb_add(&bar[XB_TOPGEN], 1u);
            else XB_SPIN(xb_ld(&bar[XB_TOPGEN]) == tg, bar);
            __builtin_amdgcn_fence(__ATOMIC_ACQUIRE, "agent");
            xb_add(&bar[XB_XGEN(b.x)], 1u);
            asm volatile("s_waitcnt vmcnt(0)" ::: "memory");
        } else {
            XB_SPIN(xb_ld(&bar[XB_XGEN(b.x)]) == gen, bar);
            __builtin_amdgcn_fence(__ATOMIC_ACQUIRE, "agent");
            asm volatile("s_waitcnt vmcnt(0)" ::: "memory");
        }
    }
    __syncthreads();
}

constexpr int CW_CVT = 12288;
constexpr int CW_GRP = 8192;
__device__ __forceinline__ void group_barrier(unsigned* cnt, unsigned target, unsigned* bar, int wave_s, unsigned* cvt = nullptr, unsigned cvt_target = 0u) {
    asm volatile("s_waitcnt vmcnt(0)" ::: "memory");
    __syncthreads();
    if (tid_of(wave_s) == 0) {
        (void)xb_add(cnt, 1u);
        XB_SPIN(xb_ld(cnt) < target, bar);
        if (cvt) XB_SPIN(xb_ld(cvt) < cvt_target, bar);
        __builtin_amdgcn_fence(__ATOMIC_ACQUIRE, "agent");
        asm volatile("s_waitcnt vmcnt(0)" ::: "memory");
    }
    __syncthreads();
}

struct Args { const float* in[18]; float* out; unsigned char* ws; int ph_lo, ph_hi; };
__global__ void __launch_bounds__(NWAVES * 64, 2) mk_fwd(Args args) {
    extern __shared__ __attribute__((aligned(16))) unsigned char lds_raw[];
    LAS unsigned char* lds = (LAS unsigned char*)lds_raw;
    cg::grid_group grid = cg::this_grid();
    const int wave_s = __builtin_amdgcn_readfirstlane(threadIdx.x >> 6);
    for (int u = threadIdx.x; u < (LDS_BYTES - 131072) / 4; u += NWAVES * 64) ((LAS unsigned*)(lds + 131072))[u] = 0u;
    __syncthreads();
#if MK_N_LAUNCHES == 1
    if (args.ph_hi < 0) grid.sync();
#endif
    XcdBarrier xbar = xcd_barrier_post((unsigned*)(args.ws + WS_CTL) + CW_BAR, (volatile LAS unsigned*)(lds + MISC_OFF) + 8); xbar.wv = wave_s;
    const int G = gridDim.x, bx = blockIdx.x, vcu = (G % 8 == 0) ? (bx % 8) * (G / 8) + bx / 8 : bx;
    const int NGW = G * NWAVES;
#define TID_VARS const int tid = tid_of(wave_s), lane = tid & 63, wave = __builtin_amdgcn_readfirstlane(tid >> 6), gw = vcu * NWAVES + wave; (void)gw; (void)lane
    unsigned char* ws = args.ws;
    float* X = args.out;
#define WSQ ({ unsigned char* p_ = ws; asm volatile("" : "+s"(p_)); p_; })
#define SS ((pg8::ss_t*)(WSQ + WS_SS))
#define LSE ((float*)(WSQ + WS_LSE))
#define XB ((bf16*)(WSQ + WS_XB))
#define ACT ((bf16*)(WSQ + WS_ACT))
#define OG ((bf16*)(WSQ + WS_OG))
#define MG ((bf16*)(WSQ + WS_MG))
    const int lo = args.ph_lo, hi = args.ph_hi;
    int ph = 0, ngrp = 0;
#define PANEL_OF(c) (8 * ((c) % 8) + ((c) / 8) % 8)
#define PH_ON (ph >= lo && ph < hi)
#define GRID_BAR() do { asm volatile("s_waitcnt vmcnt(0)" ::: "memory"); grid.sync(); __builtin_amdgcn_fence(__ATOMIC_ACQUIRE, "agent"); asm volatile("s_waitcnt vmcnt(0)" ::: "memory"); } while (0)
#ifdef DUP_BAR
#define PH_END do { if (PH_ON && ph + 1 < hi) { if (ph == 0) GRID_BAR(); else { xcd_barrier(xbar); xcd_barrier(xbar); } } ++ph; } while (0)
#else
#define PH_END do { if (PH_ON && ph + 1 < hi) xcd_barrier(xbar); ++ph; } while (0)
#endif
#if MK_N_LAUNCHES == 1 && !defined(NO_GROUP_BAR)
#define PH_END_GRP do { if (PH_ON && ph + 1 < hi) { if (G == 256) { const int c_ = opqs(bx); group_barrier((unsigned*)(args.ws + WS_CTL) + CW_GRP + 64 * (8 * (c_ % 8) + (c_ / 8) % 8), 4u * (unsigned)(ngrp + 1), (unsigned*)(args.ws + WS_CTL) + CW_BAR, wave_s); ++ngrp; } else xcd_barrier(xbar); } ++ph; } while (0)
#define PH_END_GRPC(job) do { if (PH_ON && ph + 1 < hi) { const int nt_ = ((M / 256) * (2 * FF / 256)) % G; if (G == 256 && nt_ > 0) { const int c_ = opqs(bx); group_barrier((unsigned*)(args.ws + WS_CTL) + CW_GRP + 64 * (8 * (c_ % 8) + (c_ / 8) % 8), 4u * (unsigned)(ngrp + 1), (unsigned*)(args.ws + WS_CTL) + CW_BAR, wave_s, (unsigned*)(args.ws + WS_CTL) + CW_CVT + 64 * (job), (unsigned)(G - nt_)); ++ngrp; } else xcd_barrier(xbar); } ++ph; } while (0)
#else
#define PH_END_GRP PH_END
#define PH_END_GRPC(job) PH_END
#endif
#define MAKE_RT(rt, MODE) pg8::RsTable<MODE> rt; { const int t_ = tid_of(wave_s), w_ = __builtin_amdgcn_readfirstlane(t_ >> 6); rt.tab = (LAS float*)(lds + RST_OFF) + w_ * 128; rt.ss = ss_in; \
        pg8::Unit u0_{0, 0}; if (MODE && S.next(0, u0_)) rt.fill(u0_.pm, w_ >> 2, t_ & 63); }
#define MAKE_LW(lw, L) LayerW lw; { const int L_ = (L), i_ = L_ >> 1; lw.even = !(L_ & 1); \
        lw.gu1 = args.in[2] + (size_t)L_ * D * 2 * FF; lw.d1 = args.in[3] + (size_t)L_ * FF * D; lw.gu2 = args.in[6] + (size_t)L_ * D * 2 * FF; lw.d2 = args.in[7] + (size_t)L_ * FF * D; \
        lw.g1 = args.in[1] + L_ * D; lw.gm = args.in[4] + L_ * D; lw.g2 = args.in[5] + L_ * D; \
        lw.mi = lw.even ? args.in[8] + (size_t)i_ * D * NIN_CONV : args.in[15] + (size_t)i_ * D * NQKV; lw.mo = lw.even ? args.in[14] + (size_t)i_ * D * D : args.in[16] + (size_t)i_ * D * D; }

    if (PH_ON) {
        TID_VARS;
        const float* x = args.in[0];
        for (int m0 = gw; m0 < M; m0 += 2 * NGW) { f32x4 v[2][4]; float s[2] = {0.f, 0.f};
#pragma unroll
            for (int e = 0; e < 2; ++e) { const int m = m0 + e * NGW; if (m < M) { const f32x4* xr = (const f32x4*)(x + (size_t)m * D) + lane;
#pragma unroll
                for (int j = 0; j < 4; ++j) v[e][j] = xr[64 * j]; } }
#pragma unroll
            for (int e = 0; e < 2; ++e) { const int m = m0 + e * NGW; if (m < M) {
#pragma unroll
                for (int j = 0; j < 4; ++j) s[e] += (v[e][j].x * v[e][j].x + v[e][j].y * v[e][j].y) + (v[e][j].z * v[e][j].z + v[e][j].w * v[e][j].w);
                s[e] = wave_sum(s[e]);
                v2u* bo = (v2u*)(XB + (size_t)m * D) + lane;
#pragma unroll
                for (int j = 0; j < 4; ++j) { v2u w; w.x = pk2(v[e][j].x, v[e][j].y); w.y = pk2(v[e][j].z, v[e][j].w); bo[64 * j] = w; }
                if (lane == 0) SS[m] = (pg8::ss_t)(s[e] * pg8::SS_SCALE); } } }
        MAKE_LW(lw, 0); convert_layer(lw, (bf16*)(ws + WS_W), 0, lds, gw, NGW, wave, lane);
    }
    PH_END;

    for (int sb = 0; sb < 3 * DEPTH; ++sb) {
        const int L = sb / 3, kind = sb % 3, even = !(L & 1);
        bf16* WB = (bf16*)(ws + WS_W + (size_t)(L & 1) * W_STRIDE);
        pg8::ss_t* ss_in = SS + (size_t)sb * M; pg8::ss_t* ss_out = SS + (size_t)(sb + 1) * M;
        if (kind != 1) {
            if (PH_ON) { pg8::Gemm g{XB, WB + (kind ? OW_GU2 : OW_GU1), M, 2 * FF, D}; pg8::StaticOrder S; S.init(M, 2 * FF, opqs(G), opqs(bx));
                if (G == 256) { MAKE_RT(rt, true); pg8::EpiSwiglu<true> E{ACT, ZPITCH, rt}; pg8::gemm_phase<pg8::EpiSwiglu<true>, pg8::StaticOrder, true, true>(lds, g, S, E, wave_s); }
#ifndef PROBE_NOFALLBACK
                else { MAKE_RT(rt, false); pg8::EpiSwiglu<false> E{ACT, ZPITCH, rt}; pg8::gemm_phase<pg8::EpiSwiglu<false>, pg8::StaticOrder, true, true>(lds, g, S, E, wave_s); }
#endif
                { const int nwg = (M / 256) * (2 * FF / 256), ntail = nwg % G, cl = (kind == 0) ? L : L + 1;
                  if (ntail > 0 && bx >= ntail && cl < DEPTH) { TID_VARS; MAKE_LW(lw, cl);
                      convert_layer(lw, (bf16*)(ws + WS_W + (size_t)(cl & 1) * W_STRIDE), kind == 0 ? 1 : 0, lds, (bx - ntail) * NWAVES + wave, (G - ntail) * NWAVES, wave, lane);
                      asm volatile("s_waitcnt vmcnt(0)" ::: "memory"); __syncthreads();
                      if (tid == 0) (void)xb_add((unsigned*)(args.ws + WS_CTL) + CW_CVT + 64 * (2 * cl + (kind == 0 ? 1 : 0)), 1u); }
                  else if (ntail == 0 && cl < DEPTH) { TID_VARS; MAKE_LW(lw, cl); convert_layer(lw, (bf16*)(ws + WS_W + (size_t)(cl & 1) * W_STRIDE), kind == 0 ? 1 : 0, lds, gw, NGW, wave, lane); } }
            }
            PH_END_GRP;
            if (PH_ON) { pg8::Gemm g{ACT, WB + (kind ? OW_D2 : OW_D1), M, D, FF, ZPITCH}; pg8::StaticOrder S; S.init(M, D, opqs(G), opqs(bx));
                pg8::EpiResid E{XB, ss_out, 0.5f, G == 256 ? (LAS pg8::ss_t*)(lds + QTAB_OFF) : (LAS pg8::ss_t*)nullptr};
#ifndef NO_G2
                pg8::gemm_phase<pg8::EpiResid, pg8::StaticOrder, true, true>(lds, g, S, E, wave_s);
#endif
                if (G == 256) { __syncthreads(); const int t_ = tid_of(wave_s); pg8::Unit u0_{0, 0};
                    if (t_ < 256 && S.next(0, u0_)) { const LAS pg8::ss_t* p_ = (const LAS pg8::ss_t*)(lds + QTAB_OFF) + t_ * 4; __hip_atomic_fetch_add(ss_out + u0_.pm * 256 + t_, (p_[0] + p_[1]) + (p_[2] + p_[3]), __ATOMIC_RELAXED, __HIP_MEMORY_SCOPE_AGENT); } }
#ifdef DUP_G2
                xcd_barrier(xbar); { pg8::EpiResid E2{XB, SS + (size_t)13 * M, 0.0f, (LAS pg8::ss_t*)nullptr}; pg8::gemm_phase<pg8::EpiResid, pg8::StaticOrder, true, true>(lds, g, S, E2, wave_s); }
#endif
            }
            if (kind == 0) PH_END_GRPC(2 * L + 1); else if (L + 1 < DEPTH) PH_END_GRPC(2 * (L + 1)); else PH_END_GRP;
        } else {
            const int nmi = even ? NIN_CONV : NQKV;
            if (PH_ON) { pg8::Gemm g{XB, WB + OW_MI, M, nmi, D}; pg8::StaticOrder S; S.init(M, nmi, opqs(G), opqs(bx));
                if (G == 256) { MAKE_RT(rt, true); pg8::EpiScale<true> E{ACT, ZPITCH, rt}; pg8::gemm_phase<pg8::EpiScale<true>, pg8::StaticOrder, true, true>(lds, g, S, E, wave_s); }
#ifndef PROBE_NOFALLBACK
                else { MAKE_RT(rt, false); pg8::EpiScale<false> E{ACT, ZPITCH, rt}; pg8::gemm_phase<pg8::EpiScale<false>, pg8::StaticOrder, true, true>(lds, g, S, E, wave_s); }
#endif
            }
            PH_END;
            if (PH_ON) {
                const int i = L >> 1;
                if (even) {
#ifndef NO_CONV
                    conv_phase(lds, ACT, OG, args.in[9] + i * 3 * 512, args.in[10] + i * 31 * 512, args.in[11] + i * 512, args.in[12] + i * 512, args.in[13] + i * 512, G == 256 ? PANEL_OF(bx) * 8 + (bx >> 6) * 2 : vcu, G == 256 ? 1 : G, G == 256 ? PANEL_OF(bx) * 8 + (bx >> 6) * 2 + 2 : M / 32, wave_s);
#endif
#ifdef DUP_CONV
                    __syncthreads(); conv_phase(lds, ACT, OG, args.in[9] + i * 3 * 512, args.in[10] + i * 31 * 512, args.in[11] + i * 512, args.in[12] + i * 512, args.in[13] + i * 512, G == 256 ? PANEL_OF(bx) * 8 + (bx >> 6) * 2 : vcu, G == 256 ? 1 : G, G == 256 ? PANEL_OF(bx) * 8 + (bx >> 6) * 2 + 2 : M / 32, wave_s);
#endif
                } else {
#ifndef NO_ATT
                    attn_phase(lds, ACT, OG, LSE, G, vcu, wave_s);
#endif
#ifdef DUP_ATT
                    __syncthreads(); attn_phase(lds, ACT, OG, LSE, G, vcu, wave_s);
#endif
                }
            }
            PH_END;
            if (!even) { if (PH_ON) { merge_phase(OG, LSE, MG, G == 256 ? (PANEL_OF(bx) * 256 + (bx >> 6) * 64) * 128 : vcu * 512, G == 256 ? (PANEL_OF(bx) * 256 + (bx >> 6) * 64 + 64) * 128 : M * 128, G == 256 ? 512 : G * 512, wave_s);
#ifdef DUP_MERGE
                xcd_barrier(xbar); merge_phase(OG, LSE, MG, G == 256 ? (PANEL_OF(bx) * 256 + (bx >> 6) * 64) * 128 : vcu * 512, G == 256 ? (PANEL_OF(bx) * 256 + (bx >> 6) * 64 + 64) * 128 : M * 128, G == 256 ? 512 : G * 512, wave_s);
#endif
            } PH_END_GRP; }
            if (PH_ON) { pg8::Gemm g{even ? OG : MG, WB + OW_MO, M, D, D}; pg8::StaticOrder S; S.init(M, D, opqs(G), opqs(bx));
                pg8::EpiResid E{XB, ss_out, 1.0f, G == 256 ? (LAS pg8::ss_t*)(lds + QTAB_OFF) : (LAS pg8::ss_t*)nullptr};
#ifndef NO_G4
                pg8::gemm_phase<pg8::EpiResid, pg8::StaticOrder, true, true>(lds, g, S, E, wave_s);
#endif
                if (G == 256) { __syncthreads(); const int t_ = tid_of(wave_s); pg8::Unit u0_{0, 0};
                    if (t_ < 256 && S.next(0, u0_)) { const LAS pg8::ss_t* p_ = (const LAS pg8::ss_t*)(lds + QTAB_OFF) + t_ * 4; __hip_atomic_fetch_add(ss_out + u0_.pm * 256 + t_, (p_[0] + p_[1]) + (p_[2] + p_[3]), __ATOMIC_RELAXED, __HIP_MEMORY_SCOPE_AGENT); } }
#ifdef DUP_G4
                xcd_barrier(xbar); { pg8::EpiResid E2{XB, SS + (size_t)13 * M, 0.0f, (LAS pg8::ss_t*)nullptr}; pg8::gemm_phase<pg8::EpiResid, pg8::StaticOrder, true, true>(lds, g, S, E2, wave_s); }
#endif
            }
            PH_END_GRP;
        }
    }
    if (PH_ON) {
        TID_VARS;
        const float* gf = args.in[17]; const pg8::ss_t* ssf = SS + (size_t)12 * M;
        f32x4 gv[4];
#pragma unroll
        for (int j = 0; j < 4; ++j) gv[j] = ((const f32x4*)gf)[64 * j + lane];
        const int fm0 = (G == 256) ? PANEL_OF(bx) * 256 + (bx >> 6) * 64 + wave : gw, fstep = (G == 256) ? 8 : NGW, fend = (G == 256) ? PANEL_OF(bx) * 256 + (bx >> 6) * 64 + 64 : M;
        for (int m0 = fm0; m0 < fend; m0 += 2 * fstep) { v2u w[2][4]; float rs[2] = {0.f, 0.f};
#pragma unroll
            for (int e = 0; e < 2; ++e) { const int m = m0 + e * fstep; if (m < fend) { const v2u* xb = (const v2u*)(XB + (size_t)m * D) + lane; rs[e] = pg8::rstd_of(ssf, m);
#pragma unroll
                for (int j = 0; j < 4; ++j) w[e][j] = xb[64 * j]; } }
#pragma unroll
            for (int e = 0; e < 2; ++e) { const int m = m0 + e * fstep; if (m < fend) { f32x4* xo = (f32x4*)(X + (size_t)m * D) + lane;
#pragma unroll
                for (int j = 0; j < 4; ++j) { const f32x4 v = (f32x4){bf_lo(w[e][j].x), bf_hi(w[e][j].x), bf_lo(w[e][j].y), bf_hi(w[e][j].y)}; xo[64 * j] = v * rs[e] * gv[j]; } } } }
    }
    ++ph;
}
constexpr int N_PHASES = 1 + 2 * (2 + 3 + 2) + 2 * (2 + 4 + 2) + 1;

extern "C" void kernel_launch(void* const* d_in, const int* in_sizes, int n_in, void* d_out, int out_size, void* d_ws, size_t ws_size, hipStream_t stream) {
    static int grid = 0;
    if (grid == 0) {
        if (n_in != 18 || in_sizes[0] != M * D || out_size != M * D || ws_size < WS_END) { fprintf(stderr, "kernel_launch: unexpected shapes (n_in %d, in0 %d, out %d, ws %zu)\n", n_in, n_in > 0 ? in_sizes[0] : -1, out_size, ws_size); grid = -1; return; }
        int dev = 0, cus = 0, per_cu = 0;
        hipGetDevice(&dev); hipDeviceGetAttribute(&cus, hipDeviceAttributeMultiprocessorCount, dev);
        if (hipFuncSetAttribute((const void*)mk_fwd, hipFuncAttributeMaxDynamicSharedMemorySize, LDS_BYTES) != hipSuccess) { fprintf(stderr, "kernel_launch: hipFuncSetAttribute failed\n"); grid = -1; return; }
        if (hipOccupancyMaxActiveBlocksPerMultiprocessor(&per_cu, (const void*)mk_fwd, NWAVES * 64, LDS_BYTES) != hipSuccess || per_cu < 1) { fprintf(stderr, "kernel_launch: occupancy query says %d\n", per_cu); per_cu = 1; }
        (void)hipGetLastError();
        grid = cus * (per_cu > 1 ? 1 : per_cu);
    }
    if (grid < 0) return;
    hipMemsetAsync((char*)d_ws + WS_CTL, 0, CTL_ZERO_BYTES, stream);
    Args a{};
    for (int i = 0; i < 18; ++i) a.in[i] = (const float*)d_in[i];
    a.out = (float*)d_out; a.ws = (unsigned char*)d_ws;
#if MK_N_LAUNCHES == 1
    a.ph_lo = 0; a.ph_hi = N_PHASES;
    void* kargs[] = {&a};
    hipError_t e = hipLaunchCooperativeKernel((const void*)mk_fwd, dim3(grid), dim3(NWAVES * 64), kargs, LDS_BYTES, stream);
    if (e != hipSuccess) fprintf(stderr, "kernel_launch: cooperative launch failed: %s (grid %d)\n", hipGetErrorString(e), grid);
#else
    for (int p = 0; p < N_PHASES; ++p) { a.ph_lo = p; a.ph_hi = p + 1; hipLaunchKernelGGL(mk_fwd, dim3(grid), dim3(NWAVES * 64), LDS_BYTES, stream, a); }
#endif
}
```

```cpp
#include <hip/hip_runtime.h>
#include <hip/hip_cooperative_groups.h>
#include <cstdio>
#include <cstdint>
namespace cg = cooperative_groups;
namespace pg8 {
#define PG8_LAS __attribute__((address_space(3)))
typedef unsigned short bf16_t;
typedef short bf16x8 __attribute__((ext_vector_type(8)));
typedef float f32x4 __attribute__((ext_vector_type(4)));
typedef unsigned u32x4 __attribute__((ext_vector_type(4)));
constexpr int BM = 256, BK = 64, HALF = 128, HTB = HALF * BK * 2  , STAGE_BYTES = 8 * HTB, NXCD = 8, WGM = 8;

__host__ __device__ __forceinline__ int lds_byte(int r, int c) { const int st = (r >> 4) * 2 + (c >> 5), rr = r & 15, cc = c & 31, ob = rr * 64 + cc * 2; return st * 1024 + (ob ^ (((ob >> 9) & 1) << 5)); }
__host__ __device__ __forceinline__ void stage_rc(int b, int& R, int& C) { const int st = b / 1024, sb = b % 1024, swz = sb ^ (((sb >> 9) & 1) << 5); R = (st >> 1) * 16 + swz / 64; C = (st & 1) * 32 + (swz % 64) / 2; }
__host__ __device__ __forceinline__ int perm32(int rho) { const int n = rho >> 4, i = rho & 15; return 8 * (i >> 2) + 4 * n + (i & 3); }

struct Unit { int pm, pn; };
struct Gemm { const bf16_t* A; const bf16_t* Bt; int M, N, K; int lda; };

struct StaticOrder {
    int nM, nN, nwg, G, c;
    __host__ __device__ void init(int M, int N, int G_, int c_) { nM = M / BM; nN = N / BM; nwg = nM * nN; G = G_; c = c_; }
    __host__ __device__ bool next(int i, Unit& u) const {
        const long L = (long)i * G + c; if (L >= nwg) return false;
        int wgid = (int)L; { const int q = nwg / NXCD, r = nwg % NXCD, xcd = wgid % NXCD, off = wgid / NXCD; wgid = (xcd < r ? xcd * (q + 1) : r * (q + 1) + (xcd - r) * q) + off; }
        const int nig = WGM * nN, gid = wgid / nig, fm = gid * WGM, gsz = (nM - fm) < WGM ? (nM - fm) : WGM;
        u.pm = fm + ((wgid % nig) % gsz); u.pn = (wgid % nig) / gsz; return true;
    }
    __device__ __forceinline__ void a_ready(const Unit&) const {}
    __device__ __forceinline__ void done(const Unit&) const {}
};

__device__ __forceinline__ unsigned cvt_pk_bf16(float lo, float hi) { unsigned r; asm volatile("v_cvt_pk_bf16_f32 %0, %1, %2" : "=v"(r) : "v"(lo), "v"(hi)); return r; }
typedef float f32x2 __attribute__((ext_vector_type(2)));
typedef unsigned long long ss_t;
constexpr float SS_SCALE = 1048576.0f;
__device__ __forceinline__ float rstd_of(const ss_t* ss, int row) { return __builtin_amdgcn_rsqf((float)ss[row] * (1.0f / (1024.0f * SS_SCALE)) + 1e-6f); }
__device__ __forceinline__ void st16_wt(void* p, u32x4 v) { asm volatile("global_store_dwordx4 %0, %1, off sc1\n\ts_nop 1" : : "v"(p), "v"(v) : "memory"); }
template <bool LDSTAB> struct RsTable {
    PG8_LAS float* tab; const ss_t* ss;
    __device__ __forceinline__ void fill(int pm, int wr, int lane) const {
        const float a = rstd_of(ss, pm * BM + wr * 64 + lane), b = rstd_of(ss, pm * BM + HALF + wr * 64 + lane);
        tab[lane] = a; tab[64 + lane] = b;
        asm volatile("s_waitcnt lgkmcnt(0)" ::: "memory");
    }
    __device__ __forceinline__ void get(float (&rsv)[2][4], int pm, int wr, int fr, int fq) const {
#pragma unroll
        for (int ai = 0; ai < 2; ++ai)
#pragma unroll
            for (int m = 0; m < 4; ++m) rsv[ai][m] = LDSTAB ? tab[ai * 64 + m * 16 + fr] : rstd_of(ss, pm * BM + ai * HALF + wr * 64 + m * 16 + fr);
    }
};
template <bool LDSTAB> struct EpiScale {
    static constexpr bool PERM = true, AFTER_DRAIN = false;
    bf16_t* O; int ldc; RsTable<LDSTAB> rt;
    __device__ __forceinline__ void operator()(const f32x4 (&acc)[2][2][4][2], const Unit& u, int wr, int wc, int fr, int fq) const {
        const int row0 = u.pm * BM + wr * 64 + fr, col0 = u.pn * BM + wc * 32 + 8 * fq;
        float rsv[2][4]; rt.get(rsv, u.pm, wr, fr, fq);
#pragma unroll
        for (int ai = 0; ai < 2; ++ai)
#pragma unroll
            for (int m = 0; m < 4; ++m) { const int row = row0 + ai * HALF + m * 16; const float rs = rsv[ai][m]; bf16_t* rowp = O + (size_t)row * ldc + col0;
#pragma unroll
                for (int bj = 0; bj < 2; ++bj) { const f32x4 v0 = acc[ai][bj][m][0] * rs, v1 = acc[ai][bj][m][1] * rs;
                    u32x4 w; w.x = cvt_pk_bf16(v0[0], v0[1]); w.y = cvt_pk_bf16(v0[2], v0[3]); w.z = cvt_pk_bf16(v1[0], v1[1]); w.w = cvt_pk_bf16(v1[2], v1[3]);
                    st16_wt(rowp + bj * HALF, w); }
                asm volatile("" ::: "memory"); }
    }
};
__device__ __forceinline__ float silu_mul(float g, float u) { const float e = __builtin_amdgcn_exp2f(g * -1.4426950408889634f); return g * u * __builtin_amdgcn_rcpf(1.0f + e); }
template <bool LDSTAB> struct EpiSwiglu {
    static constexpr bool PERM = true, AFTER_DRAIN = false;
    bf16_t* H; int ldh; RsTable<LDSTAB> rt;
    __device__ __forceinline__ void operator()(const f32x4 (&acc)[2][2][4][2], const Unit& u, int wr, int wc, int fr, int fq) const {
        const int row0 = u.pm * BM + wr * 64 + fr, col0 = u.pn * HALF + wc * 32 + 8 * fq;
        float rsv[2][4]; rt.get(rsv, u.pm, wr, fr, fq);
#pragma unroll
        for (int ai = 0; ai < 2; ++ai)
#pragma unroll
            for (int m = 0; m < 4; ++m) { const int row = row0 + ai * HALF + m * 16; const float rs = rsv[ai][m];
                const f32x4 g0 = acc[ai][0][m][0] * rs, g1 = acc[ai][0][m][1] * rs, u0 = acc[ai][1][m][0] * rs, u1 = acc[ai][1][m][1] * rs;
                u32x4 w; w.x = cvt_pk_bf16(silu_mul(g0[0], u0[0]), silu_mul(g0[1], u0[1])); w.y = cvt_pk_bf16(silu_mul(g0[2], u0[2]), silu_mul(g0[3], u0[3]));
                w.z = cvt_pk_bf16(silu_mul(g1[0], u1[0]), silu_mul(g1[1], u1[1])); w.w = cvt_pk_bf16(silu_mul(g1[2], u1[2]), silu_mul(g1[3], u1[3]));
                st16_wt(H + (size_t)row * ldh + col0, w); asm volatile("" ::: "memory"); }
    }
};
__device__ __forceinline__ float bfl(unsigned u) { return __builtin_bit_cast(float, u << 16); }
__device__ __forceinline__ float bfh(unsigned u) { return __builtin_bit_cast(float, u & 0xffff0000u); }
struct EpiResid {
    static constexpr bool PERM = true, AFTER_DRAIN = false;
    bf16_t* XB; ss_t* ssn; float alpha;
    PG8_LAS ss_t* qtab;
    __device__ __forceinline__ void operator()(const f32x4 (&acc)[2][2][4][2], const Unit& u, int wr, int wc, int fr, int fq) const {
        const int row0 = u.pm * BM + wr * 64 + fr, col0 = u.pn * BM + wc * 32 + 8 * fq;
        u32x4 xv[2][4][2];
#pragma unroll
        for (int ai = 0; ai < 2; ++ai)
#pragma unroll
            for (int m = 0; m < 4; ++m) { const bf16_t* bp = XB + (size_t)(row0 + ai * HALF + m * 16) * 1024 + col0; xv[ai][m][0] = *(const u32x4*)bp; xv[ai][m][1] = *(const u32x4*)(bp + HALF); }
#pragma unroll
        for (int ai = 0; ai < 2; ++ai)
#pragma unroll
            for (int m = 0; m < 4; ++m) { const int row = row0 + ai * HALF + m * 16; bf16_t* bp = XB + (size_t)row * 1024 + col0; float q = 0.f;
#pragma unroll
                for (int bj = 0; bj < 2; ++bj) { const u32x4 x = xv[ai][m][bj]; const f32x4 a0 = acc[ai][bj][m][0] * alpha, a1 = acc[ai][bj][m][1] * alpha;
                    const float y0 = bfl(x.x) + a0[0], y1 = bfh(x.x) + a0[1], y2 = bfl(x.y) + a0[2], y3 = bfh(x.y) + a0[3], y4 = bfl(x.z) + a1[0], y5 = bfh(x.z) + a1[1], y6 = bfl(x.w) + a1[2], y7 = bfh(x.w) + a1[3];
                    u32x4 w; w.x = cvt_pk_bf16(y0, y1); w.y = cvt_pk_bf16(y2, y3); w.z = cvt_pk_bf16(y4, y5); w.w = cvt_pk_bf16(y6, y7);
                    st16_wt(bp + bj * HALF, w);
                    q += (y0 * y0 + y1 * y1) + (y2 * y2 + y3 * y3) + (y4 * y4 + y5 * y5) + (y6 * y6 + y7 * y7); }
                q += __shfl_xor(q, 16); q += __shfl_xor(q, 32);
                if (fq == 0) { const ss_t qv = (ss_t)(q * SS_SCALE);
                    if (qtab) qtab[(ai * HALF + wr * 64 + m * 16 + fr) * 4 + wc] = qv; else __hip_atomic_fetch_add(ssn + row, qv, __ATOMIC_RELAXED, __HIP_MEMORY_SCOPE_AGENT); } }
    }
};
template <class Epi, class Sched, bool ALIGN_EPI = false, bool SP2 = false>
__device__ __forceinline__ void gemm_phase(PG8_LAS unsigned char* lds, const Gemm g, const Sched& S, const Epi& E, int wave_s) {
    asm volatile("" : "+s"(wave_s)); int ln_ = (int)__builtin_amdgcn_mbcnt_hi(~0u, __builtin_amdgcn_mbcnt_lo(~0u, 0u)); asm volatile("" : "+v"(ln_)); const int tid = wave_s * 64 + ln_; const int wid = wave_s, lane = tid & 63, wr = wid >> 2, wc = wid & 3, fr = lane & 15, fq = lane >> 4;
    const int K = g.K, nt = K / BK, LDA = g.lda ? g.lda : K;
    unsigned voffA[2], voffB[2];
#pragma unroll
    for (int i = 0; i < 2; ++i) { int R, C; stage_rc(tid * 16 + i * 8192, R, C); const int Rb = Epi::PERM ? ((R & ~31) + perm32(R & 31)) : R;
        voffA[i] = (unsigned)(R * LDA + C) * 2u; voffB[i] = (unsigned)(Rb * K + C) * 2u; }
    const size_t kstep = (size_t)(BK * 2);
    const size_t hstep = (size_t)HALF * K * 2;
    const size_t tstep = 2 * hstep;
    const size_t hstepA = (size_t)HALF * LDA * 2, tstepA = 2 * hstepA;
    const unsigned ldsw = (unsigned)wid * 1024u;
    const int aoff = lds_byte(wr * 64 + fr, fq * 8), boff = lds_byte(wc * 32 + fr, fq * 8);
#define PG8_SA(b, h) (((b) * 2 + (h)) * HTB)
#define PG8_SB(b, h) ((4 + (b) * 2 + (h)) * HTB)
#define PG8_STAGE(bufoff, gbase, voff) do { _Pragma("unroll") for (int _i = 0; _i < 2; ++_i) \
        __builtin_amdgcn_global_load_lds((const unsigned*)((const char*)(gbase) + (voff)[_i]), (PG8_LAS unsigned*)(lds + (bufoff) + ldsw + _i * 8192), 16, 0, 0); } while (0)
#define PG8_LDA(dst, b, h) do { _Pragma("unroll") for (int m = 0; m < 4; ++m) _Pragma("unroll") for (int k = 0; k < 2; ++k) dst[m][k] = *(const PG8_LAS bf16x8*)(lds + PG8_SA(b, h) + aoff + m * 2048 + k * 1024); } while (0)
#define PG8_LDB(dst, b, h) do { _Pragma("unroll") for (int n = 0; n < 2; ++n) _Pragma("unroll") for (int k = 0; k < 2; ++k) dst[n][k] = *(const PG8_LAS bf16x8*)(lds + PG8_SB(b, h) + boff + n * 2048 + k * 1024); } while (0)
#define PG8_MMA(ai, bj, At, Bt) do { __builtin_amdgcn_s_setprio(1); _Pragma("unroll") for (int m = 0; m < 4; ++m) _Pragma("unroll") for (int n = 0; n < 2; ++n) _Pragma("unroll") for (int k = 0; k < 2; ++k) \
        acc[ai][bj][m][n] = __builtin_amdgcn_mfma_f32_16x16x32_bf16(Bt[n][k], At[m][k], acc[ai][bj][m][n], 0, 0, 0); __builtin_amdgcn_s_setprio(0); } while (0)
#define PG8_WAIT_V(n) asm volatile("s_waitcnt vmcnt(" #n ")" ::: "memory")
#define PG8_WAIT_L(n) asm volatile("s_waitcnt lgkmcnt(" #n ")" ::: "memory")
#define PG8_BAR __builtin_amdgcn_s_barrier()
#define PG8_SCHED __builtin_amdgcn_sched_barrier(0)
    Unit cur, nxt; int ui = 0;
    if (!S.next(0, cur)) return;
    f32x4 acc[2][2][4][2];
#pragma unroll
    for (int a = 0; a < 2; ++a)
#pragma unroll
        for (int b = 0; b < 2; ++b)
#pragma unroll
            for (int m = 0; m < 4; ++m)
#pragma unroll
                for (int n = 0; n < 2; ++n) acc[a][b][m][n] = (f32x4){0.f, 0.f, 0.f, 0.f};
    bf16x8 At[4][2], B0[2][2], B1[2][2];
    const char* cA = (const char*)g.A + (size_t)cur.pm * tstepA; const char* cB = (const char*)g.Bt + (size_t)cur.pn * tstep;
    S.a_ready(cur);
    if constexpr (SP2) {
        PG8_STAGE(PG8_SB(0, 0), cB, voffB); PG8_STAGE(PG8_SB(0, 1), cB + hstep, voffB); PG8_STAGE(PG8_SA(0, 0), cA, voffA); PG8_STAGE(PG8_SA(0, 1), cA + hstepA, voffA);
        if (wr == 1) PG8_BAR;
        PG8_WAIT_V(2); PG8_BAR;
        PG8_STAGE(PG8_SB(1, 0), cB + kstep, voffB); PG8_STAGE(PG8_SA(1, 0), cA + kstep, voffA); PG8_STAGE(PG8_SB(1, 1), cB + hstep + kstep, voffB);
        PG8_WAIT_V(6); PG8_BAR;
    } else {
        PG8_STAGE(PG8_SB(0, 0), cB, voffB); PG8_STAGE(PG8_SA(0, 0), cA, voffA); PG8_STAGE(PG8_SB(0, 1), cB + hstep, voffB); PG8_STAGE(PG8_SA(0, 1), cA + hstepA, voffA);
        if (wr == 1) PG8_BAR;
        PG8_WAIT_V(4); PG8_BAR;
        PG8_STAGE(PG8_SB(1, 0), cB + kstep, voffB); PG8_STAGE(PG8_SA(1, 0), cA + kstep, voffA); PG8_STAGE(PG8_SB(1, 1), cB + hstep + kstep, voffB);
        PG8_WAIT_V(6); PG8_BAR;
    }
    for (;;) {
        const bool has_next = S.next(ui + 1, nxt);
        const char* nA = has_next ? (const char*)g.A + (size_t)nxt.pm * tstepA : cA; const char* nB = has_next ? (const char*)g.Bt + (size_t)nxt.pn * tstep : cB;
        for (int t = 0; t < nt; t += 2) {
            const bool last = (t == nt - 2);
            const char* a1 = cA + (size_t)(t + 1) * kstep;
            const char* a2 = last ? nA : cA + (size_t)(t + 2) * kstep; const char* b2 = last ? nB : cB + (size_t)(t + 2) * kstep;
            const char* a3 = a2 + kstep; const char* b3 = b2 + kstep;
            if (last && has_next) S.a_ready(nxt);
            if constexpr (SP2) {
            PG8_LDB(B0, 0, 0); PG8_LDB(B1, 0, 1); PG8_SCHED; PG8_LDA(At, 0, 0); PG8_STAGE(PG8_SA(1, 1), a1 + hstepA, voffA);
            PG8_WAIT_V(8); PG8_WAIT_L(0); PG8_BAR; PG8_MMA(0, 0, At, B0); PG8_MMA(0, 1, At, B1); PG8_BAR; PG8_SCHED;
            PG8_LDA(At, 0, 1); PG8_STAGE(PG8_SB(0, 0), b2, voffB); PG8_STAGE(PG8_SB(0, 1), b2 + hstep, voffB); PG8_STAGE(PG8_SA(0, 0), a2, voffA);
            PG8_WAIT_V(8); PG8_WAIT_L(0); PG8_BAR; PG8_MMA(1, 0, At, B0); PG8_MMA(1, 1, At, B1); PG8_BAR; PG8_SCHED;
            PG8_LDB(B0, 1, 0); PG8_LDB(B1, 1, 1); PG8_SCHED; PG8_LDA(At, 1, 0); PG8_STAGE(PG8_SA(0, 1), a2 + hstepA, voffA);
            PG8_WAIT_V(8); PG8_WAIT_L(0); PG8_BAR; PG8_MMA(0, 0, At, B0); PG8_MMA(0, 1, At, B1); PG8_BAR; PG8_SCHED;
            PG8_LDA(At, 1, 1); PG8_STAGE(PG8_SB(1, 0), b3, voffB); PG8_STAGE(PG8_SB(1, 1), b3 + hstep, voffB); PG8_STAGE(PG8_SA(1, 0), a3, voffA);
            PG8_WAIT_V(8); PG8_WAIT_L(0); PG8_BAR; PG8_MMA(1, 0, At, B0); PG8_MMA(1, 1, At, B1); PG8_BAR; PG8_SCHED;
            } else {
            PG8_LDB(B0, 0, 0); PG8_SCHED; PG8_LDA(At, 0, 0); PG8_STAGE(PG8_SA(1, 1), a1 + hstepA, voffA);
            PG8_WAIT_L(8); PG8_BAR; PG8_WAIT_L(0); PG8_MMA(0, 0, At, B0); PG8_BAR; PG8_SCHED;
            PG8_LDB(B1, 0, 1); PG8_STAGE(PG8_SB(0, 0), b2, voffB);
            PG8_BAR; PG8_WAIT_L(0); PG8_MMA(0, 1, At, B1); PG8_BAR;
            PG8_LDA(At, 0, 1); PG8_STAGE(PG8_SA(0, 0), a2, voffA);
            PG8_BAR; PG8_WAIT_L(0); PG8_MMA(1, 0, At, B0); PG8_BAR; PG8_SCHED;
            PG8_STAGE(PG8_SB(0, 1), b2 + hstep, voffB);
            PG8_WAIT_V(6); PG8_BAR; PG8_MMA(1, 1, At, B1); PG8_BAR;
            PG8_LDB(B0, 1, 0); PG8_SCHED; PG8_LDA(At, 1, 0); PG8_STAGE(PG8_SA(0, 1), a2 + hstepA, voffA);
            PG8_WAIT_L(8); PG8_BAR; PG8_WAIT_L(0); PG8_MMA(0, 0, At, B0); PG8_BAR; PG8_SCHED;
            PG8_LDB(B1, 1, 1); PG8_STAGE(PG8_SB(1, 0), b3, voffB);
            PG8_BAR; PG8_WAIT_L(0); PG8_MMA(0, 1, At, B1); PG8_BAR;
            PG8_LDA(At, 1, 1); PG8_STAGE(PG8_SA(1, 0), a3, voffA);
            PG8_BAR; PG8_WAIT_L(0); PG8_MMA(1, 0, At, B0); PG8_BAR; PG8_SCHED;
            PG8_STAGE(PG8_SB(1, 1), b3 + hstep, voffB);
            PG8_WAIT_V(6); PG8_BAR; PG8_MMA(1, 1, At, B1); PG8_BAR;
            }
        }
        if constexpr (ALIGN_EPI) { if (wr == 0) PG8_BAR; }
        if constexpr (!Epi::AFTER_DRAIN) { E(acc, cur, wr, wc, fr, fq); S.done(cur); }
        if (!has_next) break;
#pragma unroll
        for (int a = 0; a < 2; ++a)
#pragma unroll
            for (int b = 0; b < 2; ++b)
#pragma unroll
                for (int m = 0; m < 4; ++m)
#pragma unroll
                    for (int n = 0; n < 2; ++n) acc[a][b][m][n] = (f32x4){0.f, 0.f, 0.f, 0.f};
        cur = nxt; cA = nA; cB = nB; ++ui;
        if constexpr (ALIGN_EPI) { if (wr == 1) PG8_BAR; }
    }
    PG8_WAIT_V(0);
    if constexpr (!ALIGN_EPI) { if (wr == 0) PG8_BAR; }
    PG8_BAR;
    if constexpr (Epi::AFTER_DRAIN) { E.fused(acc, cur, wr, wc, fr, fq, lds, wid, lane); S.done(cur); }
#undef PG8_SA
#undef PG8_SB
#undef PG8_STAGE
#undef PG8_LDA
#undef PG8_LDB
#undef PG8_MMA
#undef PG8_WAIT_V
#undef PG8_WAIT_L
#undef PG8_BAR
#undef PG8_SCHED
}
}

#ifndef MK_N_LAUNCHES
#define MK_N_LAUNCHES 1
#endif
constexpr int NWAVES = 8;
constexpr int BATCH = 2, SEQ = 8192, D = 1024, FF = 2816, M = BATCH * SEQ, DEPTH = 4;
constexpr int NIN_CONV = 2560, NQKV = 3072, NHEAD = 16;
constexpr int ZPITCH = 3072;
constexpr size_t MiB = 1u << 20;
constexpr size_t WS_CTL = 0, CTL_ZERO_BYTES = 2 * MiB;
constexpr size_t WS_SS = 64 * 1024;
constexpr size_t WS_LSE = 2 * MiB;
constexpr size_t WS_W = 8 * MiB, W_STRIDE = 44 * MiB;
constexpr size_t WS_XB = 96 * MiB;
constexpr size_t WS_ACT = 128 * MiB;
constexpr size_t WS_OG = 224 * MiB;
constexpr size_t WS_MG = 320 * MiB;
constexpr size_t WS_END = 352 * MiB;
constexpr size_t OW_GU1 = 0, OW_D1 = OW_GU1 + (size_t)2 * FF * D, OW_MI = OW_D1 + (size_t)D * FF, OW_MO = OW_MI + (size_t)NQKV * D, OW_GU2 = OW_MO + (size_t)D * D, OW_D2 = OW_GU2 + (size_t)2 * FF * D, OW_END = OW_D2 + (size_t)D * FF;
static_assert(OW_END * 2 <= W_STRIDE, "weight buffer");
constexpr int LDS_BYTES = 147456;
constexpr int CW_BAR = 4096;
constexpr int MISC_OFF = 131072 + 320;
constexpr int QTAB_OFF = 131072 + 8192;
constexpr int RST_OFF = 131072 + 4096;

#define LAS __attribute__((address_space(3)))
typedef unsigned short bf16;
typedef unsigned v4u __attribute__((ext_vector_type(4)));
typedef unsigned v2u __attribute__((ext_vector_type(2)));
typedef float f32x4 __attribute__((ext_vector_type(4)));
typedef short bf16x8 __attribute__((ext_vector_type(8)));
typedef short s16x4 __attribute__((ext_vector_type(4)));
#define LDS_WAIT() asm volatile("s_waitcnt lgkmcnt(0)" ::: "memory")
__device__ __forceinline__ unsigned pk2(float lo, float hi) { return pg8::cvt_pk_bf16(lo, hi); }
__device__ __forceinline__ int opq(int x) { asm volatile("" : "+v"(x)); return x; }
__device__ __forceinline__ int opqs(int x) { asm volatile("" : "+s"(x)); return x; }
__device__ __forceinline__ int tid_of(int wave_s) { asm volatile("" : "+s"(wave_s)); int l = (int)__builtin_amdgcn_mbcnt_hi(~0u, __builtin_amdgcn_mbcnt_lo(~0u, 0u)); asm volatile("" : "+v"(l)); return wave_s * 64 + l; }
__device__ __forceinline__ float bf_lo(unsigned u) { return __uint_as_float(u << 16); }
__device__ __forceinline__ float bf_hi(unsigned u) { return __uint_as_float(u & 0xffff0000u); }
__device__ __forceinline__ float wave_sum(float v) {
#pragma unroll
    for (int o = 1; o < 64; o <<= 1) v += __shfl_xor(v, o);
    return v;
}
__device__ __forceinline__ float dpp_f(float x, float old) { return x; }
#define DPP_ADD(x, ctrl, rmask) x += __builtin_bit_cast(float, __builtin_amdgcn_update_dpp(0, __builtin_bit_cast(int, x), ctrl, rmask, 0xF, false))
__device__ __forceinline__ float wave_sum_hi(float x) {
    DPP_ADD(x, 0xB1, 0xF);
    DPP_ADD(x, 0x4E, 0xF);
    DPP_ADD(x, 0x141, 0xF);
    DPP_ADD(x, 0x140, 0xF);
    DPP_ADD(x, 0x142, 0xA);
    DPP_ADD(x, 0x143, 0xC);
    return x;
}

__device__ __forceinline__ void cvt_item(const float* __restrict__ W, int K, int N, bf16* WT, int dst_row0, int k0, int n0, const float* __restrict__ g, float cs, LAS float* scr, int lane) {
    float wv[32];
#pragma unroll
    for (int i = 0; i < 32; ++i) { const int kk = 2 * i + (lane >> 5); wv[i] = __builtin_nontemporal_load(&W[(size_t)(k0 + kk) * N + n0 + (lane & 31)]); }
#pragma unroll
    for (int i = 0; i < 32; ++i) { const int kk = 2 * i + (lane >> 5); const float gk = g ? g[k0 + kk] * cs : cs; scr[kk * 33 + (lane & 31)] = wv[i] * gk; }
    LDS_WAIT(); asm volatile("" ::: "memory");
    const int c = lane & 7;
#pragma unroll
    for (int j = 0; j < 4; ++j) { const int n = (lane >> 3) + 8 * j; const LAS float* s = scr + (8 * c) * 33 + n;
        v4u o; o.x = pk2(s[0 * 33], s[1 * 33]); o.y = pk2(s[2 * 33], s[3 * 33]); o.z = pk2(s[4 * 33], s[5 * 33]); o.w = pk2(s[6 * 33], s[7 * 33]);
        asm volatile("global_store_dwordx4 %0, %1, off sc1\n\ts_nop 1" : : "v"(WT + (size_t)(dst_row0 + n) * K + k0 + 8 * c), "v"(o) : "memory"); }
    LDS_WAIT(); asm volatile("" ::: "memory");
}
struct LayerW { const float *gu1, *d1, *mi, *mo, *gu2, *d2, *g1, *gm, *g2; int even; };
__device__ __forceinline__ void convert_layer(const LayerW& w, bf16* WB, int part, LAS unsigned char* lds, int gw, int NGW, int wave, int lane) {
    LAS float* scr = (LAS float*)(lds + wave * 16384);
    const int nmi = w.even ? NIN_CONV : NQKV;
    const int I_GU = (D / 64) * (2 * FF / 32), I_D = (FF / 64) * (D / 32), I_MI = (D / 64) * (nmi / 32), I_MO = (D / 64) * (D / 32);
    const int NITEMS = part == 0 ? I_GU + I_D : I_GU + I_D + I_MI + I_MO;
    for (int it = gw; it < NITEMS; it += NGW) {
        int r = it;
        if (r < I_GU) { const int nblk = 2 * FF / 32, kb = r / nblk, nb = r % nblk, n0 = nb * 32;
            const int j0 = n0 < FF ? n0 : n0 - FF; const int dst = (j0 >> 7) * 256 + (n0 < FF ? 0 : 128) + (j0 & 127);
            cvt_item(part ? w.gu2 : w.gu1, D, 2 * FF, WB + (part ? OW_GU2 : OW_GU1), dst, kb * 64, n0, part ? w.g2 : w.g1, 1.0f, scr, lane); continue; }
        r -= I_GU;
        if (r < I_D) { const int nblk = D / 32, kb = r / nblk, nb = r % nblk;
            cvt_item(part ? w.d2 : w.d1, FF, D, WB + (part ? OW_D2 : OW_D1), nb * 32, kb * 64, nb * 32, nullptr, 1.0f, scr, lane); continue; }
        r -= I_D;
        if (r < I_MI) { const int nblk = nmi / 32, kb = r / nblk, nb = r % nblk, n0 = nb * 32;
            const float cs = (!w.even && n0 < D) ? 0.125f * 1.4426950408889634f : 1.0f;
            cvt_item(w.mi, D, nmi, WB + OW_MI, n0, kb * 64, n0, w.gm, cs, scr, lane); continue; }
        r -= I_MI;
        { const int nblk = D / 32, kb = r / nblk, nb = r % nblk; cvt_item(w.mo, D, D, WB + OW_MO, nb * 32, kb * 64, nb * 32, nullptr, 1.0f, scr, lane); }
    }
}

constexpr int KP = 144;
constexpr int ATT_K = 0, ATT_V = 272 * KP;
__device__ __forceinline__ void attn_phase(LAS unsigned char* lds, const bf16* __restrict__ QKV, bf16* OG, float* LSE, int G, int vcu, int wave_s) {
    G = opqs(G); vcu = opqs(vcu);
    const int tid = tid_of(wave_s), lane = tid & 63, wid = __builtin_amdgcn_readfirstlane(tid >> 6), fr = lane & 15, fq = lane >> 4;
    const unsigned z1 = (unsigned)opq(0); const v4u zero4 = (v4u){z1, z1, z1, z1};
    for (int i = tid; i < 2 * 272 * KP / 16; i += 512) *(LAS v4u*)(lds + i * 16) = zero4;
    f32x4 relf[9];
#pragma unroll
    for (int j = 0; j < 9; ++j)
#pragma unroll
        for (int r = 0; r < 4; ++r) { const int rel = 128 + fr - 16 * j - 4 * fq - r; relf[j][r] = (rel >= 0 && rel <= 128) ? (float)rel : 1e30f; }
    const int total = 3 * BATCH * NHEAD * 64;
    const int per = (total + G - 1) / G, u_beg = vcu * per, u_end = (u_beg + per < total) ? u_beg + per : total;
    v4u kreg[2], vreg[2];
#define ATT_DECODE(u) const int g_ = (u) >> 11, rem_ = (u) & 2047, b_ = rem_ >> 10, h_ = (rem_ >> 6) & 15, rb_ = rem_ & 63, sh_ = 2 * g_, nl_ = 6 - sh_, r_ = rb_ >> nl_, n_ = rb_ & ((1 << nl_) - 1)
#define ATT_PREFETCH(u, nb) do { ATT_DECODE(u); _Pragma("unroll") for (int i = 0; i < 2; ++i) { const int idx = tid + 512 * i, k = idx >> 3, ch = idx & 7; const int j = 128 * (n_ + (nb)) + k; \
        const bf16* src = QKV + ((size_t)(b_ * SEQ + (j << sh_) + r_)) * NQKV + D + h_ * 64 + ch * 8; kreg[i] = *(const v4u*)src; vreg[i] = *(const v4u*)(src + D); } } while (0)
#define ATT_STORE(slot) do { _Pragma("unroll") for (int i = 0; i < 2; ++i) { const int idx = tid + 512 * i, k = idx >> 3, ch = idx & 7; \
        *(LAS v4u*)(lds + ATT_K + ((slot) * 128 + k) * KP + ch * 16) = kreg[i]; *(LAS v4u*)(lds + ATT_V + ((slot) * 128 + k) * KP + ch * 16) = vreg[i]; } } while (0)
    bf16x8 qn0 = (bf16x8){0, 0, 0, 0, 0, 0, 0, 0}, qn1 = qn0;
#define ATT_QLOAD(u) do { ATT_DECODE(u); const bf16* qp_ = QKV + ((size_t)(b_ * SEQ + ((128 * n_ + 16 * wid + fr) << sh_) + r_)) * NQKV + h_ * 64 + fq * 8; qn0 = *(const bf16x8*)qp_; qn1 = *(const bf16x8*)(qp_ + 32); } while (0)
    int p = 0;
    __syncthreads();
    if (u_beg < u_end) { { ATT_DECODE(u_beg); if (n_ > 0) { ATT_PREFETCH(u_beg, -1); ATT_STORE(0); } }
        ATT_PREFETCH(u_beg, 0); ATT_QLOAD(u_beg); }
    for (int u = u_beg; u < u_end; ++u) {
        __syncthreads();
        ATT_STORE(1 - p);
        __syncthreads();
        ATT_DECODE(u);
        const int dil = 1 << sh_;
        const size_t qrow = (size_t)(b_ * SEQ + ((128 * n_ + 16 * wid + fr) << sh_) + r_);
        const bf16x8 qf0 = qn0, qf1 = qn1;
        if (u + 1 < u_end) { ATT_PREFETCH(u + 1, 0); ATT_QLOAD(u + 1); }
        const float ncb = -__builtin_amdgcn_exp2f(-0.5f * (float)(h_ + 1)) * (float)dil * 1.4426950408889634f;
        f32x4 s[9];
#define ATT_ROWB(T) ((T) < 8 ? p * 128 + 16 * (T) : ((T) < 16 ? (1 - p) * 128 + 16 * ((T) - 8) : 256))
        const LAS unsigned char* kb = lds + ATT_K + fr * KP + fq * 16;
        float mx = -3.0e38f;
#pragma unroll
        for (int j = 0; j < 9; ++j) { const int rbk = ATT_ROWB(wid + j); const bf16x8 k0 = *(const LAS bf16x8*)(kb + rbk * KP), k1 = *(const LAS bf16x8*)(kb + rbk * KP + 64);
            f32x4 a = relf[j] * ncb;
            a = __builtin_amdgcn_mfma_f32_16x16x32_bf16(k0, qf0, a, 0, 0, 0); a = __builtin_amdgcn_mfma_f32_16x16x32_bf16(k1, qf1, a, 0, 0, 0);
            if (n_ == 0 && wid + j < 8) a = (f32x4){-1e30f, -1e30f, -1e30f, -1e30f};
            s[j] = a; mx = fmaxf(fmaxf(mx, fmaxf(a[0], a[1])), fmaxf(a[2], a[3])); }
        mx = fmaxf(mx, __shfl_xor(mx, 16)); mx = fmaxf(mx, __shfl_xor(mx, 32));
        float l = 0.f;
#pragma unroll
        for (int j = 0; j < 9; ++j)
#pragma unroll
            for (int r = 0; r < 4; ++r) { const float p = __builtin_amdgcn_exp2f(s[j][r] - mx); s[j][r] = p; l += p; }
        l += __shfl_xor(l, 16); l += __shfl_xor(l, 32);
        f32x4 o[4];
#pragma unroll
        for (int dt = 0; dt < 4; ++dt) o[dt] = (f32x4){0.f, 0.f, 0.f, 0.f};
        const LAS unsigned char* vb = lds + ATT_V + (4 * fq + (fr >> 2)) * KP + (fr & 3) * 8;
#pragma unroll
        for (int gk = 0; gk < 5; ++gk) {
            v4u pw; pw.x = pk2(s[2 * gk][0], s[2 * gk][1]); pw.y = pk2(s[2 * gk][2], s[2 * gk][3]);
            if (gk < 4) { pw.z = pk2(s[(2 * gk + 1) % 9][0], s[(2 * gk + 1) % 9][1]); pw.w = pk2(s[(2 * gk + 1) % 9][2], s[(2 * gk + 1) % 9][3]); } else { pw.z = 0u; pw.w = 0u; }
            const bf16x8 pb = __builtin_bit_cast(bf16x8, pw);
            const int rv0 = ATT_ROWB(wid + 2 * gk), rv1 = ATT_ROWB(wid + 2 * gk + 1);
#pragma unroll
            for (int dt = 0; dt < 4; ++dt) {
                const s16x4 lo = __builtin_bit_cast(s16x4, __builtin_amdgcn_ds_read_tr16_b64_v4i16((LAS s16x4*)(vb + rv0 * KP + dt * 32)));
                const s16x4 hi = __builtin_bit_cast(s16x4, __builtin_amdgcn_ds_read_tr16_b64_v4i16((LAS s16x4*)(vb + rv1 * KP + dt * 32)));
                const bf16x8 vf = (bf16x8){lo[0], lo[1], lo[2], lo[3], hi[0], hi[1], hi[2], hi[3]};
                o[dt] = __builtin_amdgcn_mfma_f32_16x16x32_bf16(vf, pb, o[dt], 0, 0, 0);
            }
        }
        const float il = __builtin_amdgcn_rcpf(l);
        bf16* op = OG + (size_t)g_ * M * D + qrow * D + h_ * 64 + 4 * fq;
#pragma unroll
        for (int dt = 0; dt < 4; ++dt) { v2u w; w.x = pk2(o[dt][0] * il, o[dt][1] * il); w.y = pk2(o[dt][2] * il, o[dt][3] * il); *(v2u*)(op + dt * 16) = w; }
        if (fq == 0) LSE[(size_t)g_ * M * NHEAD + qrow * NHEAD + h_] = mx + __builtin_amdgcn_logf(l);
        p ^= 1;
    }
#undef ATT_STORE
#undef ATT_ROWB
#undef ATT_QLOAD
#undef ATT_DECODE
#undef ATT_PREFETCH
}
__device__ __forceinline__ void merge_phase(const bf16* __restrict__ OG, const float* __restrict__ LSE, bf16* MG, int item0_, int total_, int nth_, int wave_s) {
    item0_ = opqs(item0_); total_ = opqs(total_); nth_ = opqs(nth_);
    const int tid = tid_of(wave_s);
    const size_t nth = (size_t)nth_, total = (size_t)total_;
    for (size_t base = (size_t)item0_ + tid; base < total; base += 4 * nth) {
        v4u a[4], b[4], c[4]; float l0[4], l1[4], l2[4];
#pragma unroll
        for (int e = 0; e < 4; ++e) { const size_t idx = base + e * nth; if (idx < total) { const size_t row = idx >> 7; const int cc = (int)(idx & 127), h = cc >> 3;
            l0[e] = LSE[row * NHEAD + h]; l1[e] = LSE[(size_t)M * NHEAD + row * NHEAD + h]; l2[e] = LSE[(size_t)2 * M * NHEAD + row * NHEAD + h];
            a[e] = *(const v4u*)(OG + row * D + cc * 8); b[e] = *(const v4u*)(OG + (size_t)M * D + row * D + cc * 8); c[e] = *(const v4u*)(OG + (size_t)2 * M * D + row * D + cc * 8); } }
#pragma unroll
        for (int e = 0; e < 4; ++e) { const size_t idx = base + e * nth; if (idx < total) { const size_t row = idx >> 7; const int cc = (int)(idx & 127);
            const float mx = fmaxf(l0[e], fmaxf(l1[e], l2[e]));
            float w0 = __builtin_amdgcn_exp2f(l0[e] - mx), w1 = __builtin_amdgcn_exp2f(l1[e] - mx), w2 = __builtin_amdgcn_exp2f(l2[e] - mx);
            const float inv = __builtin_amdgcn_rcpf(w0 + w1 + w2); w0 *= inv; w1 *= inv; w2 *= inv;
            v4u o;
#pragma unroll
            for (int i = 0; i < 4; ++i) o[i] = pk2(w0 * bf_lo(a[e][i]) + w1 * bf_lo(b[e][i]) + w2 * bf_lo(c[e][i]), w0 * bf_hi(a[e][i]) + w1 * bf_hi(b[e][i]) + w2 * bf_hi(c[e][i]));
            asm volatile("global_store_dwordx4 %0, %1, off sc1\n\ts_nop 1" : : "v"(MG + row * D + cc * 8), "v"(o) : "memory"); } }
    }
}

__device__ __forceinline__ float sigmoidf_(float x) { return __builtin_amdgcn_rcpf(1.0f + __builtin_amdgcn_exp2f(x * -1.4426950408889634f)); }
__device__ __forceinline__ void conv_phase(LAS unsigned char* lds, const bf16* __restrict__ Z, bf16* CAT, const float* __restrict__ wa, const float* __restrict__ wb, const float* __restrict__ bias,
                                           const float* __restrict__ lng, const float* __restrict__ lnb, int u0, int ustep, int uend, int wave_s) {
    u0 = opqs(u0); ustep = opqs(ustep); uend = opqs(uend);
    const int tid = tid_of(wave_s), lane = tid & 63, wid = __builtin_amdgcn_readfirstlane(tid >> 6), cp = tid & 255, th = tid >> 8;
    LAS float* red = (LAS float*)(lds + 94 * 1024);
    const unsigned z1 = (unsigned)opq(0); const v4u zero4 = (v4u){z1, z1, z1, z1};
    const bool shared = (ustep == 1 && uend - u0 == 2);
    const int nrows = shared ? 94 : 62, nbatch = shared ? 3 : 2;
    float w0[31], w1[31];
#pragma unroll
    for (int k = 0; k < 31; ++k) { const v2u w = *(const v2u*)(wb + k * 512 + 2 * cp); w0[k] = __uint_as_float(w.x); w1[k] = __uint_as_float(w.y); }
    for (int unit = u0; unit < uend; unit += ustep) {
        const int row0 = unit * 32, s0 = row0 & (SEQ - 1);
        const int lro = shared ? (unit - u0) * 32 : 0;
        __syncthreads();
        if (!shared || unit == u0) {
#pragma unroll 1
        for (int hb = 0; hb < nbatch; ++hb) { v4u bv[4], bg[4];
#pragma unroll
          for (int i = 0; i < 4; ++i) { const int it = tid + 512 * (4 * hb + i), lr = it >> 6, ch = it & 63; bv[i] = zero4; bg[i] = zero4;
              if (it < nrows * 64 && s0 - 30 + lr >= 0) { const bf16* zp = Z + (size_t)(row0 - 30 + lr) * ZPITCH + 1536 + ch * 8; bv[i] = *(const v4u*)zp; bg[i] = *(const v4u*)(zp + 512); } }
#pragma unroll
          for (int i = 0; i < 4; ++i) { const int it = tid + 512 * (4 * hb + i), lr = it >> 6, ch = it & 63; v4u o;
#pragma unroll
              for (int e = 0; e < 4; ++e) o[e] = pk2(bf_lo(bv[i][e]) * sigmoidf_(bf_lo(bg[i][e])), bf_hi(bv[i][e]) * sigmoidf_(bf_hi(bg[i][e])));
              if (it < nrows * 64) *(LAS v4u*)(lds + lr * 1024 + ch * 16) = o; } }
        __syncthreads();
        }
        float acc[16][2];
        { const v2u b = *(const v2u*)(bias + 2 * cp); const float b0 = __uint_as_float(b.x), b1 = __uint_as_float(b.y);
#pragma unroll
          for (int t = 0; t < 16; ++t) { acc[t][0] = b0; acc[t][1] = b1; } }
        const LAS unsigned char* up = lds + (lro + th * 16) * 1024 + cp * 4;
#pragma unroll
        for (int j = 0; j < 46; ++j) { const unsigned uu = *(const LAS unsigned*)(up + j * 1024); const float ul = bf_lo(uu), uh = bf_hi(uu);
#pragma unroll
            for (int t = 0; t < 16; ++t) { const int k = j - t; if (k >= 0 && k < 31) { acc[t][0] += w0[k] * ul; acc[t][1] += w1[k] * uh; } }
            if ((j & 7) == 7) asm volatile("" ::: "memory"); }
#pragma unroll
        for (int t = 0; t < 16; ++t) { const float s1 = wave_sum_hi(acc[t][0] + acc[t][1]), s2 = wave_sum_hi(acc[t][0] * acc[t][0] + acc[t][1] * acc[t][1]);
            if (lane == 63) { red[(wid * 16 + t) * 2] = s1; red[(wid * 16 + t) * 2 + 1] = s2; } }
        __syncthreads();
        { const float g0 = lng[2 * cp], g1 = lng[2 * cp + 1], c0 = lnb[2 * cp], c1 = lnb[2 * cp + 1];
#pragma unroll
          for (int t = 0; t < 16; ++t) { float s1 = 0.f, s2 = 0.f;
#pragma unroll
              for (int w = 0; w < 4; ++w) { s1 += red[((th * 4 + w) * 16 + t) * 2]; s2 += red[((th * 4 + w) * 16 + t) * 2 + 1]; }
              const float mean = s1 * (1.0f / 512.0f), var = fmaxf(s2 * (1.0f / 512.0f) - mean * mean, 0.f), rstd = __builtin_amdgcn_rsqf(var + 1e-5f);
              const float y0 = (acc[t][0] - mean) * rstd * g0 + c0, y1 = (acc[t][1] - mean) * rstd * g1 + c1;
              *(unsigned*)(CAT + (size_t)(row0 + th * 16 + t) * D + 512 + 2 * cp) = pk2(y0 * sigmoidf_(y0), y1 * sigmoidf_(y1)); } }
        { const float a00 = wa[2 * cp], a01 = wa[2 * cp + 1], a10 = wa[512 + 2 * cp], a11 = wa[512 + 2 * cp + 1], a20 = wa[1024 + 2 * cp], a21 = wa[1024 + 2 * cp + 1];
          unsigned zc[18], zx[18], zb[16];
#pragma unroll
          for (int t = -2; t < 16; ++t) { const int s = s0 + th * 16 + t; const bf16* zp = Z + (size_t)(row0 + th * 16 + t) * ZPITCH + 2 * cp; zc[t + 2] = 0u; zx[t + 2] = 0u;
              if (s >= 0) { zc[t + 2] = *(const unsigned*)(zp + 512); zx[t + 2] = *(const unsigned*)(zp + 1024); }
              if (t >= 0) zb[t] = *(const unsigned*)zp; }
          float p2x = 0.f, p2y = 0.f, p1x = 0.f, p1y = 0.f;
#pragma unroll
          for (int t = -2; t < 16; ++t) { const float px = bf_lo(zc[t + 2]) * bf_lo(zx[t + 2]), py = bf_hi(zc[t + 2]) * bf_hi(zx[t + 2]);
              if (t >= 0) { const float y0 = bf_lo(zb[t]) * (a00 * p2x + a10 * p1x + a20 * px), y1 = bf_hi(zb[t]) * (a01 * p2y + a11 * p1y + a21 * py);
                  *(unsigned*)(CAT + (size_t)(row0 + th * 16 + t) * D + 2 * cp) = pk2(y0, y1); }
              p2x = p1x; p2y = p1y; p1x = px; p1y = py; } }
    }
}

typedef __attribute__((address_space(1))) unsigned gu32;
#define XB_TMO      128
#define XB_XCNT(j)  (256  + 64 * (j))
#define XB_XSUB(j)  (1280 + 64 * (j))
#define XB_XGEN(j)  (2304 + 64 * (j))
#define XB_TOP      3328
#define XB_TOPGEN   3392
#define XCD_BAR_WORDS 3456
#define XB_SPIN_CAP (1u << 18)

__device__ __forceinline__ unsigned xb_ld(unsigned* p)              { return __hip_atomic_load(p, __ATOMIC_RELAXED, __HIP_MEMORY_SCOPE_AGENT); }
__device__ __forceinline__ unsigned xb_add(unsigned* p, unsigned v) { return __hip_atomic_fetch_add(p, v, __ATOMIC_RELAXED, __HIP_MEMORY_SCOPE_AGENT); }
__device__ __forceinline__ unsigned xb_xcc_id() { return (unsigned)__builtin_amdgcn_s_getreg((3 << 11) | 20) & 0xFu; }
#define XB_SPIN(cond, bar) do { unsigned _sp = 0; while (cond) { __builtin_amdgcn_s_sleep(1); \
    if ((++_sp & 255u) == 0u) { if (xb_ld(&(bar)[XB_TMO])) break; if (_sp > XB_SPIN_CAP) { atomicAdd(&(bar)[XB_TMO], 1u); break; } } } } while (0)

struct XcdBarrier {
    unsigned* bar; unsigned x; int wv;
    volatile LAS unsigned* st;
};

__device__ __forceinline__ XcdBarrier xcd_barrier_post(unsigned* bar, volatile LAS unsigned* st) {
    XcdBarrier b; b.bar = bar; b.x = xb_xcc_id(); b.st = st; b.wv = 0;
    if (threadIdx.x == 0) (void)xb_add(&bar[XB_XCNT(b.x)], 1u);
    return b;
}
__device__ __forceinline__ void xcd_barrier_complete(unsigned* bar, unsigned x, unsigned& nloc, unsigned& nx) {
    const unsigned G = gridDim.x * gridDim.y * gridDim.z;
    asm volatile("" : "+s"(x));
    unsigned sum, cnt, mine, sp = 0u;
    for (;;) {
        sum = 0u; cnt = 0u; mine = 0u;
#pragma unroll
        for (unsigned j = 0; j < 16; ++j) { const unsigned c = xb_ld(&bar[XB_XCNT(j)]); sum += c; cnt += (c > 0u) ? 1u : 0u; mine = (j == x) ? c : mine; }
        if (sum == G) break;
        __builtin_amdgcn_s_sleep(1);
        if ((++sp & 255u) == 0u) { if (xb_ld(&bar[XB_TMO])) break; if (sp > XB_SPIN_CAP) { atomicAdd(&bar[XB_TMO], 1u); break; } }
    }
    nloc = mine > 0u ? mine : 1u; nx = cnt > 0u ? cnt : 1u;
}

__device__ __forceinline__ void xcd_barrier(const XcdBarrier& b) {
    asm volatile("s_waitcnt vmcnt(0)" ::: "memory");
    __syncthreads();
    if (tid_of(b.wv) == 0) {
        unsigned* bar = b.bar;
        __builtin_amdgcn_s_waitcnt(0);
        unsigned nloc = b.st[0], nx = b.st[1];
        if (nloc == 0u) { xcd_barrier_complete(bar, b.x, nloc, nx); b.st[0] = nloc; b.st[1] = nx; }
        const unsigned old = xb_add(&bar[XB_XSUB(b.x)], 1u);
        const unsigned gen = old / nloc;
        if (old + 1u == (gen + 1u) * nloc) {
            __builtin_amdgcn_fence(__ATOMIC_RELEASE, "agent");
            asm volatile("s_waitcnt vmcnt(0)" ::: "memory");
            const unsigned og = xb_add(&bar[XB_TOP], 1u);
            const unsigned tg = og / nx;
            if (og + 1u == (tg + 1u) * nx) xb_add(&bar[XB_TOPGEN], 1u);
            else XB_SPIN(xb_ld(&bar[XB_TOPGEN]) == tg, bar);
            __builtin_amdgcn_fence(__ATOMIC_ACQUIRE, "agent");
            xb_add(&bar[XB_XGEN(b.x)], 1u);
            asm volatile("s_waitcnt vmcnt(0)" ::: "memory");
        } else {
            XB_SPIN(xb_ld(&bar[XB_XGEN(b.x)]) == gen, bar);
            __builtin_amdgcn_fence(__ATOMIC_ACQUIRE, "agent");
            asm volatile("s_waitcnt vmcnt(0)" ::: "memory");
        }
    }
    __syncthreads();
}

constexpr int CW_CVT = 12288;
constexpr int CW_GRP = 8192;
__device__ __forceinline__ void group_barrier(unsigned* cnt, unsigned target, unsigned* bar, int wave_s, unsigned* cvt = nullptr, unsigned cvt_target = 0u) {
    asm volatile("s_waitcnt vmcnt(0)" ::: "memory");
    __syncthreads();
    if (tid_of(wave_s) == 0) {
        (void)xb_add(cnt, 1u);
        XB_SPIN(xb_ld(cnt) < target, bar);
        if (cvt) XB_SPIN(xb_ld(cvt) < cvt_target, bar);
        __builtin_amdgcn_fence(__ATOMIC_ACQUIRE, "agent");
        asm volatile("s_waitcnt vmcnt(0)" ::: "memory");
    }
    __syncthreads();
}

struct Args { const float* in[18]; float* out; unsigned char* ws; int ph_lo, ph_hi; };
__global__ void __launch_bounds__(NWAVES * 64, 2) mk_fwd(Args args) {
    extern __shared__ __attribute__((aligned(16))) unsigned char lds_raw[];
    LAS unsigned char* lds = (LAS unsigned char*)lds_raw;
    cg::grid_group grid = cg::this_grid();
    const int wave_s = __builtin_amdgcn_readfirstlane(threadIdx.x >> 6);
    for (int u = threadIdx.x; u < (LDS_BYTES - 131072) / 4; u += NWAVES * 64) ((LAS unsigned*)(lds + 131072))[u] = 0u;
    __syncthreads();
#if MK_N_LAUNCHES == 1
    if (args.ph_hi < 0) grid.sync();
#endif
    XcdBarrier xbar = xcd_barrier_post((unsigned*)(args.ws + WS_CTL) + CW_BAR, (volatile LAS unsigned*)(lds + MISC_OFF) + 8); xbar.wv = wave_s;
    const int G = gridDim.x, bx = blockIdx.x, vcu = (G % 8 == 0) ? (bx % 8) * (G / 8) + bx / 8 : bx;
    const int NGW = G * NWAVES;
#define TID_VARS const int tid = tid_of(wave_s), lane = tid & 63, wave = __builtin_amdgcn_readfirstlane(tid >> 6), gw = vcu * NWAVES + wave; (void)gw; (void)lane
    unsigned char* ws = args.ws;
    float* X = args.out;
#define WSQ ({ unsigned char* p_ = ws; asm volatile("" : "+s"(p_)); p_; })
#define SS ((pg8::ss_t*)(WSQ + WS_SS))
#define LSE ((float*)(WSQ + WS_LSE))
#define XB ((bf16*)(WSQ + WS_XB))
#define ACT ((bf16*)(WSQ + WS_ACT))
#define OG ((bf16*)(WSQ + WS_OG))
#define MG ((bf16*)(WSQ + WS_MG))
    const int lo = args.ph_lo, hi = args.ph_hi;
    int ph = 0, ngrp = 0;
#define PANEL_OF(c) (8 * ((c) % 8) + ((c) / 8) % 8)
#define PH_ON (ph >= lo && ph < hi)
#define GRID_BAR() do { asm volatile("s_waitcnt vmcnt(0)" ::: "memory"); grid.sync(); __builtin_amdgcn_fence(__ATOMIC_ACQUIRE, "agent"); asm volatile("s_waitcnt vmcnt(0)" ::: "memory"); } while (0)
#ifdef DUP_BAR
#define PH_END do { if (PH_ON && ph + 1 < hi) { if (ph == 0) GRID_BAR(); else { xcd_barrier(xbar); xcd_barrier(xbar); } } ++ph; } while (0)
#else
#define PH_END do { if (PH_ON && ph + 1 < hi) xcd_barrier(xbar); ++ph; } while (0)
#endif
#if MK_N_LAUNCHES == 1 && !defined(NO_GROUP_BAR)
#define PH_END_GRP do { if (PH_ON && ph + 1 < hi) { if (G == 256) { const int c_ = opqs(bx); group_barrier((unsigned*)(args.ws + WS_CTL) + CW_GRP + 64 * (8 * (c_ % 8) + (c_ / 8) % 8), 4u * (unsigned)(ngrp + 1), (unsigned*)(args.ws + WS_CTL) + CW_BAR, wave_s); ++ngrp; } else xcd_barrier(xbar); } ++ph; } while (0)
#define PH_END_GRPC(job) do { if (PH_ON && ph + 1 < hi) { const int nt_ = ((M / 256) * (2 * FF / 256)) % G; if (G == 256 && nt_ > 0) { const int c_ = opqs(bx); group_barrier((unsigned*)(args.ws + WS_CTL) + CW_GRP + 64 * (8 * (c_ % 8) + (c_ / 8) % 8), 4u * (unsigned)(ngrp + 1), (unsigned*)(args.ws + WS_CTL) + CW_BAR, wave_s, (unsigned*)(args.ws + WS_CTL) + CW_CVT + 64 * (job), (unsigned)(G - nt_)); ++ngrp; } else xcd_barrier(xbar); } ++ph; } while (0)
#else
#define PH_END_GRP PH_END
#define PH_END_GRPC(job) PH_END
#endif
#define MAKE_RT(rt, MODE) pg8::RsTable<MODE> rt; { const int t_ = tid_of(wave_s), w_ = __builtin_amdgcn_readfirstlane(t_ >> 6); rt.tab = (LAS float*)(lds + RST_OFF) + w_ * 128; rt.ss = ss_in; \
        pg8::Unit u0_{0, 0}; if (MODE && S.next(0, u0_)) rt.fill(u0_.pm, w_ >> 2, t_ & 63); }
#define MAKE_LW(lw, L) LayerW lw; { const int L_ = (L), i_ = L_ >> 1; lw.even = !(L_ & 1); \
        lw.gu1 = args.in[2] + (size_t)L_ * D * 2 * FF; lw.d1 = args.in[3] + (size_t)L_ * FF * D; lw.gu2 = args.in[6] + (size_t)L_ * D * 2 * FF; lw.d2 = args.in[7] + (size_t)L_ * FF * D; \
        lw.g1 = args.in[1] + L_ * D; lw.gm = args.in[4] + L_ * D; lw.g2 = args.in[5] + L_ * D; \
        lw.mi = lw.even ? args.in[8] + (size_t)i_ * D * NIN_CONV : args.in[15] + (size_t)i_ * D * NQKV; lw.mo = lw.even ? args.in[14] + (size_t)i_ * D * D : args.in[16] + (size_t)i_ * D * D; }

    if (PH_ON) {
        TID_VARS;
        const float* x = args.in[0];
        for (int m0 = gw; m0 < M; m0 += 2 * NGW) { f32x4 v[2][4]; float s[2] = {0.f, 0.f};
#pragma unroll
            for (int e = 0; e < 2; ++e) { const int m = m0 + e * NGW; if (m < M) { const f32x4* xr = (const f32x4*)(x + (size_t)m * D) + lane;
#pragma unroll
                for (int j = 0; j < 4; ++j) v[e][j] = __builtin_nontemporal_load(&xr[64 * j]); } }
#pragma unroll
            for (int e = 0; e < 2; ++e) { const int m = m0 + e * NGW; if (m < M) {
#pragma unroll
                for (int j = 0; j < 4; ++j) s[e] += (v[e][j].x * v[e][j].x + v[e][j].y * v[e][j].y) + (v[e][j].z * v[e][j].z + v[e][j].w * v[e][j].w);
                s[e] = wave_sum(s[e]);
                v2u* bo = (v2u*)(XB + (size_t)m * D) + lane;
#pragma unroll
                for (int j = 0; j < 4; ++j) { v2u w; w.x = pk2(v[e][j].x, v[e][j].y); w.y = pk2(v[e][j].z, v[e][j].w); bo[64 * j] = w; }
                if (lane == 0) SS[m] = (pg8::ss_t)(s[e] * pg8::SS_SCALE); } } }
        MAKE_LW(lw, 0); convert_layer(lw, (bf16*)(ws + WS_W), 0, lds, gw, NGW, wave, lane);
    }
    PH_END;

    for (int sb = 0; sb < 3 * DEPTH; ++sb) {
        const int L = sb / 3, kind = sb % 3, even = !(L & 1);
        bf16* WB = (bf16*)(ws + WS_W + (size_t)(L & 1) * W_STRIDE);
        pg8::ss_t* ss_in = SS + (size_t)sb * M; pg8::ss_t* ss_out = SS + (size_t)(sb + 1) * M;
        if (kind != 1) {
            if (PH_ON) { pg8::Gemm g{XB, WB + (kind ? OW_GU2 : OW_GU1), M, 2 * FF, D}; pg8::StaticOrder S; S.init(M, 2 * FF, opqs(G), opqs(bx));
                if (G == 256) { MAKE_RT(rt, true); pg8::EpiSwiglu<true> E{ACT, ZPITCH, rt}; pg8::gemm_phase<pg8::EpiSwiglu<true>, pg8::StaticOrder, true, true>(lds, g, S, E, wave_s); }
#ifndef PROBE_NOFALLBACK
                else { MAKE_RT(rt, false); pg8::EpiSwiglu<false> E{ACT, ZPITCH, rt}; pg8::gemm_phase<pg8::EpiSwiglu<false>, pg8::StaticOrder, true, true>(lds, g, S, E, wave_s); }
#endif
                { const int nwg = (M / 256) * (2 * FF / 256), ntail = nwg % G, cl = (kind == 0) ? L : L + 1;
                  if (ntail > 0 && bx >= ntail && cl < DEPTH) { TID_VARS; MAKE_LW(lw, cl);
                      convert_layer(lw, (bf16*)(ws + WS_W + (size_t)(cl & 1) * W_STRIDE), kind == 0 ? 1 : 0, lds, (bx - ntail) * NWAVES + wave, (G - ntail) * NWAVES, wave, lane);
                      asm volatile("s_waitcnt vmcnt(0)" ::: "memory"); __syncthreads();
                      if (tid == 0) (void)xb_add((unsigned*)(args.ws + WS_CTL) + CW_CVT + 64 * (2 * cl + (kind == 0 ? 1 : 0)), 1u); }
                  else if (ntail == 0 && cl < DEPTH) { TID_VARS; MAKE_LW(lw, cl); convert_layer(lw, (bf16*)(ws + WS_W + (size_t)(cl & 1) * W_STRIDE), kind == 0 ? 1 : 0, lds, gw, NGW, wave, lane); } }
            }
            PH_END_GRP;
            if (PH_ON) { pg8::Gemm g{ACT, WB + (kind ? OW_D2 : OW_D1), M, D, FF, ZPITCH}; pg8::StaticOrder S; S.init(M, D, opqs(G), opqs(bx));
                pg8::EpiResid E{XB, ss_out, 0.5f, G == 256 ? (LAS pg8::ss_t*)(lds + QTAB_OFF) : (LAS pg8::ss_t*)nullptr};
#ifndef NO_G2
                pg8::gemm_phase<pg8::EpiResid, pg8::StaticOrder, true, true>(lds, g, S, E, wave_s);
#endif
                if (G == 256) { __syncthreads(); const int t_ = tid_of(wave_s); pg8::Unit u0_{0, 0};
                    if (t_ < 256 && S.next(0, u0_)) { const LAS pg8::ss_t* p_ = (const LAS pg8::ss_t*)(lds + QTAB_OFF) + t_ * 4; __hip_atomic_fetch_add(ss_out + u0_.pm * 256 + t_, (p_[0] + p_[1]) + (p_[2] + p_[3]), __ATOMIC_RELAXED, __HIP_MEMORY_SCOPE_AGENT); } }
#ifdef DUP_G2
                xcd_barrier(xbar); { pg8::EpiResid E2{XB, SS + (size_t)13 * M, 0.0f, (LAS pg8::ss_t*)nullptr}; pg8::gemm_phase<pg8::EpiResid, pg8::StaticOrder, true, true>(lds, g, S, E2, wave_s); }
#endif
            }
            if (kind == 0) PH_END_GRPC(2 * L + 1); else if (L + 1 < DEPTH) PH_END_GRPC(2 * (L + 1)); else PH_END_GRP;
        } else {
            const int nmi = even ? NIN_CONV : NQKV;
            if (PH_ON) { pg8::Gemm g{XB, WB + OW_MI, M, nmi, D}; pg8::StaticOrder S; S.init(M, nmi, opqs(G), opqs(bx));
                if (G == 256) { MAKE_RT(rt, true); pg8::EpiScale<true> E{ACT, ZPITCH, rt}; pg8::gemm_phase<pg8::EpiScale<true>, pg8::StaticOrder, true, true>(lds, g, S, E, wave_s); }
#ifndef PROBE_NOFALLBACK
                else { MAKE_RT(rt, false); pg8::EpiScale<false> E{ACT, ZPITCH, rt}; pg8::gemm_phase<pg8::EpiScale<false>, pg8::StaticOrder, true, true>(lds, g, S, E, wave_s); }
#endif
            }
            PH_END;
            if (PH_ON) {
                const int i = L >> 1;
                if (even) {
#ifndef NO_CONV
                    conv_phase(lds, ACT, OG, args.in[9] + i * 3 * 512, args.in[10] + i * 31 * 512, args.in[11] + i * 512, args.in[12] + i * 512, args.in[13] + i * 512, G == 256 ? PANEL_OF(bx) * 8 + (bx >> 6) * 2 : vcu, G == 256 ? 1 : G, G == 256 ? PANEL_OF(bx) * 8 + (bx >> 6) * 2 + 2 : M / 32, wave_s);
#endif
#ifdef DUP_CONV
                    __syncthreads(); conv_phase(lds, ACT, OG, args.in[9] + i * 3 * 512, args.in[10] + i * 31 * 512, args.in[11] + i * 512, args.in[12] + i * 512, args.in[13] + i * 512, G == 256 ? PANEL_OF(bx) * 8 + (bx >> 6) * 2 : vcu, G == 256 ? 1 : G, G == 256 ? PANEL_OF(bx) * 8 + (bx >> 6) * 2 + 2 : M / 32, wave_s);
#endif
                } else {
#ifndef NO_ATT
                    attn_phase(lds, ACT, OG, LSE, G, vcu, wave_s);
#endif
#ifdef DUP_ATT
                    __syncthreads(); attn_phase(lds, ACT, OG, LSE, G, vcu, wave_s);
#endif
                }
            }
            PH_END;
            if (!even) { if (PH_ON) { merge_phase(OG, LSE, MG, G == 256 ? (PANEL_OF(bx) * 256 + (bx >> 6) * 64) * 128 : vcu * 512, G == 256 ? (PANEL_OF(bx) * 256 + (bx >> 6) * 64 + 64) * 128 : M * 128, G == 256 ? 512 : G * 512, wave_s);
#ifdef DUP_MERGE
                xcd_barrier(xbar); merge_phase(OG, LSE, MG, G == 256 ? (PANEL_OF(bx) * 256 + (bx >> 6) * 64) * 128 : vcu * 512, G == 256 ? (PANEL_OF(bx) * 256 + (bx >> 6) * 64 + 64) * 128 : M * 128, G == 256 ? 512 : G * 512, wave_s);
#endif
            } PH_END_GRP; }
            if (PH_ON) { pg8::Gemm g{even ? OG : MG, WB + OW_MO, M, D, D}; pg8::StaticOrder S; S.init(M, D, opqs(G), opqs(bx));
                pg8::EpiResid E{XB, ss_out, 1.0f, G == 256 ? (LAS pg8::ss_t*)(lds + QTAB_OFF) : (LAS pg8::ss_t*)nullptr};
#ifndef NO_G4
                pg8::gemm_phase<pg8::EpiResid, pg8::StaticOrder, true, true>(lds, g, S, E, wave_s);
#endif
                if (G == 256) { __syncthreads(); const int t_ = tid_of(wave_s); pg8::Unit u0_{0, 0};
                    if (t_ < 256 && S.next(0, u0_)) { const LAS pg8::ss_t* p_ = (const LAS pg8::ss_t*)(lds + QTAB_OFF) + t_ * 4; __hip_atomic_fetch_add(ss_out + u0_.pm * 256 + t_, (p_[0] + p_[1]) + (p_[2] + p_[3]), __ATOMIC_RELAXED, __HIP_MEMORY_SCOPE_AGENT); } }
#ifdef DUP_G4
                xcd_barrier(xbar); { pg8::EpiResid E2{XB, SS + (size_t)13 * M, 0.0f, (LAS pg8::ss_t*)nullptr}; pg8::gemm_phase<pg8::EpiResid, pg8::StaticOrder, true, true>(lds, g, S, E2, wave_s); }
#endif
            }
            PH_END_GRP;
        }
    }
    if (PH_ON) {
        TID_VARS;
        const float* gf = args.in[17]; const pg8::ss_t* ssf = SS + (size_t)12 * M;
        f32x4 gv[4];
#pragma unroll
        for (int j = 0; j < 4; ++j) gv[j] = ((const f32x4*)gf)[64 * j + lane];
        const int fm0 = (G == 256) ? PANEL_OF(bx) * 256 + (bx >> 6) * 64 + wave : gw, fstep = (G == 256) ? 8 : NGW, fend = (G == 256) ? PANEL_OF(bx) * 256 + (bx >> 6) * 64 + 64 : M;
        for (int m0 = fm0; m0 < fend; m0 += 2 * fstep) { v2u w[2][4]; float rs[2] = {0.f, 0.f};
#pragma unroll
            for (int e = 0; e < 2; ++e) { const int m = m0 + e * fstep; if (m < fend) { const v2u* xb = (const v2u*)(XB + (size_t)m * D) + lane; rs[e] = pg8::rstd_of(ssf, m);
#pragma unroll
                for (int j = 0; j < 4; ++j) w[e][j] = xb[64 * j]; } }
#pragma unroll
            for (int e = 0; e < 2; ++e) { const int m = m0 + e * fstep; if (m < fend) { f32x4* xo = (f32x4*)(X + (size_t)m * D) + lane;
#pragma unroll
                for (int j = 0; j < 4; ++j) { const f32x4 v = (f32x4){bf_lo(w[e][j].x), bf_hi(w[e][j].x), bf_lo(w[e][j].y), bf_hi(w[e][j].y)}; xo[64 * j] = v * rs[e] * gv[j]; } } } }
    }
    ++ph;
}
constexpr int N_PHASES = 1 + 2 * (2 + 3 + 2) + 2 * (2 + 4 + 2) + 1;

extern "C" void kernel_launch(void* const* d_in, const int* in_sizes, int n_in, void* d_out, int out_size, void* d_ws, size_t ws_size, hipStream_t stream) {
    static int grid = 0;
    if (grid == 0) {
        if (n_in != 18 || in_sizes[0] != M * D || out_size != M * D || ws_size < WS_END) { fprintf(stderr, "kernel_launch: unexpected shapes (n_in %d, in0 %d, out %d, ws %zu)\n", n_in, n_in > 0 ? in_sizes[0] : -1, out_size, ws_size); grid = -1; return; }
        int dev = 0, cus = 0, per_cu = 0;
        hipGetDevice(&dev); hipDeviceGetAttribute(&cus, hipDeviceAttributeMultiprocessorCount, dev);
        if (hipFuncSetAttribute((const void*)mk_fwd, hipFuncAttributeMaxDynamicSharedMemorySize, LDS_BYTES) != hipSuccess) { fprintf(stderr, "kernel_launch: hipFuncSetAttribute failed\n"); grid = -1; return; }
        if (hipOccupancyMaxActiveBlocksPerMultiprocessor(&per_cu, (const void*)mk_fwd, NWAVES * 64, LDS_BYTES) != hipSuccess || per_cu < 1) { fprintf(stderr, "kernel_launch: occupancy query says %d\n", per_cu); per_cu = 1; }
        (void)hipGetLastError();
        grid = cus * (per_cu > 1 ? 1 : per_cu);
    }
    if (grid < 0) return;
    hipMemsetAsync((char*)d_ws + WS_CTL, 0, CTL_ZERO_BYTES, stream);
    Args a{};
    for (int i = 0; i < 18; ++i) a.in[i] = (const float*)d_in[i];
    a.out = (float*)d_out; a.ws = (unsigned char*)d_ws;
#if MK_N_LAUNCHES == 1
    a.ph_lo = 0; a.ph_hi = N_PHASES;
    void* kargs[] = {&a};
    hipError_t e = hipLaunchCooperativeKernel((const void*)mk_fwd, dim3(grid), dim3(NWAVES * 64), kargs, LDS_BYTES, stream);
    if (e != hipSuccess) fprintf(stderr, "kernel_launch: cooperative launch failed: %s (grid %d)\n", hipGetErrorString(e), grid);
#else
    for (int p = 0; p < N_PHASES; ++p) { a.ph_lo = p; a.ph_hi = p + 1; hipLaunchKernelGGL(mk_fwd, dim3(grid), dim3(NWAVES * 64), LDS_BYTES, stream, a); }
#endif
}
```
